# Optimizing an MI355X kernel written in HIP

```python
import math
import jax, jax.numpy as jnp
from jax import lax
import numpy as np

D_MODEL = 2048
BATCH = 1
SEQ = 16384
DEPTH = 2

HEAD_DIM = 128
N_HEADS_A = 8
DILATED_PATTERNS = ((128, 1), (512, 4), (2048, 16))
BLK = 128
N_BUCKETS = 32
MAX_DISTANCE = 2048
N_HEADS_B = 8
Q_LORA = 512
KV_LORA = 256
NOPE_DIM = 128
ROPE_DIM = 64
V_DIM = 128
QK_DIM_B = NOPE_DIM + ROPE_DIM
ROPE_THETA = 10000.0
WIDTH_A = N_HEADS_A * HEAD_DIM
WIDTH_B = N_HEADS_B * V_DIM
MIX_WIDTH = WIDTH_A + WIDTH_B
IN_COLS = 3 * WIDTH_A + Q_LORA + KV_LORA + ROPE_DIM
D_FF = 5632
N_EXPERTS = 8
TOP_K = 2
D_FF_EXPERT = 5632
N_DENSE = (DEPTH + 1) // 2
N_MOE = DEPTH // 2
EPS = 1e-6
NEG = -1e30

kernel_name = "hybrid_dilated_swa_mla_moe_block"


def rms_norm(x, g):
    xf = x.astype(jnp.float32)
    y = xf * lax.rsqrt(jnp.mean(xf * xf, axis=-1, keepdims=True) + EPS)
    return (y * g.astype(jnp.float32)).astype(x.dtype)


def t5_bucket(n):
    max_exact = N_BUCKETS // 2
    nf = jnp.maximum(n, 1).astype(jnp.float32)
    large = max_exact + (jnp.log(nf / max_exact) / math.log(MAX_DISTANCE / max_exact)
                         * (N_BUCKETS - max_exact)).astype(jnp.int32)
    large = jnp.minimum(large, N_BUCKETS - 1)
    return jnp.where(n < max_exact, n, large)


def dilated_window_attn(q, k, v, rel_bias, window, dilation):
    B, S, H, Dh = q.shape
    span = dilation * BLK
    L = -(-S // span) * span
    M = L // dilation
    nb = M // BLK
    steps = window // dilation

    def to_classes(t):
        t = jnp.pad(t, ((0, 0), (0, L - S), (0, 0), (0, 0)))
        t = t.reshape(B, M, dilation, H, Dh).transpose(0, 2, 3, 1, 4)
        return t.reshape(B, dilation, H, nb, BLK, Dh)

    qb, kb, vb = to_classes(q), to_classes(k), to_classes(v)
    prev = lambda t: jnp.pad(t, ((0, 0), (0, 0), (0, 0), (1, 0), (0, 0), (0, 0)))[:, :, :, :-1]
    kb2 = jnp.concatenate([prev(kb), kb], axis=4)
    vb2 = jnp.concatenate([prev(vb), vb], axis=4)

    i = jnp.arange(BLK)[:, None]
    j = jnp.arange(2 * BLK)[None, :]
    delta = i + BLK - j
    band = (delta >= 0) & (delta <= steps)
    bucket = t5_bucket(jnp.maximum(delta, 0) * dilation)
    bias = rel_bias[bucket].astype(jnp.float32).transpose(2, 0, 1)
    blk_valid = (jnp.arange(nb)[:, None, None] > 0) | (j[None] >= BLK)
    mask = band[None] & blk_valid

    s = jnp.einsum('bdhnqc,bdhnkc->bdhnqk', qb, kb2).astype(jnp.float32) * (Dh ** -0.5)
    s = jnp.where(mask, s + bias[:, None], NEG)
    m = jnp.max(s, axis=-1, keepdims=True)
    p = jnp.exp(s - m)
    den = jnp.sum(p, axis=-1, keepdims=True)
    o = jnp.einsum('bdhnqk,bdhnkc->bdhnqc', p.astype(v.dtype), vb2).astype(jnp.float32) / den
    lse = (m + jnp.log(den))[..., 0]

    o = o.reshape(B, dilation, H, M, Dh).transpose(0, 3, 1, 2, 4).reshape(B, L, H, Dh)[:, :S]
    lse = lse.reshape(B, dilation, H, M).transpose(0, 3, 1, 2).reshape(B, L, H)[:, :S]
    return o, lse


def dilated_mixer(qa, ka, va, q_g, k_g, rel_bias):
    B, S, _ = qa.shape
    sh = (B, S, N_HEADS_A, HEAD_DIM)
    q = rms_norm(qa.reshape(sh), q_g)
    k = rms_norm(ka.reshape(sh), k_g)
    v = va.reshape(sh)
    outs, lses = [], []
    for window, dilation in DILATED_PATTERNS:
        o, l = dilated_window_attn(q, k, v, rel_bias, window, dilation)
        outs.append(o)
        lses.append(l)
    w = jax.nn.softmax(jnp.stack(lses, axis=0), axis=0)[..., None]
    out = jnp.sum(w * jnp.stack(outs, axis=0), axis=0)
    return out.reshape(B, S, WIDTH_A).astype(qa.dtype)


def rope(x, positions):
    half = ROPE_DIM // 2
    inv = ROPE_THETA ** (-jnp.arange(half, dtype=jnp.float32) / half)
    ang = positions.astype(jnp.float32)[..., None] * inv
    cos = jnp.cos(ang)[:, :, None, :]
    sin = jnp.sin(ang)[:, :, None, :]
    xf = x.astype(jnp.float32)
    x1, x2 = xf[..., :half], xf[..., half:]
    return jnp.concatenate([x1 * cos - x2 * sin, x1 * sin + x2 * cos], axis=-1).astype(x.dtype)


def causal_block_attn(q, k, v, scale):
    B, S, H, Dq = q.shape
    nq = S // BLK
    qb = q.reshape(B, nq, BLK, H, Dq).transpose(1, 0, 2, 3, 4)
    kpos = jnp.arange(S)

    def one_block(args):
        qi, bi = args
        s = jnp.einsum('bqhc,bkhc->bhqk', qi, k).astype(jnp.float32) * scale
        qpos = bi * BLK + jnp.arange(BLK)
        s = jnp.where(kpos[None, :] <= qpos[:, None], s, NEG)
        p = jax.nn.softmax(s, axis=-1)
        return jnp.einsum('bhqk,bkhc->bqhc', p.astype(v.dtype), v)

    out = lax.map(one_block, (qb, jnp.arange(nq)))
    return out.transpose(1, 0, 2, 3, 4).reshape(B, S, H, v.shape[-1])


def mla_mixer(cq, ckv, kr, positions, q_a_g, kv_a_g, w_q_b, w_kv_b, q_g, k_g):
    B, S, _ = cq.shape
    q = (rms_norm(cq, q_a_g) @ w_q_b).reshape(B, S, N_HEADS_B, QK_DIM_B)
    kv = (rms_norm(ckv, kv_a_g) @ w_kv_b).reshape(B, S, N_HEADS_B, NOPE_DIM + V_DIM)
    k_nope, v = kv[..., :NOPE_DIM], kv[..., NOPE_DIM:]
    k_rope = jnp.broadcast_to(kr[:, :, None, :], (B, S, N_HEADS_B, ROPE_DIM))
    k = jnp.concatenate([k_nope, k_rope], axis=-1)
    q = rms_norm(q, q_g)
    k = rms_norm(k, k_g)
    q = jnp.concatenate([q[..., :NOPE_DIM], rope(q[..., NOPE_DIM:], positions)], axis=-1)
    k = jnp.concatenate([k[..., :NOPE_DIM], rope(k[..., NOPE_DIM:], positions)], axis=-1)
    out = causal_block_attn(q, k, v, QK_DIM_B ** -0.5)
    return out.reshape(B, S, WIDTH_B)


def swiglu(h, wg, wu, wd):
    return (jax.nn.silu(h @ wg) * (h @ wu)) @ wd


def moe_swiglu(h, w_router, w_gate, w_up, w_down):
    logits = (h @ w_router).astype(jnp.float32)
    top_val, top_idx = lax.top_k(logits, TOP_K)
    gates = jax.nn.softmax(top_val, axis=-1)
    combine = jnp.sum(jax.nn.one_hot(top_idx, N_EXPERTS, dtype=jnp.float32)
                      * gates[..., None], axis=-2)
    out = jnp.zeros_like(h)
    for e in range(N_EXPERTS):
        out = out + combine[..., e:e + 1].astype(h.dtype) * swiglu(h, w_gate[e], w_up[e], w_down[e])
    return out


def setup_inputs(seed: int = 0) -> dict:
    key = jax.random.key(seed)
    ks = jax.random.split(key, 24)
    f32 = jnp.float32
    nrm = lambda k, shape, fan_in: jax.random.normal(k, shape, f32) * (fan_in ** -0.5)
    gain = lambda k, shape: 1.0 + 0.02 * jax.random.normal(k, shape, f32)
    start = jax.random.randint(ks[1], (BATCH, 1), 0, 4096, dtype=jnp.int32)
    positions = start + jnp.arange(SEQ, dtype=jnp.int32)[None, :]
    return {
        "x": jax.random.normal(ks[0], (BATCH, SEQ, D_MODEL), f32),
        "positions": positions,
        "rel_bias_table": 0.5 * jax.random.normal(ks[2], (N_BUCKETS, N_HEADS_A), f32),
        "norm_mix_g": gain(ks[3], (DEPTH, D_MODEL)),
        "w_in": nrm(ks[4], (DEPTH, D_MODEL, IN_COLS), D_MODEL),
        "q_a_norm_g": gain(ks[5], (DEPTH, Q_LORA)),
        "kv_a_norm_g": gain(ks[6], (DEPTH, KV_LORA)),
        "w_q_b": nrm(ks[7], (DEPTH, Q_LORA, N_HEADS_B * QK_DIM_B), Q_LORA),
        "w_kv_b": nrm(ks[8], (DEPTH, KV_LORA, N_HEADS_B * (NOPE_DIM + V_DIM)), KV_LORA),
        "q_norm_a_g": gain(ks[9], (DEPTH, HEAD_DIM)),
        "k_norm_a_g": gain(ks[10], (DEPTH, HEAD_DIM)),
        "q_norm_b_g": gain(ks[11], (DEPTH, QK_DIM_B)),
        "k_norm_b_g": gain(ks[12], (DEPTH, QK_DIM_B)),
        "w_out": nrm(ks[13], (DEPTH, MIX_WIDTH, D_MODEL), MIX_WIDTH),
        "norm_ffn_g": gain(ks[14], (DEPTH, D_MODEL)),
        "w_ff_gate": nrm(ks[15], (N_DENSE, D_MODEL, D_FF), D_MODEL),
        "w_ff_up": nrm(ks[16], (N_DENSE, D_MODEL, D_FF), D_MODEL),
        "w_ff_down": nrm(ks[17], (N_DENSE, D_FF, D_MODEL), D_FF),
        "w_router": nrm(ks[18], (N_MOE, D_MODEL, N_EXPERTS), D_MODEL),
        "w_exp_gate": nrm(ks[19], (N_MOE, N_EXPERTS, D_MODEL, D_FF_EXPERT), D_MODEL),
        "w_exp_up": nrm(ks[20], (N_MOE, N_EXPERTS, D_MODEL, D_FF_EXPERT), D_MODEL),
        "w_exp_down": nrm(ks[21], (N_MOE, N_EXPERTS, D_FF_EXPERT, D_MODEL), D_FF_EXPERT),
    }


def reference(x, positions, rel_bias_table, norm_mix_g, w_in, q_a_norm_g, kv_a_norm_g,
              w_q_b, w_kv_b, q_norm_a_g, k_norm_a_g, q_norm_b_g, k_norm_b_g, w_out,
              norm_ffn_g, w_ff_gate, w_ff_up, w_ff_down, w_router, w_exp_gate,
              w_exp_up, w_exp_down):
    splits = [WIDTH_A, 2 * WIDTH_A, 3 * WIDTH_A, 3 * WIDTH_A + Q_LORA,
              3 * WIDTH_A + Q_LORA + KV_LORA]
    for l in range(DEPTH):
        h = rms_norm(x, norm_mix_g[l])
        proj = h @ w_in[l]
        qa, ka, va, cq, ckv, kr = jnp.split(proj, splits, axis=-1)
        a = dilated_mixer(qa, ka, va, q_norm_a_g[l], k_norm_a_g[l], rel_bias_table)
        b = mla_mixer(cq, ckv, kr, positions, q_a_norm_g[l], kv_a_norm_g[l],
                      w_q_b[l], w_kv_b[l], q_norm_b_g[l], k_norm_b_g[l])
        x = x + jnp.concatenate([a, b.astype(a.dtype)], axis=-1) @ w_out[l]
        h2 = rms_norm(x, norm_ffn_g[l])
        if l % 2 == 0:
            f = swiglu(h2, w_ff_gate[l // 2], w_ff_up[l // 2], w_ff_down[l // 2])
        else:
            f = moe_swiglu(h2, w_router[l // 2], w_exp_gate[l // 2], w_exp_up[l // 2],
                           w_exp_down[l // 2])
        x = x + f
    return x
```

```cpp
#include <hip/hip_runtime.h>
#include <cstdio>
#include <cstdint>
namespace pg8 {
#define PG8_LAS __attribute__((address_space(3)))
typedef unsigned short bf16_t;
typedef short bf16x8 __attribute__((ext_vector_type(8)));
typedef float f32x4 __attribute__((ext_vector_type(4)));
typedef unsigned u32x4 __attribute__((ext_vector_type(4)));
constexpr int BM = 256, BK = 64, HALF = 128, HTB = HALF * BK * 2  , STAGE_BYTES = 8 * HTB, NXCD = 8, WGM = 8;

__device__ __forceinline__ int lds_byte(int r, int c) { const int st = (r >> 4) * 2 + (c >> 5), rr = r & 15, cc = c & 31, ob = rr * 64 + cc * 2; return st * 1024 + (ob ^ (((ob >> 9) & 1) << 5)); }
__device__ __forceinline__ void stage_rc(int b, int& R, int& C) { const int st = b / 1024, sb = b % 1024, swz = sb ^ (((sb >> 9) & 1) << 5); R = (st >> 1) * 16 + swz / 64; C = (st & 1) * 32 + (swz % 64) / 2; }
__device__ __forceinline__ int perm32(int rho) { const int n = rho >> 4, i = rho & 15; return 8 * (i >> 2) + 4 * n + (i & 3); }

struct Unit { int pm, pn, e, lt, kt0, nkt, tail; };
struct Gemm { const bf16_t* A; const bf16_t* Bt; int K; int lda; };

struct TileOrder {
    int nM, nN, nwg, G, c, wgm, rev;
    __device__ __forceinline__ void init(int nM_, int nN_, int G_, int c_, int wgm_ = WGM) { nM = nM_; nN = nN_; nwg = nM * nN; G = G_; c = c_; wgm = wgm_; rev = 0; }
    __device__ __forceinline__ bool next(int i, Unit& u) const { return at((long)i * G + c, u); }
    __device__ __forceinline__ bool at(long L, Unit& u) const {
        if (L >= nwg) return false;
        int wgid = (int)L; { const int q = nwg / NXCD, r = nwg % NXCD, xcd = wgid % NXCD, off = wgid / NXCD; wgid = (xcd < r ? xcd * (q + 1) : r * (q + 1) + (xcd - r) * q) + off; }
        if (rev) wgid = nwg - 1 - wgid;
        const int nig = wgm * nN, gid = wgid / nig, fm = gid * wgm, gsz = (nM - fm) < wgm ? (nM - fm) : wgm;
        u.pm = fm + ((wgid % nig) % gsz); u.pn = (wgid % nig) / gsz; u.e = 0; u.lt = 0; u.kt0 = 0; u.nkt = 0; u.tail = 0; return true;
    }
    __device__ __forceinline__ unsigned a_off(const Unit&, int) const { return 0u; }
};
struct MoeOrder {
    TileOrder t; int t1, t2, t3, t4, t5, t6, t7; int nNl; const int* list; const int* cnt; int S_cap; int R, T, nkt_full;
    __device__ __forceinline__ void find(int pm, int& e, int& tb) const {
        e = (pm >= t1) + (pm >= t2) + (pm >= t3) + (pm >= t4) + (pm >= t5) + (pm >= t6) + (pm >= t7);
        tb = pm >= t7 ? t7 : pm >= t6 ? t6 : pm >= t5 ? t5 : pm >= t4 ? t4 : pm >= t3 ? t3 : pm >= t2 ? t2 : pm >= t1 ? t1 : 0;
    }
    __device__ __forceinline__ bool next(int i, Unit& u) const {
        if (R >= 0 && i >= R) {
            if (i > R || t.c >= 4 * T) return false;
            if (!t.at((long)R * t.G + (t.c >> 2), u)) return false;
            u.nkt = nkt_full / 4; u.kt0 = (t.c & 3) * u.nkt; u.tail = 1 + t.c;
        } else { if (!t.next(i, u)) return false; u.nkt = nkt_full; }
        int e, tb; find(u.pm, e, tb); u.e = e; u.lt = u.pm - tb; u.pn += e * nNl; return true;
    }
    __device__ __forceinline__ unsigned a_off(const Unit& u, int R) const {
        const int slot = u.lt * 256 + R; const int n = cnt[u.e];
        const int tok = list[(size_t)u.e * S_cap + (slot < n ? slot : 0)];
        return (unsigned)tok * 4096u;
    }
};

__device__ __forceinline__ unsigned cvt_pk_bf16(float lo, float hi) { unsigned r; asm volatile("v_cvt_pk_bf16_f32 %0, %1, %2" : "=v"(r) : "v"(lo), "v"(hi)); return r; }

__device__ __forceinline__ float shx(float v, int lane, int o) { return __builtin_bit_cast(float, __builtin_amdgcn_ds_bpermute((lane ^ o) << 2, __builtin_bit_cast(int, v))); }
__device__ __forceinline__ float sum_fq(float v, int lane) { v += shx(v, lane, 16); v += shx(v, lane, 32); return v; }
__device__ __forceinline__ float ssq4(const f32x4 a) { return (a[0] * a[0] + a[1] * a[1]) + (a[2] * a[2] + a[3] * a[3]); }
__device__ __forceinline__ float row_rs(const float* ssq, int ns, int grow, float inv_n, float eps) {
    float t;
    if (ns == 8) { const f32x4 a = *(const f32x4*)(ssq + (size_t)grow * 8), b = *(const f32x4*)(ssq + (size_t)grow * 8 + 4); t = ((a[0] + a[1]) + (a[2] + a[3])) + ((b[0] + b[1]) + (b[2] + b[3])); }
    else if (ns == 2) { t = ssq[(size_t)grow * 2] + ssq[(size_t)grow * 2 + 1]; }
    else t = ssq[grow];
    return 1.0f / sqrtf(t * inv_n + eps);
}
struct EpiBf16 {
    static constexpr bool PERM = true;
    bf16_t* O; int ldc; const float* ssq; int ns; float inv_n, eps;
    __device__ __forceinline__ void operator()(const f32x4 (&acc)[2][2][4][2], const Unit& u, int wr, int wc, int fr, int fq, int lane, PG8_LAS float* xl) const {
        const int row0 = u.pm * BM + wr * 64 + fr, col0 = u.pn * BM + wc * 32 + 8 * fq;
#pragma unroll
        for (int ai = 0; ai < 2; ++ai)
#pragma unroll
            for (int m = 0; m < 4; ++m) { const int grow = row0 + ai * HALF + m * 16; bf16_t* rowp = O + (size_t)grow * ldc + col0;
                const float rs = ssq ? row_rs(ssq, ns, grow, inv_n, eps) : 1.0f;
#pragma unroll
                for (int bj = 0; bj < 2; ++bj) { const f32x4 v0 = acc[ai][bj][m][0] * rs, v1 = acc[ai][bj][m][1] * rs;
                    u32x4 w; w.x = cvt_pk_bf16(v0[0], v0[1]); w.y = cvt_pk_bf16(v0[2], v0[3]); w.z = cvt_pk_bf16(v1[0], v1[1]); w.w = cvt_pk_bf16(v1[2], v1[3]);
                    *(u32x4*)(rowp + bj * HALF) = w; } }
    }
};
struct EpiInProj {
    static constexpr bool PERM = true;
    bf16_t* O; int ldc; const float* ssq_x; int ns_x; const float* gq; const float* gk; const float* gckv; float* ssq_cq; float eps;
    __device__ __forceinline__ void operator()(const f32x4 (&acc)[2][2][4][2], const Unit& u, int wr, int wc, int fr, int fq, int lane, PG8_LAS float* xl) const {
        const int row0 = u.pm * BM + wr * 64 + fr, col0 = u.pn * BM + wc * 32 + 8 * fq, pn = u.pn;
        const bool headn = pn < 8, ckvn = pn == 14, cq = (pn == 12 || pn == 13);
        f32x4 v[2][4][2][2];
#pragma unroll
        for (int ai = 0; ai < 2; ++ai)
#pragma unroll
            for (int m = 0; m < 4; ++m) { const float rsx = row_rs(ssq_x, ns_x, row0 + ai * HALF + m * 16, 1.0f / 2048.0f, eps);
#pragma unroll
                for (int bj = 0; bj < 2; ++bj)
#pragma unroll
                    for (int n = 0; n < 2; ++n) v[ai][m][bj][n] = acc[ai][bj][m][n] * rsx; }
        if (headn || ckvn) {
#pragma unroll
            for (int ai = 0; ai < 2; ++ai)
#pragma unroll
                for (int m = 0; m < 4; ++m)
#pragma unroll
                    for (int bj = 0; bj < 2; ++bj) { const float s = sum_fq(ssq4(v[ai][m][bj][0]) + ssq4(v[ai][m][bj][1]), lane);
                        if (fq == 0) xl[((ai * HALF + wr * 64 + m * 16 + fr) * 2 + bj) * 4 + wc] = s; }
            asm volatile("s_waitcnt lgkmcnt(0)" ::: "memory"); __builtin_amdgcn_s_barrier(); asm volatile("" ::: "memory");
            f32x4 gg[2][2];
            { const int go = wc * 32 + 8 * fq;
              if (ckvn) { gg[0][0] = *(const f32x4*)(gckv + go); gg[0][1] = *(const f32x4*)(gckv + go + 4); gg[1][0] = *(const f32x4*)(gckv + HALF + go); gg[1][1] = *(const f32x4*)(gckv + HALF + go + 4); }
              else if (pn < 4) { gg[0][0] = *(const f32x4*)(gq + go); gg[0][1] = *(const f32x4*)(gq + go + 4); gg[1][0] = gg[0][0]; gg[1][1] = gg[0][1]; }
              else { gg[0][0] = *(const f32x4*)(gk + go); gg[0][1] = *(const f32x4*)(gk + go + 4); gg[1][0] = gg[0][0]; gg[1][1] = gg[0][1]; } }
#pragma unroll
            for (int ai = 0; ai < 2; ++ai)
#pragma unroll
                for (int m = 0; m < 4; ++m) { const int r = ai * HALF + wr * 64 + m * 16 + fr;
                    const f32x4 p0 = *(const PG8_LAS f32x4*)(xl + (r * 2 + 0) * 4), p1 = *(const PG8_LAS f32x4*)(xl + (r * 2 + 1) * 4);
                    const float t0 = (p0[0] + p0[1]) + (p0[2] + p0[3]), t1 = (p1[0] + p1[1]) + (p1[2] + p1[3]);
                    const float r0 = ckvn ? 1.0f / sqrtf((t0 + t1) * (1.0f / 256.0f) + eps) : 1.0f / sqrtf(t0 * (1.0f / 128.0f) + eps);
                    const float r1 = ckvn ? r0 : 1.0f / sqrtf(t1 * (1.0f / 128.0f) + eps);
#pragma unroll
                    for (int n = 0; n < 2; ++n) { v[ai][m][0][n] = v[ai][m][0][n] * r0 * gg[0][n]; v[ai][m][1][n] = v[ai][m][1][n] * r1 * gg[1][n]; } }
        } else if (cq) {
#pragma unroll
            for (int ai = 0; ai < 2; ++ai)
#pragma unroll
                for (int m = 0; m < 4; ++m) { const float s = sum_fq((ssq4(v[ai][m][0][0]) + ssq4(v[ai][m][0][1])) + (ssq4(v[ai][m][1][0]) + ssq4(v[ai][m][1][1])), lane);
                    if (fq == 0) xl[(ai * HALF + wr * 64 + m * 16 + fr) * 4 + wc] = s; }
            asm volatile("s_waitcnt lgkmcnt(0)" ::: "memory"); __builtin_amdgcn_s_barrier(); asm volatile("" ::: "memory");
            if (wc == 0 && fq == 0) {
#pragma unroll
                for (int ai = 0; ai < 2; ++ai)
#pragma unroll
                    for (int m = 0; m < 4; ++m) { const int r = ai * HALF + wr * 64 + m * 16 + fr; const f32x4 p = *(const PG8_LAS f32x4*)(xl + r * 4);
                        ssq_cq[(size_t)(u.pm * BM + r) * 2 + (pn - 12)] = (p[0] + p[1]) + (p[2] + p[3]); } }
        }
#pragma unroll
        for (int ai = 0; ai < 2; ++ai)
#pragma unroll
            for (int m = 0; m < 4; ++m) { bf16_t* rowp = O + (size_t)(row0 + ai * HALF + m * 16) * ldc + col0;
#pragma unroll
                for (int bj = 0; bj < 2; ++bj) { const f32x4 v0 = v[ai][m][bj][0], v1 = v[ai][m][bj][1];
                    u32x4 w; w.x = cvt_pk_bf16(v0[0], v0[1]); w.y = cvt_pk_bf16(v0[2], v0[3]); w.z = cvt_pk_bf16(v1[0], v1[1]); w.w = cvt_pk_bf16(v1[2], v1[3]);
                    *(u32x4*)(rowp + bj * HALF) = w; } }
    }
};
struct EpiRes {
    static constexpr bool PERM = true;
    const float* base32; const bf16_t* base16; float* out32; bf16_t* xb; float* ssq; int ldc;
    __device__ __forceinline__ void operator()(const f32x4 (&acc)[2][2][4][2], const Unit& u, int wr, int wc, int fr, int fq, int lane, PG8_LAS float* xl) const {
        const int row0 = u.pm * BM + wr * 64 + fr, col0 = u.pn * BM + wc * 32 + 8 * fq;
        float sr[2][4];
#pragma unroll
        for (int ai = 0; ai < 2; ++ai)
#pragma unroll
            for (int m = 0; m < 4; ++m) { const size_t off = (size_t)(row0 + ai * HALF + m * 16) * ldc + col0;
                f32x4 b[2][2];
                if (base32) {
#pragma unroll
                    for (int bj = 0; bj < 2; ++bj) { b[bj][0] = *(const f32x4*)(base32 + off + bj * HALF); b[bj][1] = *(const f32x4*)(base32 + off + bj * HALF + 4); }
                } else {
#pragma unroll
                    for (int bj = 0; bj < 2; ++bj) { const u32x4 w = *(const u32x4*)(base16 + off + bj * HALF);
                        b[bj][0] = (f32x4){__builtin_bit_cast(float, w.x << 16), __builtin_bit_cast(float, w.x & 0xffff0000u), __builtin_bit_cast(float, w.y << 16), __builtin_bit_cast(float, w.y & 0xffff0000u)};
                        b[bj][1] = (f32x4){__builtin_bit_cast(float, w.z << 16), __builtin_bit_cast(float, w.z & 0xffff0000u), __builtin_bit_cast(float, w.w << 16), __builtin_bit_cast(float, w.w & 0xffff0000u)}; }
                }
                float s = 0.f;
#pragma unroll
                for (int bj = 0; bj < 2; ++bj) { const f32x4 o0 = b[bj][0] + acc[ai][bj][m][0], o1 = b[bj][1] + acc[ai][bj][m][1];
                    if (out32) { *(f32x4*)(out32 + off + bj * HALF) = o0; *(f32x4*)(out32 + off + bj * HALF + 4) = o1; }
                    if (xb) { s += ssq4(o0) + ssq4(o1); u32x4 w; w.x = cvt_pk_bf16(o0[0], o0[1]); w.y = cvt_pk_bf16(o0[2], o0[3]); w.z = cvt_pk_bf16(o1[0], o1[1]); w.w = cvt_pk_bf16(o1[2], o1[3]); *(u32x4*)(xb + off + bj * HALF) = w; } }
                sr[ai][m] = s;
                asm volatile("" ::: "memory"); }
        if (xb) {
#pragma unroll
            for (int ai = 0; ai < 2; ++ai)
#pragma unroll
                for (int m = 0; m < 4; ++m) { const float s = sum_fq(sr[ai][m], lane); if (fq == 0) xl[(ai * HALF + wr * 64 + m * 16 + fr) * 4 + wc] = s; }
            asm volatile("s_waitcnt lgkmcnt(0)" ::: "memory"); __builtin_amdgcn_s_barrier(); asm volatile("" ::: "memory");
            if (wc == 0 && fq == 0) {
#pragma unroll
                for (int ai = 0; ai < 2; ++ai)
#pragma unroll
                    for (int m = 0; m < 4; ++m) { const int r = ai * HALF + wr * 64 + m * 16 + fr; const f32x4 p = *(const PG8_LAS f32x4*)(xl + r * 4);
                        ssq[(size_t)(u.pm * BM + r) * 8 + u.pn] = (p[0] + p[1]) + (p[2] + p[3]); } }
        }
    }
};
__device__ __forceinline__ float silu_mul(float g, float u) { return g * u * __builtin_amdgcn_rcpf(1.0f + __builtin_amdgcn_exp2f(-1.4426950408889634f * g)); }
struct EpiSwiGLU {
    static constexpr bool PERM = true;
    bf16_t* O; int ldc; int nNl; const float* ssq; float eps; int probe;
    __device__ __forceinline__ void operator()(const f32x4 (&acc)[2][2][4][2], const Unit& u, int wr, int wc, int fr, int fq, int lane, PG8_LAS float* xl) const {
        const int pnl = u.pn - u.e * nNl;
        if (probe == 2) return;
        const int row0 = u.pm * BM + wr * 64 + fr, col0 = pnl * HALF + wc * 32 + 8 * fq;
#pragma unroll
        for (int ai = 0; ai < 2; ++ai)
#pragma unroll
            for (int m = 0; m < 4; ++m) { const int grow = row0 + ai * HALF + m * 16; bf16_t* rowp = O + (size_t)grow * ldc + col0;
                const float rs = ssq ? row_rs(ssq, 8, grow, 1.0f / 2048.0f, eps) : 1.0f;
                const f32x4 g0 = acc[ai][0][m][0] * rs, g1 = acc[ai][0][m][1] * rs, u0 = acc[ai][1][m][0] * rs, u1 = acc[ai][1][m][1] * rs;
                u32x4 w; w.x = cvt_pk_bf16(silu_mul(g0[0], u0[0]), silu_mul(g0[1], u0[1])); w.y = cvt_pk_bf16(silu_mul(g0[2], u0[2]), silu_mul(g0[3], u0[3]));
                w.z = cvt_pk_bf16(silu_mul(g1[0], u1[0]), silu_mul(g1[1], u1[1])); w.w = cvt_pk_bf16(silu_mul(g1[2], u1[2]), silu_mul(g1[3], u1[3]));
                if (probe != 1 || w.x == 0x12345678u) *(u32x4*)rowp = w; }
    }
};
struct EpiMoeDown {
    static constexpr bool PERM = true;
    bf16_t* Y; int ldc; int nNl; const float* glist; const int* cnt; int S_cap; bf16_t* P;
    __device__ __forceinline__ void operator()(const f32x4 (&acc)[2][2][4][2], const Unit& u, int wr, int wc, int fr, int fq, int lane, PG8_LAS float* xl) const {
        const int pnl = u.pn - u.e * nNl; const int n = cnt[u.e];
        const int r0 = wr * 64 + fr;
        char* const tbase = u.tail ? (char*)(P + (size_t)(u.tail - 1) * BM * BM) : (char*)(Y + (size_t)u.pm * BM * ldc + pnl * BM);
        const unsigned pitch = u.tail ? (unsigned)BM : (unsigned)ldc;
#pragma unroll
        for (int ai = 0; ai < 2; ++ai)
#pragma unroll
            for (int m = 0; m < 4; ++m) { const int r = r0 + ai * HALF + m * 16; const int slot = u.lt * 256 + r;
                const float gt = slot < n ? glist[(size_t)u.e * S_cap + slot] : 0.f;
                bf16_t* rowp = (bf16_t*)(tbase + ((unsigned)r * pitch + (unsigned)(wc * 32 + 8 * fq)) * 2u);
#pragma unroll
                for (int bj = 0; bj < 2; ++bj) { const f32x4 v0 = acc[ai][bj][m][0] * gt, v1 = acc[ai][bj][m][1] * gt;
                    u32x4 w; w.x = cvt_pk_bf16(v0[0], v0[1]); w.y = cvt_pk_bf16(v0[2], v0[3]); w.z = cvt_pk_bf16(v1[0], v1[1]); w.w = cvt_pk_bf16(v1[2], v1[3]);
                    *(u32x4*)(rowp + bj * HALF) = w; } }
    }
};

template <class Epi, class Sched, bool GATHER, bool KS = false>
__device__ __forceinline__ void gemm_phase(PG8_LAS unsigned char* lds, const Gemm g, const Sched& S, const Epi& E, const int wid_in, PG8_LAS float* xlds) {
    int wid_ = wid_in; asm volatile("" : "+s"(wid_)); const int wid = wid_;
    int lane_; asm volatile("v_mbcnt_lo_u32_b32 %0, -1, 0\n\tv_mbcnt_hi_u32_b32 %0, -1, %0" : "=v"(lane_));
    const int lane = lane_, tid = wid * 64 + lane, wr = wid >> 2, wc = wid & 3, fr = lane & 15, fq = lane >> 4;
    const int K = g.K; int nt = K / BK;
    unsigned voffA[2], voffB[2]; int Rg[2];
#pragma unroll
    for (int i = 0; i < 2; ++i) { int R, C; stage_rc(tid * 16 + i * 8192, R, C); const int Rb = Epi::PERM ? ((R & ~31) + perm32(R & 31)) : R;
        voffA[i] = GATHER ? (unsigned)(C * 2) : (unsigned)(R * g.lda + C) * 2u; voffB[i] = (unsigned)(Rb * K + C) * 2u; Rg[i] = R; }
    const size_t kstep = (size_t)(BK * 2);
    const size_t hstep = (size_t)HALF * K * 2;
    const size_t tstep = 2 * hstep;
    const size_t hstepA = (size_t)HALF * g.lda * 2, tstepA = 2 * hstepA;
    const unsigned ldsw = (unsigned)wid * 1024u;
    const int aoff = lds_byte(wr * 64 + fr, fq * 8), boff = lds_byte(wc * 32 + fr, fq * 8);
#define PG8_SA(b, h) (((b) * 2 + (h)) * HTB)
#define PG8_SB(b, h) ((4 + (b) * 2 + (h)) * HTB)
#define PG8_STAGE(bufoff, gbase, voff) do { _Pragma("unroll") for (int _i = 0; _i < 2; ++_i) \
        __builtin_amdgcn_global_load_lds((const unsigned*)((const char*)(gbase) + (voff)[_i]), (PG8_LAS unsigned*)(lds + (bufoff) + ldsw + _i * 8192), 16, 0, 0); } while (0)
#define PG8_STA(bufoff, pbase, gbase, half, goff) do { if constexpr (GATHER) PG8_STAGE(bufoff, gbase, (goff)[half]); else PG8_STAGE(bufoff, (pbase) + (half) * hstepA, voffA); } while (0)
#define PG8_LDA(dst, b, h) do { _Pragma("unroll") for (int m = 0; m < 4; ++m) _Pragma("unroll") for (int k = 0; k < 2; ++k) dst[m][k] = *(const PG8_LAS bf16x8*)(lds + PG8_SA(b, h) + aoff + m * 2048 + k * 1024); } while (0)
#define PG8_LDB(dst, b, h) do { _Pragma("unroll") for (int n = 0; n < 2; ++n) _Pragma("unroll") for (int k = 0; k < 2; ++k) dst[n][k] = *(const PG8_LAS bf16x8*)(lds + PG8_SB(b, h) + boff + n * 2048 + k * 1024); } while (0)
#define PG8_MMA(ai, bj, At, Bt) do { __builtin_amdgcn_s_setprio(1); _Pragma("unroll") for (int m = 0; m < 4; ++m) _Pragma("unroll") for (int n = 0; n < 2; ++n) _Pragma("unroll") for (int k = 0; k < 2; ++k) \
        acc[ai][bj][m][n] = __builtin_amdgcn_mfma_f32_16x16x32_bf16(Bt[n][k], At[m][k], acc[ai][bj][m][n], 0, 0, 0); __builtin_amdgcn_s_setprio(0); } while (0)
#define PG8_WAIT_V(n) asm volatile("s_waitcnt vmcnt(" #n ")" ::: "memory")
#define PG8_WAIT_L(n) asm volatile("s_waitcnt lgkmcnt(" #n ")" ::: "memory")
#define PG8_BAR __builtin_amdgcn_s_barrier()
#define PG8_SCHED __builtin_amdgcn_sched_barrier(0)
#define PG8_GFILL(u, o) do { _Pragma("unroll") for (int _h = 0; _h < 2; ++_h) _Pragma("unroll") for (int _i = 0; _i < 2; ++_i) (o)[_h][_i] = S.a_off(u, _h * HALF + Rg[_i]) + voffA[_i]; } while (0)
    Unit cur, nxt; int ui = 0;
    if (!S.next(0, cur)) return;
    f32x4 acc[2][2][4][2];
#pragma unroll
    for (int a = 0; a < 2; ++a)
#pragma unroll
        for (int b = 0; b < 2; ++b)
#pragma unroll
            for (int m = 0; m < 4; ++m)
#pragma unroll
                for (int n = 0; n < 2; ++n) acc[a][b][m][n] = (f32x4){0.f, 0.f, 0.f, 0.f};
    bf16x8 At[4][2], B0[2][2], B1[2][2];
    unsigned gc[2][2] = {{0u, 0u}, {0u, 0u}}, gn[2][2] = {{0u, 0u}, {0u, 0u}};
    if constexpr (GATHER) PG8_GFILL(cur, gc);
    if constexpr (KS) nt = cur.nkt;
    const char* const gA = (const char*)g.A;
    const char* cA = GATHER ? gA : gA + (size_t)cur.pm * tstepA + (KS ? (size_t)cur.kt0 * kstep : 0); const char* cB = (const char*)g.Bt + (size_t)cur.pn * tstep + (KS ? (size_t)cur.kt0 * kstep : 0);
    PG8_STAGE(PG8_SB(0, 0), cB, voffB); PG8_STAGE(PG8_SB(0, 1), cB + hstep, voffB); PG8_STA(PG8_SA(0, 0), cA, gA, 0, gc); PG8_STA(PG8_SA(0, 1), cA, gA, 1, gc);
    if (wr == 1) PG8_BAR;
    PG8_WAIT_V(2); PG8_BAR;
    PG8_STAGE(PG8_SB(1, 0), cB + kstep, voffB); PG8_STA(PG8_SA(1, 0), cA + kstep, gA + kstep, 0, gc); PG8_STAGE(PG8_SB(1, 1), cB + hstep + kstep, voffB);
    PG8_WAIT_V(6); PG8_BAR;
    for (;;) {
        const bool has_next = S.next(ui + 1, nxt);
        if constexpr (GATHER) { if (has_next) PG8_GFILL(nxt, gn); else {
#pragma unroll
            for (int h = 0; h < 2; ++h)
#pragma unroll
                for (int i = 0; i < 2; ++i) gn[h][i] = gc[h][i]; } }
        const char* nA = (has_next && !GATHER) ? gA + (size_t)nxt.pm * tstepA + (KS ? (size_t)nxt.kt0 * kstep : 0) : cA; const char* nB = has_next ? (const char*)g.Bt + (size_t)nxt.pn * tstep + (KS ? (size_t)nxt.kt0 * kstep : 0) : cB;
        for (int t = 0; t < nt; t += 2) {
            const bool last = (t == nt - 2);
            const char* a1 = cA + (size_t)(t + 1) * kstep;
            const char* a2 = last ? nA : cA + (size_t)(t + 2) * kstep; const char* b2 = last ? nB : cB + (size_t)(t + 2) * kstep;
            const char* a3 = a2 + kstep; const char* b3 = b2 + kstep;
            unsigned gs[2][2];
#pragma unroll
            for (int h = 0; h < 2; ++h)
#pragma unroll
                for (int i = 0; i < 2; ++i) gs[h][i] = last ? gn[h][i] : gc[h][i];
            PG8_LDB(B0, 0, 0); PG8_LDB(B1, 0, 1); PG8_SCHED; PG8_LDA(At, 0, 0); PG8_STA(PG8_SA(1, 1), a1, a1, 1, gc);
            PG8_WAIT_V(8); PG8_WAIT_L(0); PG8_BAR; PG8_MMA(0, 0, At, B0); PG8_MMA(0, 1, At, B1); PG8_BAR; PG8_SCHED;
            PG8_LDA(At, 0, 1); PG8_STAGE(PG8_SB(0, 0), b2, voffB); PG8_STAGE(PG8_SB(0, 1), b2 + hstep, voffB); PG8_STA(PG8_SA(0, 0), a2, a2, 0, gs);
            PG8_WAIT_V(8); PG8_WAIT_L(0); PG8_BAR; PG8_MMA(1, 0, At, B0); PG8_MMA(1, 1, At, B1); PG8_BAR; PG8_SCHED;
            PG8_LDB(B0, 1, 0); PG8_LDB(B1, 1, 1); PG8_SCHED; PG8_LDA(At, 1, 0); PG8_STA(PG8_SA(0, 1), a2, a2, 1, gs);
            PG8_WAIT_V(8); PG8_WAIT_L(0); PG8_BAR; PG8_MMA(0, 0, At, B0); PG8_MMA(0, 1, At, B1); PG8_BAR; PG8_SCHED;
            PG8_LDA(At, 1, 1); PG8_STAGE(PG8_SB(1, 0), b3, voffB); PG8_STAGE(PG8_SB(1, 1), b3 + hstep, voffB); PG8_STA(PG8_SA(1, 0), a3, a3, 0, gs);
            PG8_WAIT_V(8); PG8_WAIT_L(0); PG8_BAR; PG8_MMA(1, 0, At, B0); PG8_MMA(1, 1, At, B1); PG8_BAR; PG8_SCHED;
        }
        if (wr == 0) PG8_BAR;
        E(acc, cur, wr, wc, fr, fq, lane, xlds);
        if (!has_next) break;
#pragma unroll
        for (int a = 0; a < 2; ++a)
#pragma unroll
            for (int b = 0; b < 2; ++b)
#pragma unroll
                for (int m = 0; m < 4; ++m)
#pragma unroll
                    for (int n = 0; n < 2; ++n) acc[a][b][m][n] = (f32x4){0.f, 0.f, 0.f, 0.f};
        cur = nxt; cA = nA; cB = nB; ++ui; if constexpr (KS) nt = cur.nkt;
#pragma unroll
        for (int h = 0; h < 2; ++h)
#pragma unroll
            for (int i = 0; i < 2; ++i) gc[h][i] = gn[h][i];
        if (wr == 1) PG8_BAR;
    }
    PG8_WAIT_V(0);
    PG8_BAR;
#undef PG8_SA
#undef PG8_SB
#undef PG8_STAGE
#undef PG8_STA
#undef PG8_LDA
#undef PG8_LDB
#undef PG8_MMA
#undef PG8_WAIT_V
#undef PG8_WAIT_L
#undef PG8_BAR
#undef PG8_SCHED
#undef PG8_GFILL
}
}
namespace att {
#define ALAS __attribute__((address_space(3)))
typedef unsigned short bf16_t;
typedef short bf16x8 __attribute__((ext_vector_type(8)));
typedef short s16x4 __attribute__((ext_vector_type(4)));
typedef float f32x16 __attribute__((ext_vector_type(16)));
typedef float f32x4 __attribute__((ext_vector_type(4)));
typedef unsigned u32x4 __attribute__((ext_vector_type(4)));
typedef ALAS char* lptr;
constexpr int NW = 8, QBLK = 32, KVBLK = 64, QB = NW * QBLK;
constexpr int SHM_V = KVBLK * 128 * 2;
constexpr int TBL_U0 = 2400, TBL_N = 2688;
constexpr float THR = 8.f;

template <int DQK_, int QP_, int KP_, int VP_, int OP_, bool TBL_, int LP_ = 0, int JMIN_ = 0> struct Cfg {
    static constexpr int DQK = DQK_, QP = QP_, KP = KP_, VP = VP_, OP = OP_, LP = LP_, JMIN = JMIN_; static constexpr bool TBL = TBL_;
    static constexpr int ND = DQK / 16, NKC = DQK / 64, KROW = DQK * 2, SHM_K = KVBLK * DQK * 2;
    static constexpr float SCALE = (DQK == 128) ? 0.08838834764831845f : 0.07216878364870323f;
    static constexpr int OFF_K = 0, OFF_V = 2 * SHM_K, OFF_WS = 2 * SHM_V + 2 * SHM_K;
    static constexpr int OFF_TBL = OFF_WS + NW * 64 * 4, OFF_QR = OFF_TBL + (TBL ? TBL_N * 4 : 0), LDS_BYTES = OFF_QR + (DQK > 128 ? NW * 4096 : 0);
    static_assert(LDS_BYTES <= 131072, "attention LDS");
};

#define SBAR() __builtin_amdgcn_sched_barrier(0)
__device__ __forceinline__ int v_st(int k, int c) { const int kk = (k & ~0xC) | ((k & 4) << 1) | ((k & 8) >> 1); return ((kk >> 3) * 4 + (c >> 5)) * 512 + ((kk & 7) * 32 + (c & 31)) * 2; }
__device__ __forceinline__ int v_rd_base(int lane) { return ((lane & 3) << 3) | (((lane >> 2) & 3) << 6) | (((lane >> 4) & 1) << 5) | (((lane >> 5) & 1) << 8); }
constexpr int v_rd_off(int d0, int ks, int half) { return d0 * 512 + ks * 4096 + half * 2048; }
__device__ __forceinline__ int crow(int r, int hi) { return (r & 3) + 8 * (r >> 2) + 4 * hi; }
__device__ __forceinline__ unsigned cvtpk(float lo, float hi) { unsigned r; asm volatile("v_cvt_pk_bf16_f32 %0, %1, %2" : "=v"(r) : "v"(lo), "v"(hi)); return r; }
__device__ __forceinline__ bf16x8 ld8(const bf16_t* p) { return *reinterpret_cast<const bf16x8*>(p); }
__device__ __forceinline__ bf16x8 ld8u(const bf16_t* ubase, unsigned boff) { return *reinterpret_cast<const bf16x8*>((const char*)ubase + boff); }

__device__ __forceinline__ void mask_tile(f32x16& p0, f32x16& p1, int dq) {
    const float NEG = -__builtin_inff();
#pragma unroll
    for (int r = 0; r < 16; ++r) {
        const int c = (r & 3) + 8 * (r >> 2);
        if (dq - c < 0) p0[r] = NEG;
        if (dq - c - 32 < 0) p1[r] = NEG;
    }
}
__device__ __forceinline__ void table_tile(f32x16& p0, f32x16& p1, const ALAS float* tb) {
#pragma unroll
    for (int r = 0; r < 16; ++r) {
        const int c = (r & 3) + 8 * (r >> 2);
        p0[r] += tb[c]; p1[r] += tb[c + 32];
    }
}
template <class C>
__device__ __forceinline__ void partialSM(f32x16& p0, f32x16& p1, float& m_reg, float& mn, float& alpha) {
    float pmax = p0[0];
#pragma unroll
    for (int r = 1; r < 16; ++r) pmax = fmaxf(pmax, p0[r]);
#pragma unroll
    for (int r = 0; r < 16; ++r) pmax = fmaxf(pmax, p1[r]);
    { auto rr = __builtin_amdgcn_permlane32_swap(__float_as_uint(pmax), __float_as_uint(pmax), false, false);
      pmax = fmaxf(__uint_as_float(rr[0]), __uint_as_float(rr[1])); }
    constexpr float C2 = 1.4426950408889634f * C::SCALE;
    if (__builtin_expect(__all((pmax - m_reg) * C::SCALE <= THR), 1)) { mn = m_reg; alpha = 1.f; }
    else { mn = fmaxf(m_reg, pmax); alpha = __builtin_amdgcn_exp2f((m_reg - mn) * C2); m_reg = mn; }
    const float mnL = -mn * C2;
#pragma unroll
    for (int r = 0; r < 16; ++r) p0[r] = fmaf(p0[r], C2, mnL);
#pragma unroll
    for (int r = 0; r < 16; ++r) p1[r] = fmaf(p1[r], C2, mnL);
#pragma unroll
    for (int r = 0; r < 16; ++r) p0[r] = __builtin_amdgcn_exp2f(p0[r]);
}
__device__ __forceinline__ void finishSM(f32x16& p0, f32x16& p1, float alpha, float& l_reg, bf16x8& pa0, bf16x8& pa1, bf16x8& pa2, bf16x8& pa3) {
#pragma unroll
    for (int r = 0; r < 16; ++r) p1[r] = __builtin_amdgcn_exp2f(p1[r]);
    float ps = 0;
#pragma unroll
    for (int r = 0; r < 16; ++r) ps += p0[r];
#pragma unroll
    for (int r = 0; r < 16; ++r) ps += p1[r];
    { auto rr = __builtin_amdgcn_permlane32_swap(__float_as_uint(ps), __float_as_uint(ps), false, false);
      ps = __uint_as_float(rr[0]) + __uint_as_float(rr[1]); }
    l_reg = l_reg * alpha + ps;
#define PK4(P, B_, OUT) do { unsigned a0 = cvtpk(P[B_+0], P[B_+1]), a1 = cvtpk(P[B_+2], P[B_+3]);                          \
        unsigned b0 = cvtpk(P[B_+4], P[B_+5]), b1 = cvtpk(P[B_+6], P[B_+7]);                                             \
        auto r0 = __builtin_amdgcn_permlane32_swap(a0, b0, false, false); auto r1 = __builtin_amdgcn_permlane32_swap(a1, b1, false, false); \
        u32x4 w = {r0[0], r1[0], r0[1], r1[1]}; OUT = *reinterpret_cast<bf16x8*>(&w); } while (0)
    PK4(p0, 0, pa0); PK4(p0, 8, pa1); PK4(p1, 0, pa2); PK4(p1, 8, pa3);
#undef PK4
}
template <class C, int KB>
__device__ __forceinline__ void qkt(f32x16& p0, f32x16& p1, lptr K_lds, int r32, int hi, const bf16x8* qr, lptr qlds) {
    p0 = f32x16{}; p1 = f32x16{};
    lptr kb[4];
#pragma unroll
    for (int dd = 0; dd < 4; ++dd) {
        const int sw = (C::DQK == 128) ? (r32 & 7) : ((r32 >> 1) & 7);
        kb[dd] = K_lds + KB * C::SHM_K + r32 * C::KROW + 16 * ((2 * dd + hi) ^ sw);
    }
#pragma unroll
    for (int d0 = 0; d0 < C::ND; ++d0) { lptr a = kb[d0 & 3] + (d0 >> 2) * 128;
        bf16x8 b0 = *reinterpret_cast<const ALAS bf16x8*>(a);
        bf16x8 b1 = *reinterpret_cast<const ALAS bf16x8*>(a + 32 * C::KROW);
        bf16x8 q; if (d0 < 8) q = qr[d0]; else q = *reinterpret_cast<const ALAS bf16x8*>(qlds + (d0 - 8) * 1024);
        p0 = __builtin_amdgcn_mfma_f32_32x32x16_bf16(b0, q, p0, 0, 0, 0);
        p1 = __builtin_amdgcn_mfma_f32_32x32x16_bf16(b1, q, p1, 0, 0, 0); }
}
template <int VB>
__device__ __forceinline__ void pv_tile(f32x16* o, int vb0, bf16x8 pa0, bf16x8 pa1, bf16x8 pa2, bf16x8 pa3) {
#define TRRD(dst, off) asm volatile("ds_read_b64_tr_b16 %0, %1 offset:%2" : "=&v"(dst) : "v"(vb0), "i"(off) : "memory")
#define PV_D0(d0) do { s16x4 l0, l1, l2, l3, h0, h1, h2, h3; constexpr int b_ = VB * SHM_V + v_rd_off(d0, 0, 0); \
        TRRD(l0, b_); TRRD(h0, b_ + 2048); TRRD(l1, b_ + 4096); TRRD(h1, b_ + 6144); TRRD(l2, b_ + 8192); TRRD(h2, b_ + 10240); TRRD(l3, b_ + 12288); TRRD(h3, b_ + 14336); \
        asm volatile("s_waitcnt lgkmcnt(0)" ::: "memory"); SBAR();   \
        o[d0] = __builtin_amdgcn_mfma_f32_32x32x16_bf16(pa0, (bf16x8){l0[0], l0[1], l0[2], l0[3], h0[0], h0[1], h0[2], h0[3]}, o[d0], 0, 0, 0);   \
        o[d0] = __builtin_amdgcn_mfma_f32_32x32x16_bf16(pa1, (bf16x8){l1[0], l1[1], l1[2], l1[3], h1[0], h1[1], h1[2], h1[3]}, o[d0], 0, 0, 0);   \
        o[d0] = __builtin_amdgcn_mfma_f32_32x32x16_bf16(pa2, (bf16x8){l2[0], l2[1], l2[2], l2[3], h2[0], h2[1], h2[2], h2[3]}, o[d0], 0, 0, 0);   \
        o[d0] = __builtin_amdgcn_mfma_f32_32x32x16_bf16(pa3, (bf16x8){l3[0], l3[1], l3[2], l3[3], h3[0], h3[1], h3[2], h3[3]}, o[d0], 0, 0, 0); } while (0)
    PV_D0(0); PV_D0(1); PV_D0(2); PV_D0(3);
#undef PV_D0
#undef TRRD
}

struct BlockRef { const bf16_t* Q; const bf16_t* K; const bf16_t* V; bf16_t* O; float* lse; int P0; };
template <class C> struct Seam { bf16x8 qr[C::ND]; bf16x8 st_v0, st_v1; bf16x8 st_k[C::NKC]; };
__device__ __forceinline__ int swa_jlo(int P0, int W) { const int lowk = P0 - W + 1; return lowk > 0 ? lowk / KVBLK : 0; }

#define VMW() asm volatile("s_waitcnt vmcnt(0)" ::: "memory")
#define VMWN(n) asm volatile("s_waitcnt vmcnt(%0)" :: "i"(n) : "memory")
#define SLOAD_H(Kp, Vp, k0) do { const bf16_t* vu_ = (Vp) + (size_t)(k0) * C::VP; const bf16_t* ku_ = (Kp) + (size_t)(k0) * C::KP;                        \
        S.st_v0 = ld8u(vu_, voffV); S.st_v1 = ld8u(vu_ + 32 * C::VP, voffV);     \
        if constexpr (C::DQK == 128) { S.st_k[0] = ld8u(ku_, voffK); S.st_k[1] = ld8u(ku_ + 32 * C::KP, voffK); } \
        else { _Pragma("unroll") for (int i_ = 0; i_ < 3; ++i_) S.st_k[i_] = ld8u(ku_ + 64 * i_, voffK); } } while (0)
#define SWRITE_HK(bf) do { if constexpr (C::DQK == 128) { *(ALAS bf16x8*)(K_lds + (bf) * C::SHM_K + kws) = S.st_k[0]; *(ALAS bf16x8*)(K_lds + (bf) * C::SHM_K + kws + 32 * 256) = S.st_k[1]; } \
        else { _Pragma("unroll") for (int i_ = 0; i_ < 3; ++i_) *(ALAS bf16x8*)(K_lds + (bf) * C::SHM_K + kws + 128 * i_) = S.st_k[i_]; } } while (0)
#define SWRITE_HV(bf) do { *(ALAS bf16x8*)(V_lds + (bf) * SHM_V + vst0) = S.st_v0; *(ALAS bf16x8*)(V_lds + (bf) * SHM_V + vst1) = S.st_v1; } while (0)
#define SWRITE_H(bf) do { SWRITE_HV(bf); SWRITE_HK(bf); } while (0)
#define ATT_IDX() int lane_; asm volatile("v_mbcnt_lo_u32_b32 %0, -1, 0\n\tv_mbcnt_hi_u32_b32 %0, -1, %0" : "=v"(lane_)); const int lane = lane_, tid = wid * 64 + lane, r32 = lane & 31, hi = lane >> 5; \
    const int sr = tid >> 4, sc = (tid & 15) * 8, kr = tid >> 3, kc = (tid & 7) * 8; \
    const int kws = (C::DQK == 128) ? (sr * 256 + ((sc * 2) ^ ((sr & 7) << 4))) : (kr * 384 + 16 * ((tid & 7) ^ ((kr >> 1) & 7))); \
    const unsigned voffV = (unsigned)(sr * C::VP + sc) * 2u, voffK = (C::DQK == 128) ? (unsigned)(sr * C::KP + sc) * 2u : (unsigned)(kr * C::KP + kc) * 2u, voffQ = (unsigned)((wid * QBLK + r32) * C::QP + hi * 8) * 2u; \
    (void)wid; (void)lane; (void)r32; (void)hi; (void)kr; (void)kc; (void)sr; (void)sc; (void)kws; (void)voffV; (void)voffK; (void)voffQ

template <class C>
__device__ __forceinline__ void prime(const BlockRef& cur, int W, lptr lds, Seam<C>& S, const int wid) {
    ATT_IDX(); lptr K_lds = lds + C::OFF_K;
    const int kb0 = swa_jlo(cur.P0, W) * KVBLK;
#pragma unroll
    for (int d0 = 0; d0 < C::ND; ++d0) S.qr[d0] = ld8u(cur.Q + d0 * 16, voffQ);
    SLOAD_H(cur.K, cur.V, kb0); VMW(); SWRITE_HK(0);
    __syncthreads();
}
template <class C>
__device__ __forceinline__ void block(const BlockRef& cur, const BlockRef& nxt, int skv, int W, lptr lds, Seam<C>& S, const int wid) {
    ATT_IDX();
    const int j_lo = swa_jlo(cur.P0, W);
    int j_hi = (cur.P0 + QB - 1 - C::JMIN) / KVBLK + 1; if (j_hi > skv / KVBLK) j_hi = skv / KVBLK;
    const int NT = j_hi - j_lo;
    const int kbn = swa_jlo(nxt.P0, W) * KVBLK;
    const int qlo = cur.P0 + wid * QBLK, qm = qlo + r32 - 4 * hi;
    lptr V_lds = lds + C::OFF_V; lptr K_lds = lds + C::OFF_K;
    ALAS float* ws = (ALAS float*)(lds + C::OFF_WS) + wid * 64; ALAS float* li_l = ws; ALAS float* al_l = ws + 32;
    const ALAS float* tbl = (const ALAS float*)(lds + C::OFF_TBL);
    float m_reg = -1e30f, l_reg = 0; f32x16 o[4] = {};
    const int vst0 = v_st(sr, sc), vst1 = v_st(32 + sr, sc);
    const int vb0 = (int)(unsigned)(uintptr_t)V_lds + v_rd_base(lane);
    const bf16_t* Kh = cur.K; const bf16_t* Vh = cur.V;
#define RESC(a) do { if (__any((a) < 1.f)) { if (hi == 0) al_l[r32] = (a); asm volatile("s_waitcnt lgkmcnt(0)" ::: "memory");              \
                     _Pragma("unroll") for (int d_ = 0; d_ < 4; ++d_) _Pragma("unroll") for (int r = 0; r < 16; ++r) o[d_][r] *= al_l[crow(r, hi)]; } } while (0)
#define KBASE(t) ((j_lo + (t)) * KVBLK)
#define MASKT(P0_, P1_, t) do { const int kb_ = KBASE(t); if constexpr (C::TBL) { table_tile(P0_, P1_, tbl + (TBL_U0 - (qm - kb_))); } \
                                else { if (kb_ + KVBLK - 1 > qlo) mask_tile(P0_, P1_, qm - kb_); } } while (0)
#define SEAM_K0() do { VMWN(C::ND); SWRITE_HK(0); SBAR(); } while (0)
    f32x16 pA0, pA1, pB0, pB1; float mnA, mnB, alA, alB; bf16x8 pa0, pa1, pa2, pa3;
    lptr qlds = lds + C::OFF_QR + wid * 4096 + lane * 16;
    if constexpr (C::DQK > 128) {
#pragma unroll
        for (int d0 = 8; d0 < C::ND; ++d0) *reinterpret_cast<ALAS bf16x8*>(qlds + (d0 - 8) * 1024) = S.qr[d0]; }
    SWRITE_HV(0); SBAR();
    if (NT > 1) { SLOAD_H(Kh, Vh, KBASE(1)); }
    SBAR(); qkt<C, 0>(pA0, pA1, K_lds, r32, hi, S.qr, qlds);
    MASKT(pA0, pA1, 0); partialSM<C>(pA0, pA1, m_reg, mnA, alA);
    if (NT > 1) { VMW(); SWRITE_H(1); }
    __syncthreads();
#define HALF_STEP(PX0, PX1, mnX, alX, PY0, PY1, alY, t, KB, VB, SB) do {                                                      \
        SBAR(); qkt<C, KB>(PX0, PX1, K_lds, r32, hi, S.qr, qlds);                                                                   \
        finishSM(PY0, PY1, alY, l_reg, pa0, pa1, pa2, pa3); SBAR();                                                           \
        if ((t) + 1 < NT) { SLOAD_H(Kh, Vh, KBASE((t) + 1)); SBAR(); }                                                        \
        pv_tile<VB>(o, vb0, pa0, pa1, pa2, pa3); MASKT(PX0, PX1, (t)); partialSM<C>(PX0, PX1, m_reg, mnX, alX);               \
        __syncthreads();                                                                                                      \
        if ((t) + 1 < NT) { VMW(); SWRITE_H(SB); }                                                                            \
        RESC(alX); __syncthreads(); } while (0)
    for (int t = 1; t + 1 < NT; t += 2) {
        HALF_STEP(pB0, pB1, mnB, alB, pA0, pA1, alA, t, 1, 0, 0);
        HALF_STEP(pA0, pA1, mnA, alA, pB0, pB1, alB, t + 1, 0, 1, 1);
    }
    {
    int lane2_; asm volatile("v_mbcnt_lo_u32_b32 %0, -1, 0\n\tv_mbcnt_hi_u32_b32 %0, -1, %0" : "=v"(lane2_));
    const int lane = lane2_, r32 = lane & 31, hi = lane >> 5, qm = qlo + r32 - 4 * hi;
    const unsigned voffQ = (unsigned)((wid * QBLK + r32) * C::QP + hi * 8) * 2u;
    lptr qlds = lds + C::OFF_QR + wid * 4096 + lane * 16; (void)qlds; (void)qm;
    const bool even = (NT & 1) == 0;
    if (even) { SBAR(); qkt<C, 1>(pB0, pB1, K_lds, r32, hi, S.qr, qlds); SBAR(); }
    SLOAD_H(nxt.K, nxt.V, kbn); SBAR();
#pragma unroll
    for (int d0 = 0; d0 < C::ND; ++d0) S.qr[d0] = ld8u(nxt.Q + d0 * 16, voffQ);
    SBAR();
    finishSM(pA0, pA1, alA, l_reg, pa0, pa1, pa2, pa3); SBAR();
    pv_tile<0>(o, vb0, pa0, pa1, pa2, pa3);
    if (even) { MASKT(pB0, pB1, NT - 1); partialSM<C>(pB0, pB1, m_reg, mnB, alB); __syncthreads(); RESC(alB);
        finishSM(pB0, pB1, alB, l_reg, pa0, pa1, pa2, pa3); SBAR(); pv_tile<1>(o, vb0, pa0, pa1, pa2, pa3); }
    SBAR(); SEAM_K0();
    if (hi == 0) li_l[r32] = l_reg; asm volatile("s_waitcnt lgkmcnt(0)" ::: "memory");
    float rli[16];
#pragma unroll
    for (int r = 0; r < 16; ++r) { const float lv = li_l[crow(r, hi)]; rli[r] = lv > 0.f ? __builtin_amdgcn_rcpf(lv) : 0.f; }
    if constexpr (C::LP > 0) { if (hi == 0) cur.lse[(size_t)(wid * QBLK + r32) * C::LP] = l_reg > 0.f ? m_reg * C::SCALE + __logf(l_reg) : -__builtin_inff(); }
    char* const Ou = (char*)cur.O;
    const unsigned ooff = (unsigned)((wid * QBLK + 4 * hi) * C::OP + r32) * 2u;
#pragma unroll
    for (int r = 0; r < 16; ++r) { const int orow = (r & 3) + 8 * (r >> 2);
#pragma unroll
        for (int d0 = 0; d0 < 4; ++d0) { const float v = o[d0][r] * rli[r];
            const float vn = __builtin_bit_cast(float, __builtin_amdgcn_mov_dpp(__builtin_bit_cast(int, v), 0xB1, 0xF, 0xF, true));
            if ((r32 & 1) == 0) *(unsigned*)(Ou + ooff + (unsigned)(orow * C::OP + d0 * 32) * 2u) = cvtpk(v, vn); } }
    }
    __syncthreads();
#undef RESC
#undef KBASE
#undef MASKT
#undef SEAM_K0
#undef HALF_STEP
}
#undef VMW
#undef VMWN
#undef SLOAD_H
#undef SWRITE_HK
#undef SWRITE_HV
#undef SWRITE_H
#undef ATT_IDX
#undef SBAR
}
constexpr int NWAVES = 8;
constexpr int S_ = 16384, DM = 2048, NLAYER = 2;
constexpr int WA = 1024, QLORA = 512, KVLORA = 256, ROPE = 64, INC = 3904, INP = 4096;
constexpr int C_QA = 0, C_KA = 1024, C_VA = 2048, C_CQ = 3072, C_CKV = 3584, C_KR = 3840;
constexpr int NH = 8, HD = 128, QKB = 192, NQB_ = 1536  , NKVB = 2048  ;
constexpr int FF = 5632, NEXP = 8, NGU = 2 * FF  , NT_GU = NGU / 256  , NT_D = DM / 256  ;
constexpr int MT_MAX = 136;
constexpr float EPS = 1e-6f;
constexpr int W_DIL = 2049;
constexpr int W_CAUSAL = 0x40000000;

constexpr size_t MiB = 1u << 20;
constexpr size_t WS_CTL = 0, CTL_ZERO_BYTES = 1 * MiB;
constexpr size_t WS_TBL = 1 * MiB;
constexpr size_t WS_POS = 1 * MiB + 512 * 1024;
constexpr size_t WS_LTOK = 2 * MiB;
constexpr size_t WS_LGATE = 2 * MiB + 512 * 1024;
constexpr size_t WS_SSQ0 = 3 * MiB;
constexpr size_t WS_SSQX = WS_SSQ0 + 64 * 1024;
constexpr size_t WS_SSQC = WS_SSQX + 1 * MiB;
static_assert(WS_SSQC + 256 * 1024 <= 6 * MiB, "ws map");
constexpr size_t WS_WIN = 6 * MiB;
constexpr size_t WS_WQB = WS_WIN + 32 * MiB;
constexpr size_t WS_WKVB = WS_WQB + 3 * MiB;
constexpr size_t WS_WOUT = WS_WKVB + 2 * MiB;
constexpr size_t WS_WGU = WS_WOUT + 16 * MiB;
constexpr size_t WS_WD = WS_WGU + 44 * MiB;
constexpr size_t WS_WGUE = WS_WD + 22 * MiB;
constexpr size_t WS_WDE = WS_WGUE + 352 * MiB;
constexpr size_t WS_H = WS_WDE + 176 * MiB;
constexpr size_t WS_ACTS = WS_H + 64 * MiB;
constexpr size_t WS_PROJ = WS_ACTS;
constexpr size_t WS_QM = WS_PROJ + 128 * MiB;
constexpr size_t WS_KVM = WS_QM + 48 * MiB;
constexpr size_t WS_KM = WS_KVM + 64 * MiB;
constexpr size_t WS_CQN = WS_KM + 48 * MiB;
constexpr size_t WS_CKVN = WS_CQN + 16 * MiB;
constexpr size_t WS_ATT = WS_CKVN + 8 * MiB;
constexpr size_t WS_OA = WS_ATT + 64 * MiB, WS_OB = WS_OA + 32 * MiB;
constexpr size_t WS_LSEA = WS_OB + 32 * MiB, WS_LSEB = WS_LSEA + 1 * MiB;
constexpr size_t WS_ACT = WS_ACTS;
constexpr size_t WS_Y = WS_ACT + 374 * MiB;
constexpr size_t WS_PT = WS_Y + 136 * MiB;
constexpr size_t WS_END = WS_PT + 32 * MiB;
static_assert(WS_LSEB + 1 * MiB <= WS_END, "ws map");
static_assert((size_t)MT_MAX * 256 * FF * 2 <= 374 * MiB && (size_t)MT_MAX * 256 * DM * 2 <= 136 * MiB, "ws map");
constexpr int CW_TMO = 0, CW_CODE = 1;
constexpr int CW_CNT = 64;
constexpr int CW_BAR = 4096;

constexpr int RING_OFF = 0, RING_BYTES = 131072;
constexpr int LDSCTL_OFF = RING_BYTES, MISC_OFF = LDSCTL_OFF + 320, XLDS_OFF = RING_BYTES + 1024;
constexpr int LDS_BYTES = 147456;
static_assert(MISC_OFF + 128 <= XLDS_OFF && XLDS_OFF + 8192 <= LDS_BYTES, "LDS map");

#define GAS __attribute__((address_space(1)))
#define LAS __attribute__((address_space(3)))
typedef unsigned short bf16;
typedef unsigned v4u __attribute__((ext_vector_type(4)));
typedef unsigned v2u __attribute__((ext_vector_type(2)));
typedef float f32x4 __attribute__((ext_vector_type(4)));
typedef GAS unsigned gu32;
#define RLX_AGENT __ATOMIC_RELAXED, __HIP_MEMORY_SCOPE_AGENT
#define LDS_WAIT() asm volatile("s_waitcnt lgkmcnt(0)" ::: "memory")
#define VM_WAIT() asm volatile("s_waitcnt vmcnt(0)" ::: "memory")
__device__ __forceinline__ unsigned f2bf(float f) { unsigned u = __builtin_bit_cast(unsigned, f); return (u + 0x7fffu + ((u >> 16) & 1u)) >> 16; }
__device__ __forceinline__ unsigned pk2(float lo, float hi) { return f2bf(lo) | (f2bf(hi) << 16); }
__device__ __forceinline__ float bflo(unsigned w) { return __builtin_bit_cast(float, w << 16); }
__device__ __forceinline__ float bfhi(unsigned w) { return __builtin_bit_cast(float, w & 0xffff0000u); }

#define XB_TMO      128
#define XB_XCNT(j)  (256  + 64 * (j))
#define XB_XSUB(j)  (1280 + 64 * (j))
#define XB_XGEN(j)  (2304 + 64 * (j))
#define XB_TOP      3328
#define XB_TOPGEN   3392
#define XCD_BAR_WORDS 3456
#define XB_SPIN_CAP (1u << 20)

__device__ __forceinline__ unsigned xb_ld(gu32* p)              { return __hip_atomic_load(p, __ATOMIC_RELAXED, __HIP_MEMORY_SCOPE_AGENT); }
__device__ __forceinline__ unsigned xb_add(gu32* p, unsigned v) { return __hip_atomic_fetch_add(p, v, __ATOMIC_RELAXED, __HIP_MEMORY_SCOPE_AGENT); }
__device__ __forceinline__ unsigned xb_xcc_id() { return (unsigned)__builtin_amdgcn_s_getreg((3 << 11) | 20) & 0xFu; }
#define XB_SPIN(cond, bar) do { unsigned _sp = 0; while (cond) { __builtin_amdgcn_s_sleep(1); \
    if ((++_sp & 255u) == 0u) { if (xb_ld(&(bar)[XB_TMO])) break; if (_sp > XB_SPIN_CAP) { xb_add(&(bar)[XB_TMO], 1u); break; } } } } while (0)

struct XcdBarrier {
    gu32* bar; unsigned x;
    volatile LAS unsigned* st;
};
__device__ __forceinline__ XcdBarrier xcd_barrier_post(gu32* bar, volatile LAS unsigned* st) {
    XcdBarrier b; b.bar = bar; b.x = xb_xcc_id(); b.st = st;
    if (threadIdx.x == 0) (void)xb_add(&bar[XB_XCNT(b.x)], 1u);
    return b;
}
__device__ __forceinline__ void xcd_barrier_complete(gu32* bar, unsigned x, unsigned& nloc, unsigned& nx) {
    const unsigned G = gridDim.x * gridDim.y * gridDim.z;
    unsigned sum, cnt, mine, sp = 0u;
    for (;;) {
        sum = 0u; cnt = 0u; mine = 0u;
#pragma unroll
        for (unsigned j = 0; j < 16; ++j) { const unsigned c = xb_ld(&bar[XB_XCNT(j)]); sum += c; cnt += (c > 0u) ? 1u : 0u; mine = (j == x) ? c : mine; }
        if (sum == G) break;
        __builtin_amdgcn_s_sleep(1);
        if ((++sp & 255u) == 0u) { if (xb_ld(&bar[XB_TMO])) break; if (sp > XB_SPIN_CAP) { xb_add(&bar[XB_TMO], 1u); break; } }
    }
    nloc = mine > 0u ? mine : 1u; nx = cnt > 0u ? cnt : 1u;
}
__device__ __forceinline__ void xcd_barrier(const XcdBarrier& b) {
    asm volatile("s_waitcnt vmcnt(0)" ::: "memory");
    __syncthreads();
    if (threadIdx.x == 0) {
        gu32* bar = b.bar;
        __builtin_amdgcn_s_waitcnt(0);
        unsigned nloc = b.st[0], nx = b.st[1];
        if (nloc == 0u) { xcd_barrier_complete(bar, b.x, nloc, nx); b.st[0] = nloc; b.st[1] = nx; }
        const unsigned old = xb_add(&bar[XB_XSUB(b.x)], 1u);
        const unsigned gen = old / nloc;
        if (old + 1u == (gen + 1u) * nloc) {
            __builtin_amdgcn_fence(__ATOMIC_RELEASE, "agent");
            asm volatile("s_waitcnt vmcnt(0)" ::: "memory");
            const unsigned og = xb_add(&bar[XB_TOP], 1u);
            const unsigned tg = og / nx;
            if (og + 1u == (tg + 1u) * nx) xb_add(&bar[XB_TOPGEN], 1u);
            else XB_SPIN(xb_ld(&bar[XB_TOPGEN]) == tg, bar);
            __builtin_amdgcn_fence(__ATOMIC_ACQUIRE, "agent");
            xb_add(&bar[XB_XGEN(b.x)], 1u);
            asm volatile("s_waitcnt vmcnt(0)" ::: "memory");
        } else {
            XB_SPIN(xb_ld(&bar[XB_XGEN(b.x)]) == gen, bar);
            __builtin_amdgcn_fence(__ATOMIC_ACQUIRE, "agent");
            asm volatile("s_waitcnt vmcnt(0)" ::: "memory");
        }
    }
    __syncthreads();
}

struct Args { const void* in[22]; float* out; unsigned char* ws; int ph_lo, ph_hi, use_bar, pad; };
struct ArgsD { const GAS void* in[22]; GAS float* out; GAS unsigned char* ws; int ph_lo, ph_hi, use_bar, pad; };
static_assert(sizeof(ArgsD) == sizeof(Args), "ArgsD");
typedef const __attribute__((address_space(4))) ArgsD* KArgs;
__device__ __forceinline__ KArgs kargs() { KArgs p = (KArgs)__builtin_amdgcn_kernarg_segment_ptr(); asm volatile("" : "+s"(p)); return p; }
struct Frame {
    LAS unsigned char* lds;
    int vcu, G, wave;
};
#define PH_IDX() int lane_; asm volatile("v_mbcnt_lo_u32_b32 %0, -1, 0\n\tv_mbcnt_hi_u32_b32 %0, -1, %0" : "=v"(lane_)); const int lane = lane_, wave = F.wave, tid = wave * 64 + lane; (void)tid; (void)lane; (void)wave
__device__ __forceinline__ float shx(float v, int lane, int o) { return __builtin_bit_cast(float, __builtin_amdgcn_ds_bpermute((lane ^ o) << 2, __builtin_bit_cast(int, v))); }
__device__ __forceinline__ float wave_sum(float v, int lane) {
#pragma unroll
    for (int o = 1; o < 64; o <<= 1) v += shx(v, lane, o);
    return v;
}

template <bool GAIN>
__device__ __forceinline__ void xpose_item(const float* W, int K, int N, bf16* WT, int k0, int n0, int drow0, LAS float* scr, int lane, const float* gk) {
    float gl = 1.0f, gh = 1.0f; if constexpr (GAIN) { gl = gk[k0 + (lane & 31)]; gh = gk[k0 + 32 + (lane & 31)]; }
    float w[32];
    const GAS float* src = (const GAS float*)W + (size_t)(k0 + (lane >> 5)) * N + n0 + (lane & 31);
#pragma unroll
    for (int i = 0; i < 32; ++i) w[i] = __builtin_nontemporal_load(src + (size_t)(2 * i) * N);
#pragma unroll
    for (int i = 0; i < 32; ++i) { const int kk = 2 * i + (lane >> 5); float v = w[i];
        if constexpr (GAIN) { const float gsel = (i >= 16) ? gh : gl; v *= __builtin_bit_cast(float, __builtin_amdgcn_ds_bpermute((kk & 31) << 2, __builtin_bit_cast(int, gsel))); }
        scr[kk * 33 + (lane & 31)] = v; }
    LDS_WAIT(); asm volatile("" ::: "memory");
    const int c = lane & 7;
#pragma unroll
    for (int j = 0; j < 4; ++j) { const int n = (lane >> 3) + 8 * j; const LAS float* s = scr + (8 * c) * 33 + n;
        v4u o; o.x = pk2(s[0 * 33], s[1 * 33]); o.y = pk2(s[2 * 33], s[3 * 33]); o.z = pk2(s[4 * 33], s[5 * 33]); o.w = pk2(s[6 * 33], s[7 * 33]);
        __builtin_nontemporal_store(o, (GAS v4u*)(WT + (size_t)(drow0 + n) * K + k0 + 8 * c)); }
    LDS_WAIT(); asm volatile("" ::: "memory");
}
constexpr int IT_WIN1 = 32 * 122, IT_WQB1 = 8 * 48, IT_WKVB1 = 4 * 64, IT_WOUT1 = 32 * 64, IT_GU1 = 32 * 176, IT_D1 = 88 * 64;
constexpr int IT_EARLY = IT_WIN1 + IT_WQB1 + IT_WKVB1;
constexpr int IT_LATE = IT_WIN1 + IT_WQB1 + IT_WKVB1 + 2 * IT_WOUT1 + 2 * IT_GU1 + IT_D1 + 16 * IT_GU1 + 8 * IT_D1, IT_TOTAL = IT_EARLY + IT_LATE;
static_assert(IT_LATE % 2 == 0, "late items split in two halves");
__device__ __forceinline__ void conv_item(KArgs a, int it, LAS float* scr, int lane) {
    unsigned char* ws = (unsigned char*)a->ws;
    const float* W; bf16* WT; int K, N, kb, nb, drow0; const float* gk = nullptr;
    int l = 0; if (it >= IT_EARLY) { it -= IT_EARLY; l = 1; }
    if (it < IT_WIN1) { const int r = it; kb = r / 122; nb = r % 122; K = DM; N = INC; W = (const float*)a->in[4] + (size_t)l * DM * INC; WT = (bf16*)(ws + WS_WIN) + (size_t)l * INP * DM; drow0 = 32 * nb; gk = (const float*)a->in[3] + l * DM; }
    else if ((it -= IT_WIN1) < IT_WQB1) { const int r = it; kb = r / 48; nb = r % 48; K = QLORA; N = NQB_; W = (const float*)a->in[7] + (size_t)l * QLORA * NQB_; WT = (bf16*)(ws + WS_WQB) + (size_t)l * NQB_ * QLORA; drow0 = 32 * nb; gk = (const float*)a->in[5] + l * QLORA; }
    else if ((it -= IT_WQB1) < IT_WKVB1) { const int r = it; kb = r / 64; nb = r % 64; K = KVLORA; N = NKVB; W = (const float*)a->in[8] + (size_t)l * KVLORA * NKVB; WT = (bf16*)(ws + WS_WKVB) + (size_t)l * NKVB * KVLORA; drow0 = 32 * nb; }
    else if ((it -= IT_WKVB1) < IT_WOUT1) { const int r = it; kb = r / 64; nb = r % 64; K = DM; N = DM; W = (const float*)a->in[13] + (size_t)DM * DM; WT = (bf16*)(ws + WS_WOUT) + (size_t)DM * DM; drow0 = 32 * nb; }
    else if ((it -= IT_WOUT1) < 16 * IT_GU1) { const int m = it / IT_GU1, r = it % IT_GU1; kb = r / 176; nb = r % 176; const int isup = m >> 3, e = m & 7; K = DM; N = FF;
        W = (isup ? (const float*)a->in[20] : (const float*)a->in[19]) + (size_t)e * DM * FF; WT = (bf16*)(ws + WS_WGUE) + (size_t)e * NGU * DM;
        const int n0 = 32 * nb; drow0 = 256 * (n0 >> 7) + (n0 & 127) + (isup ? 128 : 0); }
    else if ((it -= 16 * IT_GU1) < 8 * IT_D1) { const int e = it / IT_D1, r = it % IT_D1; kb = r / 64; nb = r % 64; K = FF; N = DM;
        W = (const float*)a->in[21] + (size_t)e * FF * DM; WT = (bf16*)(ws + WS_WDE) + (size_t)e * DM * FF; drow0 = 32 * nb; }
    else if ((it -= 8 * IT_D1) < IT_WOUT1) { const int r = it; kb = r / 64; nb = r % 64; K = DM; N = DM; W = (const float*)a->in[13]; WT = (bf16*)(ws + WS_WOUT); drow0 = 32 * nb; }
    else if ((it -= IT_WOUT1) < 2 * IT_GU1) { const int isup = it / IT_GU1, r = it % IT_GU1; kb = r / 176; nb = r % 176; K = DM; N = FF;
        W = isup ? (const float*)a->in[16] : (const float*)a->in[15]; WT = (bf16*)(ws + WS_WGU);
        const int n0 = 32 * nb; drow0 = 256 * (n0 >> 7) + (n0 & 127) + (isup ? 128 : 0); gk = (const float*)a->in[14]; }
    else { it -= 2 * IT_GU1; const int r = it; kb = r / 64; nb = r % 64; K = FF; N = DM; W = (const float*)a->in[17]; WT = (bf16*)(ws + WS_WD); drow0 = 32 * nb; }
    if (gk) xpose_item<true>(W, K, N, WT, 64 * kb, 32 * nb, drow0, scr, lane, gk); else xpose_item<false>(W, K, N, WT, 64 * kb, 32 * nb, drow0, scr, lane, gk);
}
__device__ __forceinline__ void late_convert(Frame& F, KArgs a, int part) {
    PH_IDX();
    LAS float* scr = (LAS float*)(F.lds + RING_OFF + wave * 16384);
    const int bx = (int)blockIdx.x, cgw = ((bx >> 3) * 4 + (bx & 3)) * NWAVES + wave, CNGW = (F.G / 2) * NWAVES;
    for (int it = IT_EARLY + part * (IT_LATE / 2) + cgw; it < IT_EARLY + (part + 1) * (IT_LATE / 2); it += CNGW) conv_item(a, it, scr, lane);
}
__device__ __forceinline__ void p0_prologue(Frame& F, KArgs a) {
    PH_IDX();
    unsigned char* ws = (unsigned char*)a->ws;
    LAS float* scr = (LAS float*)(F.lds + RING_OFF + wave * 16384);
    const int gw = F.vcu * NWAVES + wave, NGW = F.G * NWAVES;
    const int it_end = (F.G % 8 == 0) ? IT_EARLY : IT_TOTAL;
    for (int it0 = gw; it0 < it_end; it0 += NGW) conv_item(a, it0, scr, lane);
    for (int r = gw; r < 2 * (INP - INC); r += NGW) { const int l = r / (INP - INC), rr = INC + r % (INP - INC);
        GAS v4u* p = (GAS v4u*)((bf16*)(ws + WS_WIN) + ((size_t)l * INP + rr) * DM) + lane;
#pragma unroll
        for (int j = 0; j < 4; ++j) p[64 * j] = (v4u){0u, 0u, 0u, 0u}; }
    { const float* x = (const float*)a->in[0]; bf16* H = (bf16*)(ws + WS_H); float* ssq0 = (float*)(ws + WS_SSQ0);
      for (int m = gw; m < S_; m += NGW) { const GAS f32x4* xr = (const GAS f32x4*)(x + (size_t)m * DM) + lane; GAS v2u* o8 = (GAS v2u*)(H + (size_t)m * DM) + lane; float ss = 0.f;
#pragma unroll
          for (int j = 0; j < 8; ++j) { const f32x4 v = xr[64 * j]; ss += (v.x * v.x + v.y * v.y) + (v.z * v.z + v.w * v.w); o8[64 * j] = (v2u){pk2(v.x, v.y), pk2(v.z, v.w)}; }
          ss = wave_sum(ss, lane); if (lane == 0) ssq0[m] = ss; } }
    { const float* rb = (const float*)a->in[2]; float* tbl = (float*)(ws + WS_TBL);
      for (int i = gw * 64 + lane; i < 2 * NH * att::TBL_N; i += NGW * 64) {
          const int pass = i / (NH * att::TBL_N), ii = i % (NH * att::TBL_N), h = ii / att::TBL_N, u = ii % att::TBL_N, st = att::TBL_U0 - u; float v = -__builtin_inff();
          int dl = -1, mu = 0;
          if (pass == 0) { if (st >= 0 && st <= 512) { dl = st; mu = (dl <= 128 ? 1 : 0) + (((dl & 3) == 0) ? 1 : 0) + (((dl & 15) == 0) ? 1 : 0); } }
          else { if (st >= 33 && st <= 128) { dl = 16 * st; mu = 1; } }
          if (mu > 0) { int bk; if (dl < 16) bk = dl; else { bk = 16 + (int)(logf((float)dl * 0.0625f) / 4.852030263919617f * 16.0f); if (bk > 31) bk = 31; }
              v = (rb[bk * NH + h] + logf((float)mu)) * 11.313708498984761f; }
          tbl[i] = v; } }
}

template <bool ROUTE>
__device__ __forceinline__ void norm_rows(Frame& F, const float* x, const float* g, bf16* H, KArgs a, bool dry = false) {
    PH_IDX();
    const int gw = F.vcu * NWAVES + wave, NGW = F.G * NWAVES;
    LAS float* wr_l = (LAS float*)(F.lds + RING_OFF);
    if constexpr (ROUTE) {
        const float* wrt = (const float*)a->in[18];
        for (int i = tid; i < DM * NEXP; i += NWAVES * 64) { const int k = i >> 3, e = i & 7; wr_l[e * DM + k] = wrt[i]; }
        LDS_WAIT(); __syncthreads();
    }
    f32x4 gv[8];
#pragma unroll
    for (int j = 0; j < 8; ++j) gv[j] = ((const GAS f32x4*)g)[lane + 64 * j];
    for (int m = gw; m < S_; m += NGW) {
        const GAS f32x4* xr = (const GAS f32x4*)(x + (size_t)m * DM) + lane;
        f32x4 v[8]; float ss = 0.f;
#pragma unroll
        for (int j = 0; j < 8; ++j) { v[j] = xr[64 * j]; ss += (v[j].x * v[j].x + v[j].y * v[j].y) + (v[j].z * v[j].z + v[j].w * v[j].w); }
        const float rstd = 1.0f / sqrtf(wave_sum(ss, lane) * (1.0f / DM) + EPS);
#pragma unroll
        for (int j = 0; j < 8; ++j) v[j] = v[j] * rstd * gv[j];
        GAS v2u* o8 = (GAS v2u*)(H + (size_t)m * DM) + lane;
#pragma unroll
        for (int j = 0; j < 8; ++j) o8[64 * j] = (v2u){pk2(v[j].x, v[j].y), pk2(v[j].z, v[j].w)};
        if constexpr (ROUTE) {
            float v0 = -__builtin_inff(), v1 = -__builtin_inff(); int e0 = 0, e1 = 0;
#pragma unroll 1
            for (int e = 0; e < 8; ++e) { float s = 0.f;
#pragma unroll
                for (int j = 0; j < 8; ++j) { const f32x4 w = *(const LAS f32x4*)(wr_l + e * DM + 4 * (lane + 64 * j)); s += (v[j].x * w.x + v[j].y * w.y) + (v[j].z * w.z + v[j].w * w.w); }
                s = wave_sum(s, lane);
                if (s > v0) { v1 = v0; e1 = e0; v0 = s; e0 = e; } else if (s > v1) { v1 = s; e1 = e; } }
            const float g0 = 1.0f / (1.0f + expf(v1 - v0)), g1 = 1.0f - g0;
            if (lane == 0 && !dry) {
                gu32* cnt = (gu32*)(a->ws + WS_CTL) + CW_CNT;
                const int s0 = (int)xb_add(cnt + e0, 1u), s1 = (int)xb_add(cnt + e1, 1u);
                int* ltok = (int*)(a->ws + WS_LTOK); float* lgate = (float*)(a->ws + WS_LGATE);
                ltok[(size_t)e0 * S_ + s0] = m; lgate[(size_t)e0 * S_ + s0] = g0;
                ltok[(size_t)e1 * S_ + s1] = m; lgate[(size_t)e1 * S_ + s1] = g1;
                ((int4*)(a->ws + WS_POS))[m] = make_int4(e0, s0, e1, s1);
            }
        }
    }
}

__device__ __forceinline__ void unpack8(const v4u w, float (&f)[8]) { f[0] = bflo(w.x); f[1] = bfhi(w.x); f[2] = bflo(w.y); f[3] = bfhi(w.y); f[4] = bflo(w.z); f[5] = bfhi(w.z); f[6] = bflo(w.w); f[7] = bfhi(w.w); }
__device__ __forceinline__ v4u pack8s(const float (&f)[8], float s, const float (&g)[8]) {
    v4u o; o.x = pk2(f[0] * s * g[0], f[1] * s * g[1]); o.y = pk2(f[2] * s * g[2], f[3] * s * g[3]); o.z = pk2(f[4] * s * g[4], f[5] * s * g[5]); o.w = pk2(f[6] * s * g[6], f[7] * s * g[7]); return o; }
__device__ __forceinline__ float ssq8(const float (&f)[8]) { return ((f[0] * f[0] + f[1] * f[1]) + (f[2] * f[2] + f[3] * f[3])) + ((f[4] * f[4] + f[5] * f[5]) + (f[6] * f[6] + f[7] * f[7])); }
__device__ __forceinline__ void prep2(Frame& F, KArgs a, int l, bool dry = false) {
    PH_IDX();
    const int gw = F.vcu * NWAVES + wave, NGW = F.G * NWAVES, h = lane >> 3, sub = lane & 7;
    bf16* PROJ = (bf16*)(a->ws + WS_PROJ); bf16* QM = (bf16*)(a->ws + WS_QM); bf16* KVM = (bf16*)(a->ws + WS_KVM); bf16* KM = (bf16*)(a->ws + WS_KM);
    const int* pos = (const int*)a->in[1];
    const float* gq = (const float*)a->in[11] + l * QKB; const float* gk = (const float*)a->in[12] + l * QKB;
    float g_q[3][8], g_k[3][8], inv[8];
#pragma unroll
    for (int i = 0; i < 3; ++i)
#pragma unroll
        for (int j = 0; j < 8; ++j) { g_q[i][j] = gq[64 * i + 8 * sub + j]; g_k[i][j] = gk[64 * i + 8 * sub + j]; }
#pragma unroll
    for (int j = 0; j < 8; ++j) inv[j] = powf(10000.0f, -(float)((sub & 3) * 8 + j) * (1.0f / 32.0f));
    for (int m = gw; m < S_; m += NGW) {
        const float p = (float)pos[m];
        float cs[8], sn[8];
#pragma unroll
        for (int j = 0; j < 8; ++j) { const float ang = p * inv[j]; sincosf(ang, &sn[j], &cs[j]); }
        const GAS v4u* qrow = (const GAS v4u*)(QM + (size_t)m * NQB_ + h * QKB);
        const GAS v4u* krow = (const GAS v4u*)(KVM + (size_t)m * NKVB + h * 256);
        const GAS v4u* rrow = (const GAS v4u*)(PROJ + (size_t)m * INP + C_KR);
        float fq[3][8], fk[3][8];
#pragma unroll
        for (int i = 0; i < 3; ++i) unpack8(qrow[sub + 8 * i], fq[i]);
        unpack8(krow[sub], fk[0]); unpack8(krow[8 + sub], fk[1]); unpack8(rrow[sub], fk[2]);
        float sq = ssq8(fq[0]) + ssq8(fq[1]) + ssq8(fq[2]), sk = ssq8(fk[0]) + ssq8(fk[1]) + ssq8(fk[2]);
#pragma unroll
        for (int o = 1; o < 8; o <<= 1) { sq += shx(sq, lane, o); sk += shx(sk, lane, o); }
        const float rq = 1.0f / sqrtf(sq * (1.0f / QKB) + EPS), rk = 1.0f / sqrtf(sk * (1.0f / QKB) + EPS);
        float nq[8], nk[8];
#pragma unroll
        for (int j = 0; j < 8; ++j) { nq[j] = fq[2][j] * rq * g_q[2][j]; nk[j] = fk[2][j] * rk * g_k[2][j]; }
        float oq[8], ok[8];
#pragma unroll
        for (int j = 0; j < 8; ++j) { const float pq = shx(nq[j], lane, 4), pk = shx(nk[j], lane, 4);
            oq[j] = (sub < 4) ? (nq[j] * cs[j] - pq * sn[j]) : (pq * sn[j] + nq[j] * cs[j]);
            ok[j] = (sub < 4) ? (nk[j] * cs[j] - pk * sn[j]) : (pk * sn[j] + nk[j] * cs[j]); }
        const float one[8] = {1.f, 1.f, 1.f, 1.f, 1.f, 1.f, 1.f, 1.f};
        const size_t dofs = dry ? (size_t)(400 * MiB) / 2 : 0; GAS v4u* qo = (GAS v4u*)(QM + dofs + (size_t)m * NQB_ + h * QKB); GAS v4u* ko = (GAS v4u*)(KM + dofs + (size_t)m * NQB_ + h * QKB);
        qo[sub] = pack8s(fq[0], rq, g_q[0]); qo[8 + sub] = pack8s(fq[1], rq, g_q[1]); qo[16 + sub] = pack8s(oq, 1.0f, one);
        ko[sub] = pack8s(fk[0], rk, g_k[0]); ko[8 + sub] = pack8s(fk[1], rk, g_k[1]); ko[16 + sub] = pack8s(ok, 1.0f, one);
    }
}
__device__ __forceinline__ void att_merge(Frame& F, KArgs a) {
    PH_IDX();
    const int gw = F.vcu * NWAVES + wave, NGW = F.G * NWAVES;
    const bf16* OA = (const bf16*)(a->ws + WS_OA); const bf16* OB = (const bf16*)(a->ws + WS_OB); const float* LA = (const float*)(a->ws + WS_LSEA); const float* LB = (const float*)(a->ws + WS_LSEB);
    bf16* ATT = (bf16*)(a->ws + WS_ATT);
    for (int m = gw; m < S_; m += NGW) {
        const float la = LA[(size_t)m * NH + (lane >> 3)], lb = LB[(size_t)m * NH + (lane >> 3)];
        const float wb = 1.0f / (1.0f + expf(la - lb)), wa = 1.0f - wb;
        const GAS v4u* pa = (const GAS v4u*)(OA + (size_t)m * WA) + 2 * lane; const GAS v4u* pb = (const GAS v4u*)(OB + (size_t)m * WA) + 2 * lane;
        GAS v4u* po = (GAS v4u*)(ATT + (size_t)m * DM) + 2 * lane;
#pragma unroll
        for (int j = 0; j < 2; ++j) { float fa[8], fb[8]; unpack8(pa[j], fa); unpack8(pb[j], fb);
            v4u o; o.x = pk2(wa * fa[0] + wb * fb[0], wa * fa[1] + wb * fb[1]); o.y = pk2(wa * fa[2] + wb * fb[2], wa * fa[3] + wb * fb[3]);
            o.z = pk2(wa * fa[4] + wb * fb[4], wa * fa[5] + wb * fb[5]); o.w = pk2(wa * fa[6] + wb * fb[6], wa * fa[7] + wb * fb[7]); po[j] = o; }
    }
}
__device__ __forceinline__ void moe_tail_reduce(Frame& F, KArgs a, int T, int pm, int pnl) {
    PH_IDX();
    const int bx = (int)blockIdx.x; if (bx >= 4 * T) return;
    const int tu = bx >> 2, q = bx & 3;
    const bf16* P = (const bf16*)(a->ws + WS_PT) + (size_t)tu * 4 * 65536; bf16* Y = (bf16*)(a->ws + WS_Y);
    for (int rr = wave; rr < 64; rr += NWAVES) { const int r = 64 * q + rr;
        float s0 = 0.f, s1 = 0.f, s2 = 0.f, s3 = 0.f;
#pragma unroll
        for (int k = 0; k < 4; ++k) { const v2u w = *((const GAS v2u*)(P + (size_t)k * 65536 + (size_t)r * 256) + lane); s0 += bflo(w.x); s1 += bfhi(w.x); s2 += bflo(w.y); s3 += bfhi(w.y); }
        *((GAS v2u*)(Y + (size_t)(pm * 256 + r) * DM + pnl * 256) + lane) = (v2u){pk2(s0, s1), pk2(s2, s3)}; }
}
__device__ __forceinline__ void moe_tiles(KArgs a, int (&tb)[9]) {
    gu32* cnt = (gu32*)(a->ws + WS_CTL) + CW_CNT; int acc = 0;
#pragma unroll
    for (int e = 0; e < 8; ++e) { tb[e] = acc; acc += ((int)__builtin_amdgcn_readfirstlane(__hip_atomic_load(cnt + e, RLX_AGENT)) + 255) >> 8; }
    tb[8] = acc;
}
__device__ __forceinline__ void moe_combine(Frame& F, KArgs a, bool dry = false) {
    PH_IDX();
    const int gw = F.vcu * NWAVES + wave, NGW = F.G * NWAVES;
    int tb[9]; moe_tiles(a, tb);
    const bf16* Y = (const bf16*)(a->ws + WS_Y); float* out = (float*)a->out; float* outw = dry ? (float*)(a->ws + WS_PROJ) : out;
    for (int m = gw; m < S_; m += NGW) {
        const int4 ps = ((const int4*)(a->ws + WS_POS))[m];
        int b0 = 0, b1 = 0;
#pragma unroll
        for (int e = 0; e < 8; ++e) { b0 = (ps.x == e) ? tb[e] : b0; b1 = (ps.z == e) ? tb[e] : b1; }
        const GAS v2u* y0 = (const GAS v2u*)(Y + (size_t)(b0 * 256 + ps.y) * DM) + lane; const GAS v2u* y1 = (const GAS v2u*)(Y + (size_t)(b1 * 256 + ps.w) * DM) + lane;
        GAS f32x4* xr = (GAS f32x4*)(out + (size_t)m * DM) + lane; GAS f32x4* xw = (GAS f32x4*)(outw + (size_t)m * DM) + lane;
#pragma unroll
        for (int j = 0; j < 8; ++j) { const v2u w0 = y0[64 * j], w1 = y1[64 * j]; f32x4 v = xr[64 * j];
            v.x += bflo(w0.x) + bflo(w1.x); v.y += bfhi(w0.x) + bfhi(w1.x); v.z += bflo(w0.y) + bflo(w1.y); v.w += bfhi(w0.y) + bfhi(w1.y); xw[64 * j] = v; }
    }
}
#ifndef MK_PER_PHASE
#define MK_PER_PHASE 0
#endif
#ifndef DBG_STOP
#define DBG_STOP 23
#endif
#ifndef DUP_MASK
#define DUP_MASK 0u
#endif
constexpr int NPH = 20;
#undef DBG_STOP
#define DBG_STOP NPH

using CfgM = att::Cfg<192, NQB_, NQB_, NKVB, DM, false>;
using CfgA = att::Cfg<128, INP, INP, INP, WA, true, NH, 0>;
using CfgB = att::Cfg<128, 16 * INP, 16 * INP, 16 * INP, 16 * WA, true, 16 * NH, 33>;
constexpr int W_DILA = 513, W_DILB = 129;

__global__ void __launch_bounds__(NWAVES * 64, 2) mega_fwd(Args a_byval) {
    extern __shared__ __attribute__((aligned(16))) unsigned char lds[];
    Frame F;
    F.lds = (LAS unsigned char*)lds;
    F.wave = __builtin_amdgcn_readfirstlane((int)threadIdx.x >> 6); asm volatile("" : "+s"(F.wave));
    F.G = gridDim.x; { const int bx = blockIdx.x; F.vcu = (F.G % 8 == 0) ? (bx % 8) * (F.G / 8) + bx / 8 : bx; }
    const int lo = a_byval.ph_lo, hi = a_byval.ph_hi, use_bar = a_byval.use_bar;
    GAS unsigned char* const ws0 = kargs()->ws;
    volatile LAS unsigned* MISC = (volatile LAS unsigned*)(F.lds + MISC_OFF);
    for (int u = threadIdx.x; u < (LDS_BYTES - LDSCTL_OFF) / 4; u += NWAVES * 64) ((LAS unsigned*)(F.lds + LDSCTL_OFF))[u] = 0u;
    __syncthreads();
    XcdBarrier bar; bar.bar = (gu32*)(ws0 + WS_CTL) + CW_BAR; bar.x = 0; bar.st = nullptr;
    if (use_bar) bar = xcd_barrier_post((gu32*)(ws0 + WS_CTL) + CW_BAR, MISC + 8);
#define IN(k) (lo <= (k) && (k) < hi)
#define REPS(k) (((DUP_MASK >> (k)) & 1u) ? 2 : 1)
#ifndef DUP_BAR
#define DUP_BAR 0
#endif
#define DUP(k) for (int rp_ = 0; rp_ < REPS(k); (DUP_BAR && use_bar && rp_ == 0 && REPS(k) > 1) ? (xcd_barrier(bar), 0) : 0, ++rp_)
#ifndef DOWN_REV
#define DOWN_REV 1
#endif
#ifndef DOWN_WGM
#define DOWN_WGM 4
#endif
#ifndef PROBE_EPI
#define PROBE_EPI 0
#endif
#ifndef SEAM_REPS
#define SEAM_REPS 1
#endif
#define SEAM(k) do { if (use_bar && IN(k) && IN((k) + 1)) { for (int sr_ = 0; sr_ < SEAM_REPS; ++sr_) { XcdBarrier b_ = bar; asm volatile("" : "+s"(b_.bar)); xcd_barrier(b_); } } } while (0)
    LAS unsigned char* const ring = F.lds + RING_OFF;
    LAS float* const xlds = (LAS float*)(F.lds + XLDS_OFF);

    if (IN(0)) { DUP(0) p0_prologue(F, kargs()); SEAM(0); }

    for (int l = 0; l < NLAYER; ++l) {
        const int pb = l ? 9 : 1;
        int bx = (int)blockIdx.x, G_ = F.G; asm volatile("" : "+s"(bx), "+s"(G_));
        const KArgs a = kargs(); GAS unsigned char* ws = a->ws; asm volatile("" : "+s"(ws));
        bf16* const H = (bf16*)(ws + WS_H); bf16* const PROJ = (bf16*)(ws + WS_PROJ); bf16* const QM = (bf16*)(ws + WS_QM); bf16* const KVM = (bf16*)(ws + WS_KVM);
        bf16* const KM = (bf16*)(ws + WS_KM); bf16* const ATT = (bf16*)(ws + WS_ATT);
        bf16* const ACT = (bf16*)(ws + WS_ACT); bf16* const Y = (bf16*)(ws + WS_Y);
        float* const ssq0 = (float*)(ws + WS_SSQ0); float* const ssqx = (float*)(ws + WS_SSQX); float* const ssqc = (float*)(ws + WS_SSQC) + (size_t)l * S_ * 2;
        if (IN(pb + 0)) { DUP(pb + 0) {
            pg8::Gemm g{H, (const bf16*)(ws + WS_WIN) + (size_t)l * INP * DM, DM, DM}; pg8::TileOrder O; O.init(S_ / 256, INP / 256, G_, bx);
            pg8::EpiInProj E{PROJ, INP, l ? ssqx + (size_t)S_ * 8 : ssq0, l ? 8 : 1, (const float*)a->in[9] + l * HD, (const float*)a->in[10] + l * HD, (const float*)a->in[6] + l * KVLORA, ssqc, EPS};
            pg8::gemm_phase<pg8::EpiInProj, pg8::TileOrder, false>(ring, g, O, E, F.wave, xlds); }
            SEAM(pb + 0);
        }
        if (IN(pb + 1)) { DUP(pb + 1) {
            { pg8::Gemm g{PROJ + C_CQ, (const bf16*)(ws + WS_WQB) + (size_t)l * NQB_ * QLORA, QLORA, INP}; pg8::TileOrder O; O.init(S_ / 256, NQB_ / 256, G_, bx);
              pg8::EpiBf16 E{QM, NQB_, ssqc, 2, 1.0f / QLORA, EPS}; pg8::gemm_phase<pg8::EpiBf16, pg8::TileOrder, false>(ring, g, O, E, F.wave, xlds); }
            { pg8::Gemm g{PROJ + C_CKV, (const bf16*)(ws + WS_WKVB) + (size_t)l * NKVB * KVLORA, KVLORA, INP}; pg8::TileOrder O; O.init(S_ / 256, NKVB / 256, G_, bx);
              pg8::EpiBf16 E{KVM, NKVB, nullptr, 0, 0.f, 0.f}; pg8::gemm_phase<pg8::EpiBf16, pg8::TileOrder, false>(ring, g, O, E, F.wave, xlds); } }
            SEAM(pb + 1);
        }
        if (IN(pb + 2)) { if (REPS(pb + 2) > 1) prep2(F, a, l, true); prep2(F, a, l); SEAM(pb + 2); }
        if (IN(pb + 3)) { DUP(pb + 3) {
            att::lptr albs = (att::lptr)ring;
            const bool host = (l == 0) && (G_ % 8 == 0) && rp_ == 0;
            if (host && (bx & 4) == 0) { late_convert(F, a, 0); __syncthreads(); }
            if (F.wave >= 4) __builtin_amdgcn_s_setprio(1);
            {   att::Seam<CfgM> Sm;
                for (int it = bx; it < 256; it += G_) {
                    const int h = it & 7, x = it >> 3;
                    att::BlockRef b0, b1;
                    b0.P0 = x * 256; b1.P0 = (63 - x) * 256;
                    b0.K = b1.K = KM + h * QKB; b0.V = b1.V = KVM + h * 256 + 128;
                    b0.Q = QM + (size_t)b0.P0 * NQB_ + h * QKB; b1.Q = QM + (size_t)b1.P0 * NQB_ + h * QKB;
                    b0.O = ATT + (size_t)b0.P0 * DM + WA + h * HD; b1.O = ATT + (size_t)b1.P0 * DM + WA + h * HD; b0.lse = b1.lse = nullptr;
                    att::prime<CfgM>(b0, W_CAUSAL, albs, Sm, F.wave);
                    for (int pass = 0; pass < 2; ++pass) { const att::BlockRef cur = pass ? b1 : b0; att::block<CfgM>(cur, b1, S_, W_CAUSAL, albs, Sm, F.wave); }
                } }
            {   att::Seam<CfgA> Sa;
                bf16* const OA = (bf16*)(ws + WS_OA); float* const LA = (float*)(ws + WS_LSEA);
                for (int it = bx; it < 256; it += G_) {
                    const int h = it & 7, x = it >> 3;
                    { const float* tg = (const float*)(ws + WS_TBL) + h * att::TBL_N; LAS float* tl = (LAS float*)(ring + CfgA::OFF_TBL);
                      PH_IDX(); for (int i = tid; i < att::TBL_N; i += NWAVES * 64) tl[i] = tg[i]; }
                    att::BlockRef b0, b1;
                    b0.P0 = x * 256; b1.P0 = (63 - x) * 256;
                    b0.K = b1.K = PROJ + C_KA + h * HD; b0.V = b1.V = PROJ + C_VA + h * HD;
                    b0.Q = PROJ + (size_t)b0.P0 * INP + C_QA + h * HD; b1.Q = PROJ + (size_t)b1.P0 * INP + C_QA + h * HD;
                    b0.O = OA + (size_t)b0.P0 * WA + h * HD; b1.O = OA + (size_t)b1.P0 * WA + h * HD;
                    b0.lse = LA + (size_t)b0.P0 * NH + h; b1.lse = LA + (size_t)b1.P0 * NH + h;
                    att::prime<CfgA>(b0, W_DILA, albs, Sa, F.wave);
                    for (int pass = 0; pass < 2; ++pass) { const att::BlockRef cur = pass ? b1 : b0; att::block<CfgA>(cur, b1, S_, W_DILA, albs, Sa, F.wave); }
                } }
            {   att::Seam<CfgB> Sb;
                bf16* const OB = (bf16*)(ws + WS_OB); float* const LB = (float*)(ws + WS_LSEB);
                for (int it = bx; it < 256; it += G_) {
                    const int h = it & 7, y = it >> 3;
                    { const float* tg = (const float*)(ws + WS_TBL) + (NH + h) * att::TBL_N; LAS float* tl = (LAS float*)(ring + CfgB::OFF_TBL);
                      PH_IDX(); for (int i = tid; i < att::TBL_N; i += NWAVES * 64) tl[i] = tg[i]; }
                    att::BlockRef b0, b1;
                    const int i0 = 2 * y, i1 = 2 * y + 1, r0 = i0 >> 2, r1 = i1 >> 2;
                    b0.P0 = (i0 & 3) * 256; b1.P0 = (i1 & 3) * 256;
                    b0.K = PROJ + (size_t)r0 * INP + C_KA + h * HD; b1.K = PROJ + (size_t)r1 * INP + C_KA + h * HD;
                    b0.V = PROJ + (size_t)r0 * INP + C_VA + h * HD; b1.V = PROJ + (size_t)r1 * INP + C_VA + h * HD;
                    b0.Q = PROJ + ((size_t)b0.P0 * 16 + r0) * INP + C_QA + h * HD; b1.Q = PROJ + ((size_t)b1.P0 * 16 + r1) * INP + C_QA + h * HD;
                    b0.O = OB + ((size_t)b0.P0 * 16 + r0) * WA + h * HD; b1.O = OB + ((size_t)b1.P0 * 16 + r1) * WA + h * HD;
                    b0.lse = LB + ((size_t)b0.P0 * 16 + r0) * NH + h; b1.lse = LB + ((size_t)b1.P0 * 16 + r1) * NH + h;
                    att::prime<CfgB>(b0, W_DILB, albs, Sb, F.wave);
                    for (int pass = 0; pass < 2; ++pass) { const att::BlockRef cur = pass ? b1 : b0; att::block<CfgB>(cur, b1, S_ / 16, W_DILB, albs, Sb, F.wave); }
                } }
            __builtin_amdgcn_s_setprio(0);
            if (host && (bx & 4) != 0) { __syncthreads(); late_convert(F, a, 1); } }
            SEAM(pb + 3);
        }
        if (IN(pb + 4)) { att_merge(F, a); SEAM(pb + 4); }
        if (IN(pb + 5)) { for (int rp_ = 0; rp_ < (l == 0 ? REPS(6) : 1); ++rp_) {
            pg8::Gemm g{ATT, (const bf16*)(ws + WS_WOUT) + (size_t)l * DM * DM, DM, DM}; pg8::TileOrder O; O.init(S_ / 256, DM / 256, G_, bx);
            pg8::EpiRes E{l == 0 ? (const float*)a->in[0] : nullptr, H, l == 0 ? nullptr : (float*)a->out, l == 0 ? H : nullptr, ssqx, DM};
            pg8::gemm_phase<pg8::EpiRes, pg8::TileOrder, false>(ring, g, O, E, F.wave, xlds); }
            SEAM(pb + 5);
        }
        if (l == 0) {
            if (IN(7)) { DUP(7) {
                pg8::Gemm g{H, (const bf16*)(ws + WS_WGU), DM, DM}; pg8::TileOrder O; O.init(S_ / 256, NT_GU, G_, bx);
                pg8::EpiSwiGLU E{ACT, FF, NT_GU, ssqx, EPS, (REPS(7) > 1 && rp_ == 0) ? PROBE_EPI : 0};
                pg8::gemm_phase<pg8::EpiSwiGLU, pg8::TileOrder, false>(ring, g, O, E, F.wave, xlds); }
                SEAM(7);
            }
            if (IN(8)) { DUP(8) {
                const bool dry = REPS(8) > 1 && rp_ == 0;
                pg8::Gemm g{ACT, (const bf16*)(ws + WS_WD), FF, FF}; pg8::TileOrder O; O.init(S_ / 256, NT_D, G_, bx, DOWN_WGM);
                pg8::EpiRes E{nullptr, H, dry ? (float*)(ws + WS_END) : nullptr, dry ? nullptr : H, ssqx + (size_t)S_ * 8, DM};
                pg8::gemm_phase<pg8::EpiRes, pg8::TileOrder, false>(ring, g, O, E, F.wave, xlds); }
                SEAM(8);
            }
        } else {
            if (IN(15)) { if (REPS(15) > 1) norm_rows<true>(F, (const float*)a->out, (const float*)a->in[14] + l * DM, H, a, true); norm_rows<true>(F, (const float*)a->out, (const float*)a->in[14] + l * DM, H, a); SEAM(15); }
            if (IN(16)) { DUP(16) {
                int tb[9]; moe_tiles(a, tb);
                pg8::MoeOrder O; O.t.init(tb[8], NT_GU, G_, bx); O.t1 = tb[1]; O.t2 = tb[2]; O.t3 = tb[3]; O.t4 = tb[4]; O.t5 = tb[5]; O.t6 = tb[6]; O.t7 = tb[7];
                O.nNl = NT_GU; O.list = (const int*)(ws + WS_LTOK); O.cnt = (const int*)(ws + WS_CTL) + CW_CNT; O.S_cap = S_; O.R = -1; O.T = 0; O.nkt_full = DM / 64;
                pg8::Gemm g{H, (const bf16*)(ws + WS_WGUE), DM, DM};
                pg8::EpiSwiGLU E{ACT, FF, NT_GU, nullptr, 0.f, (REPS(16) > 1 && rp_ == 0) ? PROBE_EPI : 0};
                pg8::gemm_phase<pg8::EpiSwiGLU, pg8::MoeOrder, true>(ring, g, O, E, F.wave, xlds); }
                SEAM(16);
            }
            if (IN(17)) { DUP(17) {
                int tb[9]; moe_tiles(a, tb);
                pg8::MoeOrder O; O.t.init(tb[8], NT_D, G_, bx, DOWN_WGM); O.t.rev = DOWN_REV; O.t1 = tb[1]; O.t2 = tb[2]; O.t3 = tb[3]; O.t4 = tb[4]; O.t5 = tb[5]; O.t6 = tb[6]; O.t7 = tb[7];
                O.nNl = NT_D; O.list = (const int*)(ws + WS_LTOK); O.cnt = (const int*)(ws + WS_CTL) + CW_CNT; O.S_cap = S_; O.nkt_full = FF / 64;
                { const int U = tb[8] * NT_D, Rr = U / G_, Tt = U - Rr * G_; const bool split = Tt > 0 && 4 * Tt <= G_; O.R = split ? Rr : -1; O.T = split ? Tt : 0; }
                pg8::Gemm g{ACT, (const bf16*)(ws + WS_WDE), FF, FF};
                pg8::EpiMoeDown E{Y, DM, NT_D, (const float*)(ws + WS_LGATE), (const int*)(ws + WS_CTL) + CW_CNT, S_, (bf16*)(ws + WS_PT)};
                pg8::gemm_phase<pg8::EpiMoeDown, pg8::MoeOrder, false, true>(ring, g, O, E, F.wave, xlds); }
                SEAM(17);
            }
            if (IN(18)) {
                int tb[9]; moe_tiles(a, tb);
                const int U = tb[8] * NT_D, Rr = U / G_, Tt = U - Rr * G_;
                if (Tt > 0 && 4 * Tt <= G_ && bx < 4 * Tt) {
                    pg8::TileOrder O; O.init(tb[8], NT_D, G_, bx, DOWN_WGM); O.rev = DOWN_REV; pg8::Unit u; O.at((long)Rr * G_ + (bx >> 2), u);
                    moe_tail_reduce(F, a, Tt, u.pm, u.pn); }
                SEAM(18);
            }
            if (IN(19)) { if (REPS(19) > 1) moe_combine(F, a, true); moe_combine(F, a); }
        }
    }
#undef IN
#undef SEAM
#undef REPS
#undef DUP
}

extern "C" void kernel_launch(void* const* d_in, const int* in_sizes, int n_in, void* d_out, int out_size, void* d_ws, size_t ws_size, hipStream_t stream) {
    static int grid = 0;
    if (grid == 0) {
        if (n_in != 22 || in_sizes[0] != S_ * DM || out_size != S_ * DM || ws_size < WS_END) { fprintf(stderr, "kernel_launch: shape/workspace mismatch (n_in %d, in0 %d, out %d, ws %zu, need %zu)\n", n_in, n_in > 0 ? in_sizes[0] : -1, out_size, ws_size, (size_t)WS_END); grid = -1; return; }
        int dev = 0, cus = 0, per_cu = 0;
        if (hipGetDevice(&dev) != hipSuccess || hipDeviceGetAttribute(&cus, hipDeviceAttributeMultiprocessorCount, dev) != hipSuccess) { grid = -1; return; }
        if (hipFuncSetAttribute((const void*)mega_fwd, hipFuncAttributeMaxDynamicSharedMemorySize, LDS_BYTES) != hipSuccess) { fprintf(stderr, "kernel_launch: hipFuncSetAttribute failed\n"); grid = -1; return; }
        if (hipOccupancyMaxActiveBlocksPerMultiprocessor(&per_cu, (const void*)mega_fwd, NWAVES * 64, LDS_BYTES) != hipSuccess || per_cu < 1) { fprintf(stderr, "kernel_launch: occupancy query reports %d\n", per_cu); }
        (void)hipGetLastError();
        grid = cus;
    }
    if (grid < 0) return;
    if (hipMemsetAsync((char*)d_ws + WS_CTL, 0, CTL_ZERO_BYTES, stream) != hipSuccess) return;
    Args a{};
    for (int i = 0; i < 22; ++i) a.in[i] = d_in[i];
    a.out = (float*)d_out; a.ws = (unsigned char*)d_ws; a.pad = 0;
#if MK_PER_PHASE
    for (int ph = 0; ph < DBG_STOP; ++ph) { a.ph_lo = ph; a.ph_hi = ph + 1; a.use_bar = 0;
        hipLaunchKernelGGL(mega_fwd, dim3(grid), dim3(NWAVES * 64), LDS_BYTES, stream, a); }
#else
    a.ph_lo = 0; a.ph_hi = DBG_STOP; a.use_bar = 1;
    hipLaunchKernelGGL(mega_fwd, dim3(grid), dim3(NWAVES * 64), LDS_BYTES, stream, a);
#endif
}
```

```cpp
#define KLOOP_ALIGN "4"
#define OUT_WGM 4
#include <hip/hip_runtime.h>
#include <cstdio>
#include <cstdint>
namespace pg8 {
constexpr int CNT_STRIDE = 32;
#define PG8_LAS __attribute__((address_space(3)))
typedef unsigned short bf16_t;
typedef short bf16x8 __attribute__((ext_vector_type(8)));
typedef float f32x4 __attribute__((ext_vector_type(4)));
typedef unsigned u32x4 __attribute__((ext_vector_type(4)));
constexpr int BM = 256, BK = 64, HALF = 128, HTB = HALF * BK * 2  , STAGE_BYTES = 8 * HTB, NXCD = 8, WGM = 8;

__device__ __forceinline__ int lds_byte(int r, int c) { const int st = (r >> 4) * 2 + (c >> 5), rr = r & 15, cc = c & 31, ob = rr * 64 + cc * 2; return st * 1024 + (ob ^ (((ob >> 9) & 1) << 5)); }
__device__ __forceinline__ void stage_rc(int b, int& R, int& C) { const int st = b / 1024, sb = b % 1024, swz = sb ^ (((sb >> 9) & 1) << 5); R = (st >> 1) * 16 + swz / 64; C = (st & 1) * 32 + (swz % 64) / 2; }
__device__ __forceinline__ int perm32(int rho) { const int n = rho >> 4, i = rho & 15; return 8 * (i >> 2) + 4 * n + (i & 3); }

struct Unit { int pm, pn, e, lt, kt0, nkt, tail; };
struct Gemm { const bf16_t* A; const bf16_t* Bt; int K; int lda; };

struct TileOrder {
    int nM, nN, nwg, G, c, wgm, rev;
    __device__ __forceinline__ void init(int nM_, int nN_, int G_, int c_, int wgm_ = WGM) { nM = nM_; nN = nN_; nwg = nM * nN; G = G_; c = c_; wgm = wgm_; rev = 0; }
    __device__ __forceinline__ bool next(int i, Unit& u) const { return at((long)i * G + c, u); }
    __device__ __forceinline__ bool at(long L, Unit& u) const {
        if (L >= nwg) return false;
        int wgid = (int)L; { const int q = nwg / NXCD, r = nwg % NXCD, xcd = wgid % NXCD, off = wgid / NXCD; wgid = (xcd < r ? xcd * (q + 1) : r * (q + 1) + (xcd - r) * q) + off; }
        if (rev) wgid = nwg - 1 - wgid;
        const int nig = wgm * nN, gid = wgid / nig, fm = gid * wgm, gsz = (nM - fm) < wgm ? (nM - fm) : wgm;
        u.pm = fm + ((wgid % nig) % gsz); u.pn = (wgid % nig) / gsz; u.e = 0; u.lt = 0; u.kt0 = 0; u.nkt = 0; u.tail = 0; return true;
    }
    __device__ __forceinline__ unsigned a_off(const Unit&, int) const { return 0u; }
};
struct MoeOrder {
    TileOrder t; int t1, t2, t3, t4, t5, t6, t7; int nNl; const int* list; const int* cnt; int S_cap; int R, T, nkt_full;
    __device__ __forceinline__ void find(int pm, int& e, int& tb) const {
        e = (pm >= t1) + (pm >= t2) + (pm >= t3) + (pm >= t4) + (pm >= t5) + (pm >= t6) + (pm >= t7);
        tb = pm >= t7 ? t7 : pm >= t6 ? t6 : pm >= t5 ? t5 : pm >= t4 ? t4 : pm >= t3 ? t3 : pm >= t2 ? t2 : pm >= t1 ? t1 : 0;
    }
    __device__ __forceinline__ bool next(int i, Unit& u) const {
        if (R >= 0 && i >= R) {
            if (i > R || t.c >= 4 * T) return false;
            if (!t.at((long)R * t.G + (t.c >> 2), u)) return false;
            u.nkt = nkt_full / 4; u.kt0 = (t.c & 3) * u.nkt; u.tail = 1 + t.c;
        } else { if (!t.next(i, u)) return false; u.nkt = nkt_full; }
        int e, tb; find(u.pm, e, tb); u.e = e; u.lt = u.pm - tb; u.pn += e * nNl; return true;
    }
    __device__ __forceinline__ unsigned a_off(const Unit& u, int R) const {
        const int slot = u.lt * 256 + R; const int n = cnt[u.e * CNT_STRIDE];
        const int tok = list[(size_t)u.e * S_cap + (slot < n ? slot : 0)];
        return (unsigned)tok * 4096u;
    }
};

__device__ __forceinline__ unsigned cvt_pk_bf16(float lo, float hi) { unsigned r; asm volatile("v_cvt_pk_bf16_f32 %0, %1, %2" : "=v"(r) : "v"(lo), "v"(hi)); return r; }

__device__ __forceinline__ float shx(float v, int lane, int o) { return __builtin_bit_cast(float, __builtin_amdgcn_ds_bpermute((lane ^ o) << 2, __builtin_bit_cast(int, v))); }
__device__ __forceinline__ float sum_fq(float v, int lane) { v += shx(v, lane, 16); v += shx(v, lane, 32); return v; }
__device__ __forceinline__ float ssq4(const f32x4 a) { return (a[0] * a[0] + a[1] * a[1]) + (a[2] * a[2] + a[3] * a[3]); }
typedef float f32x2 __attribute__((ext_vector_type(2)));
template <int NS>
__device__ __forceinline__ void row_rs8(const float* ssq, int row0, float inv_n, float eps, float (&rs)[2][4]) {
    if constexpr (NS == 8) { f32x4 a[2][4], b[2][4];
#pragma unroll
        for (int ai = 0; ai < 2; ++ai)
#pragma unroll
            for (int m = 0; m < 4; ++m) { const float* p = ssq + (size_t)(row0 + ai * HALF + m * 16) * 8; a[ai][m] = *(const f32x4*)p; b[ai][m] = *(const f32x4*)(p + 4); }
#pragma unroll
        for (int ai = 0; ai < 2; ++ai)
#pragma unroll
            for (int m = 0; m < 4; ++m) { const f32x4 x = a[ai][m], y = b[ai][m]; rs[ai][m] = __builtin_amdgcn_rsqf((((x[0] + x[1]) + (x[2] + x[3])) + ((y[0] + y[1]) + (y[2] + y[3]))) * inv_n + eps); }
    } else if constexpr (NS == 2) { f32x2 a[2][4];
#pragma unroll
        for (int ai = 0; ai < 2; ++ai)
#pragma unroll
            for (int m = 0; m < 4; ++m) a[ai][m] = *(const f32x2*)(ssq + (size_t)(row0 + ai * HALF + m * 16) * 2);
#pragma unroll
        for (int ai = 0; ai < 2; ++ai)
#pragma unroll
            for (int m = 0; m < 4; ++m) rs[ai][m] = __builtin_amdgcn_rsqf((a[ai][m][0] + a[ai][m][1]) * inv_n + eps);
    } else { float a[2][4];
#pragma unroll
        for (int ai = 0; ai < 2; ++ai)
#pragma unroll
            for (int m = 0; m < 4; ++m) a[ai][m] = ssq[row0 + ai * HALF + m * 16];
#pragma unroll
        for (int ai = 0; ai < 2; ++ai)
#pragma unroll
            for (int m = 0; m < 4; ++m) rs[ai][m] = __builtin_amdgcn_rsqf(a[ai][m] * inv_n + eps);
    }
}
__device__ __forceinline__ void row_rs8n(const float* ssq, int ns, int row0, float inv_n, float eps, float (&rs)[2][4]) {
    if (ns == 8) row_rs8<8>(ssq, row0, inv_n, eps, rs); else if (ns == 2) row_rs8<2>(ssq, row0, inv_n, eps, rs); else row_rs8<1>(ssq, row0, inv_n, eps, rs);
}
__device__ __forceinline__ void ones8(float (&rs)[2][4]) {
#pragma unroll
    for (int ai = 0; ai < 2; ++ai)
#pragma unroll
        for (int m = 0; m < 4; ++m) rs[ai][m] = 1.0f;
}
struct EpiBf16 {
    static constexpr bool PERM = true;
    bf16_t* O; int ldc; const float* ssq; int ns; float inv_n, eps;
    __device__ __forceinline__ void operator()(const f32x4 (&acc)[2][2][4][2], const Unit& u, int wr, int wc, int fr, int fq, int lane, PG8_LAS float* xl) const {
        const int row0 = u.pm * BM + wr * 64 + fr, col0 = u.pn * BM + wc * 32 + 8 * fq;
        float rsv[2][4];
        if (ssq) row_rs8n(ssq, ns, row0, inv_n, eps, rsv); else ones8(rsv);
#pragma unroll
        for (int ai = 0; ai < 2; ++ai)
#pragma unroll
            for (int m = 0; m < 4; ++m) { const int grow = row0 + ai * HALF + m * 16; bf16_t* rowp = O + (size_t)grow * ldc + col0;
                const float rs = rsv[ai][m];
#pragma unroll
                for (int bj = 0; bj < 2; ++bj) { const f32x4 v0 = acc[ai][bj][m][0] * rs, v1 = acc[ai][bj][m][1] * rs;
                    u32x4 w; w.x = cvt_pk_bf16(v0[0], v0[1]); w.y = cvt_pk_bf16(v0[2], v0[3]); w.z = cvt_pk_bf16(v1[0], v1[1]); w.w = cvt_pk_bf16(v1[2], v1[3]);
                    *(u32x4*)(rowp + bj * HALF) = w; } }
    }
};
struct EpiInProj {
    static constexpr bool PERM = true;
    bf16_t* O; int ldc; const float* ssq_x; int ns_x; const float* gq; const float* gk; const float* gckv; float* ssq_cq; float eps;
    __device__ __forceinline__ void operator()(const f32x4 (&acc)[2][2][4][2], const Unit& u, int wr, int wc, int fr, int fq, int lane, PG8_LAS float* xl) const {
        const int row0 = u.pm * BM + wr * 64 + fr, col0 = u.pn * BM + wc * 32 + 8 * fq, pn = u.pn;
        const bool headn = pn < 8, ckvn = pn == 14, cq = (pn == 12 || pn == 13);
        f32x4 v[2][4][2][2];
        float rsxv[2][4]; row_rs8n(ssq_x, ns_x, row0, 1.0f / 2048.0f, eps, rsxv);
#pragma unroll
        for (int ai = 0; ai < 2; ++ai)
#pragma unroll
            for (int m = 0; m < 4; ++m) { const float rsx = rsxv[ai][m];
#pragma unroll
                for (int bj = 0; bj < 2; ++bj)
#pragma unroll
                    for (int n = 0; n < 2; ++n) v[ai][m][bj][n] = acc[ai][bj][m][n] * rsx; }
        if (headn || ckvn) {
#pragma unroll
            for (int ai = 0; ai < 2; ++ai)
#pragma unroll
                for (int m = 0; m < 4; ++m)
#pragma unroll
                    for (int bj = 0; bj < 2; ++bj) { const float s = sum_fq(ssq4(v[ai][m][bj][0]) + ssq4(v[ai][m][bj][1]), lane);
                        if (fq == 0) xl[((ai * HALF + wr * 64 + m * 16 + fr) * 2 + bj) * 4 + wc] = s; }
            asm volatile("s_waitcnt lgkmcnt(0)" ::: "memory"); __builtin_amdgcn_s_barrier(); asm volatile("" ::: "memory");
            f32x4 gg[2][2];
            { const int go = wc * 32 + 8 * fq;
              if (ckvn) { gg[0][0] = *(const f32x4*)(gckv + go); gg[0][1] = *(const f32x4*)(gckv + go + 4); gg[1][0] = *(const f32x4*)(gckv + HALF + go); gg[1][1] = *(const f32x4*)(gckv + HALF + go + 4); }
              else if (pn < 4) { gg[0][0] = *(const f32x4*)(gq + go); gg[0][1] = *(const f32x4*)(gq + go + 4); gg[1][0] = gg[0][0]; gg[1][1] = gg[0][1]; }
              else { gg[0][0] = *(const f32x4*)(gk + go); gg[0][1] = *(const f32x4*)(gk + go + 4); gg[1][0] = gg[0][0]; gg[1][1] = gg[0][1]; } }
#pragma unroll
            for (int ai = 0; ai < 2; ++ai)
#pragma unroll
                for (int m = 0; m < 4; ++m) { const int r = ai * HALF + wr * 64 + m * 16 + fr;
                    const f32x4 p0 = *(const PG8_LAS f32x4*)(xl + (r * 2 + 0) * 4), p1 = *(const PG8_LAS f32x4*)(xl + (r * 2 + 1) * 4);
                    const float t0 = (p0[0] + p0[1]) + (p0[2] + p0[3]), t1 = (p1[0] + p1[1]) + (p1[2] + p1[3]);
                    const float r0 = ckvn ? __builtin_amdgcn_rsqf((t0 + t1) * (1.0f / 256.0f) + eps) : __builtin_amdgcn_rsqf(t0 * (1.0f / 128.0f) + eps);
                    const float r1 = ckvn ? r0 : __builtin_amdgcn_rsqf(t1 * (1.0f / 128.0f) + eps);
#pragma unroll
                    for (int n = 0; n < 2; ++n) { v[ai][m][0][n] = v[ai][m][0][n] * r0 * gg[0][n]; v[ai][m][1][n] = v[ai][m][1][n] * r1 * gg[1][n]; } }
        } else if (cq) {
#pragma unroll
            for (int ai = 0; ai < 2; ++ai)
#pragma unroll
                for (int m = 0; m < 4; ++m) { const float s = sum_fq((ssq4(v[ai][m][0][0]) + ssq4(v[ai][m][0][1])) + (ssq4(v[ai][m][1][0]) + ssq4(v[ai][m][1][1])), lane);
                    if (fq == 0) xl[(ai * HALF + wr * 64 + m * 16 + fr) * 4 + wc] = s; }
            asm volatile("s_waitcnt lgkmcnt(0)" ::: "memory"); __builtin_amdgcn_s_barrier(); asm volatile("" ::: "memory");
            if (wc == 0 && fq == 0) {
#pragma unroll
                for (int ai = 0; ai < 2; ++ai)
#pragma unroll
                    for (int m = 0; m < 4; ++m) { const int r = ai * HALF + wr * 64 + m * 16 + fr; const f32x4 p = *(const PG8_LAS f32x4*)(xl + r * 4);
                        ssq_cq[(size_t)(u.pm * BM + r) * 2 + (pn - 12)] = (p[0] + p[1]) + (p[2] + p[3]); } }
        }
#pragma unroll
        for (int ai = 0; ai < 2; ++ai)
#pragma unroll
            for (int m = 0; m < 4; ++m) { bf16_t* rowp = O + (size_t)(row0 + ai * HALF + m * 16) * ldc + col0;
#pragma unroll
                for (int bj = 0; bj < 2; ++bj) { const f32x4 v0 = v[ai][m][bj][0], v1 = v[ai][m][bj][1];
                    u32x4 w; w.x = cvt_pk_bf16(v0[0], v0[1]); w.y = cvt_pk_bf16(v0[2], v0[3]); w.z = cvt_pk_bf16(v1[0], v1[1]); w.w = cvt_pk_bf16(v1[2], v1[3]);
                    *(u32x4*)(rowp + bj * HALF) = w; } }
    }
};
struct EpiRes {
    static constexpr bool PERM = true;
    const float* base32; const bf16_t* base16; float* out32; bf16_t* xb; float* ssq; int ldc;
    __device__ __forceinline__ void operator()(const f32x4 (&acc)[2][2][4][2], const Unit& u, int wr, int wc, int fr, int fq, int lane, PG8_LAS float* xl) const {
        const int row0 = u.pm * BM + wr * 64 + fr, col0 = u.pn * BM + wc * 32 + 8 * fq;
        float sr[2][4];
#define PG8_RES_ROW(ai, m, B00, B01, B10, B11) do { const size_t off = (size_t)(row0 + (ai) * HALF + (m) * 16) * ldc + col0; float s = 0.f;                      \
            { const f32x4 o0 = (B00) + acc[ai][0][m][0], o1 = (B01) + acc[ai][0][m][1];                                                                     \
              if (out32) { *(f32x4*)(out32 + off) = o0; *(f32x4*)(out32 + off + 4) = o1; }                                                                  \
              if (xb) { s += ssq4(o0) + ssq4(o1); u32x4 w; w.x = cvt_pk_bf16(o0[0], o0[1]); w.y = cvt_pk_bf16(o0[2], o0[3]); w.z = cvt_pk_bf16(o1[0], o1[1]); w.w = cvt_pk_bf16(o1[2], o1[3]); *(u32x4*)(xb + off) = w; } } \
            { const f32x4 o0 = (B10) + acc[ai][1][m][0], o1 = (B11) + acc[ai][1][m][1];                                                                     \
              if (out32) { *(f32x4*)(out32 + off + HALF) = o0; *(f32x4*)(out32 + off + HALF + 4) = o1; }                                                    \
              if (xb) { s += ssq4(o0) + ssq4(o1); u32x4 w; w.x = cvt_pk_bf16(o0[0], o0[1]); w.y = cvt_pk_bf16(o0[2], o0[3]); w.z = cvt_pk_bf16(o1[0], o1[1]); w.w = cvt_pk_bf16(o1[2], o1[3]); *(u32x4*)(xb + off + HALF) = w; } } \
            sr[ai][m] = s; } while (0)
#define PG8_BF_LO(q_) ((f32x4){__builtin_bit_cast(float, (q_).x << 16), __builtin_bit_cast(float, (q_).x & 0xffff0000u), __builtin_bit_cast(float, (q_).y << 16), __builtin_bit_cast(float, (q_).y & 0xffff0000u)})
#define PG8_BF_HI(q_) ((f32x4){__builtin_bit_cast(float, (q_).z << 16), __builtin_bit_cast(float, (q_).z & 0xffff0000u), __builtin_bit_cast(float, (q_).w << 16), __builtin_bit_cast(float, (q_).w & 0xffff0000u)})
        if (base32) {
#pragma unroll
            for (int ai = 0; ai < 2; ++ai) { f32x4 b[4][2][2];
#pragma unroll
                for (int m = 0; m < 4; ++m) { const size_t off = (size_t)(row0 + ai * HALF + m * 16) * ldc + col0;
#pragma unroll
                    for (int bj = 0; bj < 2; ++bj) { b[m][bj][0] = *(const f32x4*)(base32 + off + bj * HALF); b[m][bj][1] = *(const f32x4*)(base32 + off + bj * HALF + 4); } }
#pragma unroll
                for (int m = 0; m < 4; ++m) PG8_RES_ROW(ai, m, b[m][0][0], b[m][0][1], b[m][1][0], b[m][1][1]); }
        } else {
            u32x4 w[2][4][2];
#pragma unroll
            for (int ai = 0; ai < 2; ++ai)
#pragma unroll
                for (int m = 0; m < 4; ++m) { const size_t off = (size_t)(row0 + ai * HALF + m * 16) * ldc + col0; w[ai][m][0] = *(const u32x4*)(base16 + off); w[ai][m][1] = *(const u32x4*)(base16 + off + HALF); }
#pragma unroll
            for (int ai = 0; ai < 2; ++ai)
#pragma unroll
                for (int m = 0; m < 4; ++m) PG8_RES_ROW(ai, m, PG8_BF_LO(w[ai][m][0]), PG8_BF_HI(w[ai][m][0]), PG8_BF_LO(w[ai][m][1]), PG8_BF_HI(w[ai][m][1]));
        }
#undef PG8_RES_ROW
#undef PG8_BF_LO
#undef PG8_BF_HI
        if (xb) {
#pragma unroll
            for (int ai = 0; ai < 2; ++ai)
#pragma unroll
                for (int m = 0; m < 4; ++m) { const float s = sum_fq(sr[ai][m], lane); if (fq == 0) xl[(ai * HALF + wr * 64 + m * 16 + fr) * 4 + wc] = s; }
            asm volatile("s_waitcnt lgkmcnt(0)" ::: "memory"); __builtin_amdgcn_s_barrier(); asm volatile("" ::: "memory");
            if (wc == 0 && fq == 0) {
#pragma unroll
                for (int ai = 0; ai < 2; ++ai)
#pragma unroll
                    for (int m = 0; m < 4; ++m) { const int r = ai * HALF + wr * 64 + m * 16 + fr; const f32x4 p = *(const PG8_LAS f32x4*)(xl + r * 4);
                        ssq[(size_t)(u.pm * BM + r) * 8 + u.pn] = (p[0] + p[1]) + (p[2] + p[3]); } }
        }
    }
};
__device__ __forceinline__ float silu_mul(float g, float u) { return g * u * __builtin_amdgcn_rcpf(1.0f + __builtin_amdgcn_exp2f(-1.4426950408889634f * g)); }
struct EpiSwiGLU {
    static constexpr bool PERM = true;
    bf16_t* O; int ldc; int nNl; const float* ssq; float eps; int probe;
    __device__ __forceinline__ void operator()(const f32x4 (&acc)[2][2][4][2], const Unit& u, int wr, int wc, int fr, int fq, int lane, PG8_LAS float* xl) const {
        const int pnl = u.pn - u.e * nNl;
        if (probe == 2) return;
        const int row0 = u.pm * BM + wr * 64 + fr, col0 = pnl * HALF + wc * 32 + 8 * fq;
        float rsv[2][4];
        if (ssq) row_rs8<8>(ssq, row0, 1.0f / 2048.0f, eps, rsv); else ones8(rsv);
#pragma unroll
        for (int ai = 0; ai < 2; ++ai)
#pragma unroll
            for (int m = 0; m < 4; ++m) { const int grow = row0 + ai * HALF + m * 16; bf16_t* rowp = O + (size_t)grow * ldc + col0;
                const float rs = rsv[ai][m];
                const f32x4 g0 = acc[ai][0][m][0] * rs, g1 = acc[ai][0][m][1] * rs, u0 = acc[ai][1][m][0] * rs, u1 = acc[ai][1][m][1] * rs;
                u32x4 w; w.x = cvt_pk_bf16(silu_mul(g0[0], u0[0]), silu_mul(g0[1], u0[1])); w.y = cvt_pk_bf16(silu_mul(g0[2], u0[2]), silu_mul(g0[3], u0[3]));
                w.z = cvt_pk_bf16(silu_mul(g1[0], u1[0]), silu_mul(g1[1], u1[1])); w.w = cvt_pk_bf16(silu_mul(g1[2], u1[2]), silu_mul(g1[3], u1[3]));
                if (probe != 1 || w.x == 0x12345678u) *(u32x4*)rowp = w; }
    }
};
struct EpiMoeDown {
    static constexpr bool PERM = true;
    bf16_t* Y; int ldc; int nNl; const float* glist; const int* cnt; int S_cap; bf16_t* P;
    __device__ __forceinline__ void operator()(const f32x4 (&acc)[2][2][4][2], const Unit& u, int wr, int wc, int fr, int fq, int lane, PG8_LAS float* xl) const {
        const int pnl = u.pn - u.e * nNl; const int n = cnt[u.e * CNT_STRIDE];
        const int r0 = wr * 64 + fr;
        char* const tbase = u.tail ? (char*)(P + (size_t)(u.tail - 1) * BM * BM) : (char*)(Y + (size_t)u.pm * BM * ldc + pnl * BM);
        const unsigned pitch = u.tail ? (unsigned)BM : (unsigned)ldc;
        float gtv[2][4];
#pragma unroll
        for (int ai = 0; ai < 2; ++ai)
#pragma unroll
            for (int m = 0; m < 4; ++m) { const int slot = u.lt * 256 + r0 + ai * HALF + m * 16; gtv[ai][m] = slot < n ? glist[(size_t)u.e * S_cap + slot] : 0.f; }
#pragma unroll
        for (int ai = 0; ai < 2; ++ai)
#pragma unroll
            for (int m = 0; m < 4; ++m) { const int r = r0 + ai * HALF + m * 16;
                const float gt = gtv[ai][m];
                bf16_t* rowp = (bf16_t*)(tbase + ((unsigned)r * pitch + (unsigned)(wc * 32 + 8 * fq)) * 2u);
#pragma unroll
                for (int bj = 0; bj < 2; ++bj) { const f32x4 v0 = acc[ai][bj][m][0] * gt, v1 = acc[ai][bj][m][1] * gt;
                    u32x4 w; w.x = cvt_pk_bf16(v0[0], v0[1]); w.y = cvt_pk_bf16(v0[2], v0[3]); w.z = cvt_pk_bf16(v1[0], v1[1]); w.w = cvt_pk_bf16(v1[2], v1[3]);
                    *(u32x4*)(rowp + bj * HALF) = w; } }
    }
};

template <class Epi, class Sched, bool GATHER, bool KS = false>
__device__ __forceinline__ void gemm_phase(PG8_LAS unsigned char* lds, const Gemm g, const Sched& S, const Epi& E, const int wid_in, PG8_LAS float* xlds) {
    int wid_ = wid_in; asm volatile("" : "+s"(wid_)); const int wid = wid_;
    int lane_; asm volatile("v_mbcnt_lo_u32_b32 %0, -1, 0\n\tv_mbcnt_hi_u32_b32 %0, -1, %0" : "=v"(lane_));
    const int lane = lane_, tid = wid * 64 + lane, wr = wid >> 2, wc = wid & 3, fr = lane & 15, fq = lane >> 4;
    const int K = g.K; int nt = K / BK;
    unsigned voffA[2], voffB[2]; int Rg[2];
#pragma unroll
    for (int i = 0; i < 2; ++i) { int R, C; stage_rc(tid * 16 + i * 8192, R, C); const int Rb = Epi::PERM ? ((R & ~31) + perm32(R & 31)) : R;
        voffA[i] = GATHER ? (unsigned)(C * 2) : (unsigned)(R * g.lda + C) * 2u; voffB[i] = (unsigned)(Rb * K + C) * 2u; Rg[i] = R; }
    const size_t kstep = (size_t)(BK * 2);
    const size_t hstep = (size_t)HALF * K * 2;
    const size_t tstep = 2 * hstep;
    const size_t hstepA = (size_t)HALF * g.lda * 2, tstepA = 2 * hstepA;
    const unsigned ldsw = (unsigned)wid * 1024u;
    const int aoff = lds_byte(wr * 64 + fr, fq * 8), boff = lds_byte(wc * 32 + fr, fq * 8);
#define PG8_SA(b, h) (((b) * 2 + (h)) * HTB)
#define PG8_SB(b, h) ((4 + (b) * 2 + (h)) * HTB)
#define PG8_STAGE(bufoff, gbase, voff) do { _Pragma("unroll") for (int _i = 0; _i < 2; ++_i) \
        __builtin_amdgcn_global_load_lds((const unsigned*)((const char*)(gbase) + (voff)[_i]), (PG8_LAS unsigned*)(lds + (bufoff) + ldsw + _i * 8192), 16, 0, 0); } while (0)
#define PG8_STA(bufoff, pbase, gbase, half, goff) do { if constexpr (GATHER) PG8_STAGE(bufoff, gbase, (goff)[half]); else PG8_STAGE(bufoff, (pbase) + (half) * hstepA, voffA); } while (0)
#define PG8_LDA(dst, b, h) do { _Pragma("unroll") for (int m = 0; m < 4; ++m) _Pragma("unroll") for (int k = 0; k < 2; ++k) dst[m][k] = *(const PG8_LAS bf16x8*)(lds + PG8_SA(b, h) + aoff + m * 2048 + k * 1024); } while (0)
#define PG8_LDB(dst, b, h) do { _Pragma("unroll") for (int n = 0; n < 2; ++n) _Pragma("unroll") for (int k = 0; k < 2; ++k) dst[n][k] = *(const PG8_LAS bf16x8*)(lds + PG8_SB(b, h) + boff + n * 2048 + k * 1024); } while (0)
#define PG8_MMA(ai, bj, At, Bt) do { __builtin_amdgcn_s_setprio(1); _Pragma("unroll") for (int m = 0; m < 4; ++m) _Pragma("unroll") for (int n = 0; n < 2; ++n) _Pragma("unroll") for (int k = 0; k < 2; ++k) \
        acc[ai][bj][m][n] = __builtin_amdgcn_mfma_f32_16x16x32_bf16(Bt[n][k], At[m][k], acc[ai][bj][m][n], 0, 0, 0); __builtin_amdgcn_s_setprio(0); } while (0)
#define PG8_WAIT_V(n) asm volatile("s_waitcnt vmcnt(" #n ")" ::: "memory")
#define PG8_WAIT_L(n) asm volatile("s_waitcnt lgkmcnt(" #n ")" ::: "memory")
#define PG8_BAR __builtin_amdgcn_s_barrier()
#define PG8_SCHED __builtin_amdgcn_sched_barrier(0)
#define PG8_GFILL(u, o) do { _Pragma("unroll") for (int _h = 0; _h < 2; ++_h) _Pragma("unroll") for (int _i = 0; _i < 2; ++_i) (o)[_h][_i] = S.a_off(u, _h * HALF + Rg[_i]) + voffA[_i]; } while (0)
    Unit cur, nxt; int ui = 0;
    if (!S.next(0, cur)) return;
    f32x4 acc[2][2][4][2];
#pragma unroll
    for (int a = 0; a < 2; ++a)
#pragma unroll
        for (int b = 0; b < 2; ++b)
#pragma unroll
            for (int m = 0; m < 4; ++m)
#pragma unroll
                for (int n = 0; n < 2; ++n) acc[a][b][m][n] = (f32x4){0.f, 0.f, 0.f, 0.f};
    bf16x8 At[4][2], B0[2][2], B1[2][2];
    unsigned gc[2][2] = {{0u, 0u}, {0u, 0u}}, gn[2][2] = {{0u, 0u}, {0u, 0u}};
    if constexpr (GATHER) PG8_GFILL(cur, gc);
    if constexpr (KS) nt = cur.nkt;
    const char* const gA = (const char*)g.A;
    const char* cA = GATHER ? gA : gA + (size_t)cur.pm * tstepA + (KS ? (size_t)cur.kt0 * kstep : 0); const char* cB = (const char*)g.Bt + (size_t)cur.pn * tstep + (KS ? (size_t)cur.kt0 * kstep : 0);
    PG8_STAGE(PG8_SB(0, 0), cB, voffB); PG8_STAGE(PG8_SB(0, 1), cB + hstep, voffB); PG8_STA(PG8_SA(0, 0), cA, gA, 0, gc); PG8_STA(PG8_SA(0, 1), cA, gA, 1, gc);
    if (wr == 1) PG8_BAR;
    PG8_WAIT_V(2); PG8_BAR;
    PG8_STAGE(PG8_SB(1, 0), cB + kstep, voffB); PG8_STA(PG8_SA(1, 0), cA + kstep, gA + kstep, 0, gc); PG8_STAGE(PG8_SB(1, 1), cB + hstep + kstep, voffB);
    PG8_WAIT_V(6); PG8_BAR;
    for (;;) {
        const bool has_next = S.next(ui + 1, nxt);
        if constexpr (GATHER) { if (has_next) PG8_GFILL(nxt, gn); else {
#pragma unroll
            for (int h = 0; h < 2; ++h)
#pragma unroll
                for (int i = 0; i < 2; ++i) gn[h][i] = gc[h][i]; } }
        const char* nA = (has_next && !GATHER) ? gA + (size_t)nxt.pm * tstepA + (KS ? (size_t)nxt.kt0 * kstep : 0) : cA; const char* nB = has_next ? (const char*)g.Bt + (size_t)nxt.pn * tstep + (KS ? (size_t)nxt.kt0 * kstep : 0) : cB;
        for (int t = 0; t < nt; t += 2) {
#ifdef KLOOP_ALIGN
            asm volatile(".p2align 6\n\t.rept " KLOOP_ALIGN "\n\ts_nop 0\n\t.endr");
#endif
            const bool last = (t == nt - 2);
            const char* a1 = cA + (size_t)(t + 1) * kstep;
            const char* a2 = last ? nA : cA + (size_t)(t + 2) * kstep; const char* b2 = last ? nB : cB + (size_t)(t + 2) * kstep;
            const char* a3 = a2 + kstep; const char* b3 = b2 + kstep;
            unsigned gs[2][2];
#pragma unroll
            for (int h = 0; h < 2; ++h)
#pragma unroll
                for (int i = 0; i < 2; ++i) gs[h][i] = last ? gn[h][i] : gc[h][i];
            PG8_LDB(B0, 0, 0); PG8_LDB(B1, 0, 1); PG8_SCHED; PG8_LDA(At, 0, 0); PG8_STA(PG8_SA(1, 1), a1, a1, 1, gc);
            PG8_WAIT_V(8); PG8_WAIT_L(0); PG8_BAR; PG8_MMA(0, 0, At, B0); PG8_MMA(0, 1, At, B1); PG8_BAR; PG8_SCHED;
            PG8_LDA(At, 0, 1); PG8_STAGE(PG8_SB(0, 0), b2, voffB); PG8_STAGE(PG8_SB(0, 1), b2 + hstep, voffB); PG8_STA(PG8_SA(0, 0), a2, a2, 0, gs);
            PG8_WAIT_V(8); PG8_WAIT_L(0); PG8_BAR; PG8_MMA(1, 0, At, B0); PG8_MMA(1, 1, At, B1); PG8_BAR; PG8_SCHED;
            PG8_LDB(B0, 1, 0); PG8_LDB(B1, 1, 1); PG8_SCHED; PG8_LDA(At, 1, 0); PG8_STA(PG8_SA(0, 1), a2, a2, 1, gs);
            PG8_WAIT_V(8); PG8_WAIT_L(0); PG8_BAR; PG8_MMA(0, 0, At, B0); PG8_MMA(0, 1, At, B1); PG8_BAR; PG8_SCHED;
            PG8_LDA(At, 1, 1); PG8_STAGE(PG8_SB(1, 0), b3, voffB); PG8_STAGE(PG8_SB(1, 1), b3 + hstep, voffB); PG8_STA(PG8_SA(1, 0), a3, a3, 0, gs);
            PG8_WAIT_V(8); PG8_WAIT_L(0); PG8_BAR; PG8_MMA(1, 0, At, B0); PG8_MMA(1, 1, At, B1); PG8_BAR; PG8_SCHED;
        }
        if (wr == 0) PG8_BAR;
        E(acc, cur, wr, wc, fr, fq, lane, xlds);
        if (!has_next) break;
#pragma unroll
        for (int a = 0; a < 2; ++a)
#pragma unroll
            for (int b = 0; b < 2; ++b)
#pragma unroll
                for (int m = 0; m < 4; ++m)
#pragma unroll
                    for (int n = 0; n < 2; ++n) acc[a][b][m][n] = (f32x4){0.f, 0.f, 0.f, 0.f};
        cur = nxt; cA = nA; cB = nB; ++ui; if constexpr (KS) nt = cur.nkt;
#pragma unroll
        for (int h = 0; h < 2; ++h)
#pragma unroll
            for (int i = 0; i < 2; ++i) gc[h][i] = gn[h][i];
        if (wr == 1) PG8_BAR;
    }
    PG8_WAIT_V(0);
    PG8_BAR;
#undef PG8_SA
#undef PG8_SB
#undef PG8_STAGE
#undef PG8_STA
#undef PG8_LDA
#undef PG8_LDB
#undef PG8_MMA
#undef PG8_WAIT_V
#undef PG8_WAIT_L
#undef PG8_BAR
#undef PG8_SCHED
#undef PG8_GFILL
}
}
namespace att {
#define ALAS __attribute__((address_space(3)))
typedef unsigned short bf16_t;
typedef short bf16x8 __attribute__((ext_vector_type(8)));
typedef short s16x4 __attribute__((ext_vector_type(4)));
typedef float f32x16 __attribute__((ext_vector_type(16)));
typedef float f32x4 __attribute__((ext_vector_type(4)));
typedef unsigned u32x4 __attribute__((ext_vector_type(4)));
typedef ALAS char* lptr;
constexpr int NW = 8, QBLK = 32, KVBLK = 64, QB = NW * QBLK;
constexpr int SHM_V = KVBLK * 128 * 2;
constexpr int TBL_U0 = 2400, TBL_N = 2688;
constexpr float THR = 8.f;

template <int DQK_, int QP_, int KP_, int VP_, int OP_, bool TBL_, int LP_ = 0, int JMIN_ = 0> struct Cfg {
    static constexpr int DQK = DQK_, QP = QP_, KP = KP_, VP = VP_, OP = OP_, LP = LP_, JMIN = JMIN_; static constexpr bool TBL = TBL_;
    static constexpr int ND = DQK / 16, NKC = DQK / 64, KROW = DQK * 2, SHM_K = KVBLK * DQK * 2;
    static constexpr float SCALE = (DQK == 128) ? 0.08838834764831845f : 0.07216878364870323f;
    static constexpr int OFF_K = 0, OFF_V = 2 * SHM_K, OFF_WS = 2 * SHM_V + 2 * SHM_K;
    static constexpr int OFF_TBL = OFF_WS + NW * 64 * 4, OFF_QR = OFF_TBL + (TBL ? TBL_N * 4 : 0), LDS_BYTES = OFF_QR + (DQK > 128 ? NW * 4096 : 0);
    static_assert(LDS_BYTES <= 131072, "attention LDS");
};

#define SBAR() __builtin_amdgcn_sched_barrier(0)
__device__ __forceinline__ int v_st(int k, int c) { const int kk = (k & ~0xC) | ((k & 4) << 1) | ((k & 8) >> 1); return ((kk >> 3) * 4 + (c >> 5)) * 512 + ((kk & 7) * 32 + (c & 31)) * 2; }
__device__ __forceinline__ int v_rd_base(int lane) { return ((lane & 3) << 3) | (((lane >> 2) & 3) << 6) | (((lane >> 4) & 1) << 5) | (((lane >> 5) & 1) << 8); }
constexpr int v_rd_off(int d0, int ks, int half) { return d0 * 512 + ks * 4096 + half * 2048; }
__device__ __forceinline__ int crow(int r, int hi) { return (r & 3) + 8 * (r >> 2) + 4 * hi; }
__device__ __forceinline__ unsigned cvtpk(float lo, float hi) { unsigned r; asm volatile("v_cvt_pk_bf16_f32 %0, %1, %2" : "=v"(r) : "v"(lo), "v"(hi)); return r; }
__device__ __forceinline__ bf16x8 ld8(const bf16_t* p) { return *reinterpret_cast<const bf16x8*>(p); }
__device__ __forceinline__ bf16x8 ld8u(const bf16_t* ubase, unsigned boff) { return *reinterpret_cast<const bf16x8*>((const char*)ubase + boff); }

__device__ __forceinline__ void mask_tile(f32x16& p0, f32x16& p1, int dq) {
    const float NEG = -__builtin_inff();
#pragma unroll
    for (int r = 0; r < 16; ++r) {
        const int c = (r & 3) + 8 * (r >> 2);
        if (dq - c < 0) p0[r] = NEG;
        if (dq - c - 32 < 0) p1[r] = NEG;
    }
}
__device__ __forceinline__ void table_tile(f32x16& p0, f32x16& p1, const ALAS float* tb) {
#pragma unroll
    for (int r = 0; r < 16; ++r) {
        const int c = (r & 3) + 8 * (r >> 2);
        p0[r] += tb[c]; p1[r] += tb[c + 32];
    }
}
template <class C>
__device__ __forceinline__ void partialSM(f32x16& p0, f32x16& p1, float& m_reg, float& mn, float& alpha) {
    float pmax = p0[0];
#pragma unroll
    for (int r = 1; r < 16; ++r) pmax = fmaxf(pmax, p0[r]);
#pragma unroll
    for (int r = 0; r < 16; ++r) pmax = fmaxf(pmax, p1[r]);
    { auto rr = __builtin_amdgcn_permlane32_swap(__float_as_uint(pmax), __float_as_uint(pmax), false, false);
      pmax = fmaxf(__uint_as_float(rr[0]), __uint_as_float(rr[1])); }
    constexpr float C2 = 1.4426950408889634f * C::SCALE;
    if (__builtin_expect(__all((pmax - m_reg) * C::SCALE <= THR), 1)) { mn = m_reg; alpha = 1.f; }
    else { mn = fmaxf(m_reg, pmax); alpha = __builtin_amdgcn_exp2f((m_reg - mn) * C2); m_reg = mn; }
    const float mnL = -mn * C2;
#pragma unroll
    for (int r = 0; r < 16; ++r) p0[r] = fmaf(p0[r], C2, mnL);
#pragma unroll
    for (int r = 0; r < 16; ++r) p1[r] = fmaf(p1[r], C2, mnL);
#pragma unroll
    for (int r = 0; r < 16; ++r) p0[r] = __builtin_amdgcn_exp2f(p0[r]);
}
__device__ __forceinline__ void finishSM(f32x16& p0, f32x16& p1, float alpha, float& l_reg, bf16x8& pa0, bf16x8& pa1, bf16x8& pa2, bf16x8& pa3) {
#pragma unroll
    for (int r = 0; r < 16; ++r) p1[r] = __builtin_amdgcn_exp2f(p1[r]);
    float ps = 0;
#pragma unroll
    for (int r = 0; r < 16; ++r) ps += p0[r];
#pragma unroll
    for (int r = 0; r < 16; ++r) ps += p1[r];
    { auto rr = __builtin_amdgcn_permlane32_swap(__float_as_uint(ps), __float_as_uint(ps), false, false);
      ps = __uint_as_float(rr[0]) + __uint_as_float(rr[1]); }
    l_reg = l_reg * alpha + ps;
#define PK4(P, B_, OUT) do { unsigned a0 = cvtpk(P[B_+0], P[B_+1]), a1 = cvtpk(P[B_+2], P[B_+3]);                          \
        unsigned b0 = cvtpk(P[B_+4], P[B_+5]), b1 = cvtpk(P[B_+6], P[B_+7]);                                             \
        auto r0 = __builtin_amdgcn_permlane32_swap(a0, b0, false, false); auto r1 = __builtin_amdgcn_permlane32_swap(a1, b1, false, false); \
        u32x4 w = {r0[0], r1[0], r0[1], r1[1]}; OUT = *reinterpret_cast<bf16x8*>(&w); } while (0)
    PK4(p0, 0, pa0); PK4(p0, 8, pa1); PK4(p1, 0, pa2); PK4(p1, 8, pa3);
#undef PK4
}
template <class C, int KB>
__device__ __forceinline__ void qkt(f32x16& p0, f32x16& p1, lptr K_lds, int r32, int hi, const bf16x8* qr, lptr qlds) {
    p0 = f32x16{}; p1 = f32x16{};
    lptr kb[4];
#pragma unroll
    for (int dd = 0; dd < 4; ++dd) {
        const int sw = (C::DQK == 128) ? (r32 & 7) : ((r32 >> 1) & 7);
        kb[dd] = K_lds + KB * C::SHM_K + r32 * C::KROW + 16 * ((2 * dd + hi) ^ sw);
    }
#pragma unroll
    for (int d0 = 0; d0 < C::ND; ++d0) { lptr a = kb[d0 & 3] + (d0 >> 2) * 128;
        bf16x8 b0 = *reinterpret_cast<const ALAS bf16x8*>(a);
        bf16x8 b1 = *reinterpret_cast<const ALAS bf16x8*>(a + 32 * C::KROW);
        bf16x8 q; if (d0 < 8) q = qr[d0]; else q = *reinterpret_cast<const ALAS bf16x8*>(qlds + (d0 - 8) * 1024);
        p0 = __builtin_amdgcn_mfma_f32_32x32x16_bf16(b0, q, p0, 0, 0, 0);
        p1 = __builtin_amdgcn_mfma_f32_32x32x16_bf16(b1, q, p1, 0, 0, 0); }
}
template <int VB>
__device__ __forceinline__ void pv_tile(f32x16* o, int vb0, bf16x8 pa0, bf16x8 pa1, bf16x8 pa2, bf16x8 pa3) {
#define TRRD(dst, off) asm volatile("ds_read_b64_tr_b16 %0, %1 offset:%2" : "=&v"(dst) : "v"(vb0), "i"(off) : "memory")
#define PV_D0(d0) do { s16x4 l0, l1, l2, l3, h0, h1, h2, h3; constexpr int b_ = VB * SHM_V + v_rd_off(d0, 0, 0); \
        TRRD(l0, b_); TRRD(h0, b_ + 2048); TRRD(l1, b_ + 4096); TRRD(h1, b_ + 6144); TRRD(l2, b_ + 8192); TRRD(h2, b_ + 10240); TRRD(l3, b_ + 12288); TRRD(h3, b_ + 14336); \
        asm volatile("s_waitcnt lgkmcnt(0)" ::: "memory"); SBAR();   \
        o[d0] = __builtin_amdgcn_mfma_f32_32x32x16_bf16(pa0, (bf16x8){l0[0], l0[1], l0[2], l0[3], h0[0], h0[1], h0[2], h0[3]}, o[d0], 0, 0, 0);   \
        o[d0] = __builtin_amdgcn_mfma_f32_32x32x16_bf16(pa1, (bf16x8){l1[0], l1[1], l1[2], l1[3], h1[0], h1[1], h1[2], h1[3]}, o[d0], 0, 0, 0);   \
        o[d0] = __builtin_amdgcn_mfma_f32_32x32x16_bf16(pa2, (bf16x8){l2[0], l2[1], l2[2], l2[3], h2[0], h2[1], h2[2], h2[3]}, o[d0], 0, 0, 0);   \
        o[d0] = __builtin_amdgcn_mfma_f32_32x32x16_bf16(pa3, (bf16x8){l3[0], l3[1], l3[2], l3[3], h3[0], h3[1], h3[2], h3[3]}, o[d0], 0, 0, 0); } while (0)
    PV_D0(0); PV_D0(1); PV_D0(2); PV_D0(3);
#undef PV_D0
#undef TRRD
}

struct BlockRef { const bf16_t* Q; const bf16_t* K; const bf16_t* V; bf16_t* O; float* lse; int P0; };
template <class C> struct Seam { bf16x8 qr[C::ND]; bf16x8 st_v0, st_v1; bf16x8 st_k[C::NKC]; };
__device__ __forceinline__ int swa_jlo(int P0, int W) { const int lowk = P0 - W + 1; return lowk > 0 ? lowk / KVBLK : 0; }

#define VMW() asm volatile("s_waitcnt vmcnt(0)" ::: "memory")
#define VMWN(n) asm volatile("s_waitcnt vmcnt(%0)" :: "i"(n) : "memory")
#define SLOAD_H(Kp, Vp, k0) do { const bf16_t* vu_ = (Vp) + (size_t)(k0) * C::VP; const bf16_t* ku_ = (Kp) + (size_t)(k0) * C::KP;                        \
        S.st_v0 = ld8u(vu_, voffV); S.st_v1 = ld8u(vu_ + 32 * C::VP, voffV);     \
        if constexpr (C::DQK == 128) { S.st_k[0] = ld8u(ku_, voffK); S.st_k[1] = ld8u(ku_ + 32 * C::KP, voffK); } \
        else { _Pragma("unroll") for (int i_ = 0; i_ < 3; ++i_) S.st_k[i_] = ld8u(ku_ + 64 * i_, voffK); } } while (0)
#define SWRITE_HK(bf) do { if constexpr (C::DQK == 128) { *(ALAS bf16x8*)(K_lds + (bf) * C::SHM_K + kws) = S.st_k[0]; *(ALAS bf16x8*)(K_lds + (bf) * C::SHM_K + kws + 32 * 256) = S.st_k[1]; } \
        else { _Pragma("unroll") for (int i_ = 0; i_ < 3; ++i_) *(ALAS bf16x8*)(K_lds + (bf) * C::SHM_K + kws + 128 * i_) = S.st_k[i_]; } } while (0)
#define SWRITE_HV(bf) do { *(ALAS bf16x8*)(V_lds + (bf) * SHM_V + vst0) = S.st_v0; *(ALAS bf16x8*)(V_lds + (bf) * SHM_V + vst1) = S.st_v1; } while (0)
#define SWRITE_H(bf) do { SWRITE_HV(bf); SWRITE_HK(bf); } while (0)
#define ATT_IDX() int lane_; asm volatile("v_mbcnt_lo_u32_b32 %0, -1, 0\n\tv_mbcnt_hi_u32_b32 %0, -1, %0" : "=v"(lane_)); const int lane = lane_, tid = wid * 64 + lane, r32 = lane & 31, hi = lane >> 5; \
    const int sr = tid >> 4, sc = (tid & 15) * 8, kr = tid >> 3, kc = (tid & 7) * 8; \
    const int kws = (C::DQK == 128) ? (sr * 256 + ((sc * 2) ^ ((sr & 7) << 4))) : (kr * 384 + 16 * ((tid & 7) ^ ((kr >> 1) & 7))); \
    const unsigned voffV = (unsigned)(sr * C::VP + sc) * 2u, voffK = (C::DQK == 128) ? (unsigned)(sr * C::KP + sc) * 2u : (unsigned)(kr * C::KP + kc) * 2u, voffQ = (unsigned)((wid * QBLK + r32) * C::QP + hi * 8) * 2u; \
    (void)wid; (void)lane; (void)r32; (void)hi; (void)kr; (void)kc; (void)sr; (void)sc; (void)kws; (void)voffV; (void)voffK; (void)voffQ

template <class C>
__device__ __forceinline__ void prime(const BlockRef& cur, int W, lptr lds, Seam<C>& S, const int wid) {
    ATT_IDX(); lptr K_lds = lds + C::OFF_K;
    const int kb0 = swa_jlo(cur.P0, W) * KVBLK;
#pragma unroll
    for (int d0 = 0; d0 < C::ND; ++d0) S.qr[d0] = ld8u(cur.Q + d0 * 16, voffQ);
    SLOAD_H(cur.K, cur.V, kb0); VMW(); SWRITE_HK(0);
    __syncthreads();
}
template <class C>
__device__ __forceinline__ void block(const BlockRef& cur, const BlockRef& nxt, int skv, int W, lptr lds, Seam<C>& S, const int wid) {
    ATT_IDX();
    const int j_lo = swa_jlo(cur.P0, W);
    int j_hi = (cur.P0 + QB - 1 - C::JMIN) / KVBLK + 1; if (j_hi > skv / KVBLK) j_hi = skv / KVBLK;
    const int NT = j_hi - j_lo;
    const int kbn = swa_jlo(nxt.P0, W) * KVBLK;
    const int qlo = cur.P0 + wid * QBLK, qm = qlo + r32 - 4 * hi;
    lptr V_lds = lds + C::OFF_V; lptr K_lds = lds + C::OFF_K;
    ALAS float* ws = (ALAS float*)(lds + C::OFF_WS) + wid * 64; ALAS float* li_l = ws; ALAS float* al_l = ws + 32;
    const ALAS float* tbl = (const ALAS float*)(lds + C::OFF_TBL);
    float m_reg = -1e30f, l_reg = 0; f32x16 o[4] = {};
    const int vst0 = v_st(sr, sc), vst1 = v_st(32 + sr, sc);
    const int vb0 = (int)(unsigned)(uintptr_t)V_lds + v_rd_base(lane);
    const bf16_t* Kh = cur.K; const bf16_t* Vh = cur.V;
#define RESC(a) do { if (__any((a) < 1.f)) { if (hi == 0) al_l[r32] = (a); asm volatile("s_waitcnt lgkmcnt(0)" ::: "memory");              \
                     _Pragma("unroll") for (int d_ = 0; d_ < 4; ++d_) _Pragma("unroll") for (int r = 0; r < 16; ++r) o[d_][r] *= al_l[crow(r, hi)]; } } while (0)
#define KBASE(t) ((j_lo + (t)) * KVBLK)
#define MASKT(P0_, P1_, t) do { const int kb_ = KBASE(t); if constexpr (C::TBL) { table_tile(P0_, P1_, tbl + (TBL_U0 - (qm - kb_))); } \
                                else { if (kb_ + KVBLK - 1 > qlo) mask_tile(P0_, P1_, qm - kb_); } } while (0)
#define SEAM_K0() do { VMWN(C::ND); SWRITE_HK(0); SBAR(); } while (0)
    f32x16 pA0, pA1, pB0, pB1; float mnA, mnB, alA, alB; bf16x8 pa0, pa1, pa2, pa3;
    lptr qlds = lds + C::OFF_QR + wid * 4096 + lane * 16;
    if constexpr (C::DQK > 128) {
#pragma unroll
        for (int d0 = 8; d0 < C::ND; ++d0) *reinterpret_cast<ALAS bf16x8*>(qlds + (d0 - 8) * 1024) = S.qr[d0]; }
    SWRITE_HV(0); SBAR();
    if (NT > 1) { SLOAD_H(Kh, Vh, KBASE(1)); }
    SBAR(); qkt<C, 0>(pA0, pA1, K_lds, r32, hi, S.qr, qlds);
    MASKT(pA0, pA1, 0); partialSM<C>(pA0, pA1, m_reg, mnA, alA);
    if (NT > 1) { VMW(); SWRITE_H(1); }
    __syncthreads();
#define HALF_STEP(PX0, PX1, mnX, alX, PY0, PY1, alY, t, KB, VB, SB) do {                                                      \
        SBAR(); qkt<C, KB>(PX0, PX1, K_lds, r32, hi, S.qr, qlds);                                                                   \
        finishSM(PY0, PY1, alY, l_reg, pa0, pa1, pa2, pa3); SBAR();                                                           \
        if ((t) + 1 < NT) { SLOAD_H(Kh, Vh, KBASE((t) + 1)); SBAR(); }                                                        \
        pv_tile<VB>(o, vb0, pa0, pa1, pa2, pa3); MASKT(PX0, PX1, (t)); partialSM<C>(PX0, PX1, m_reg, mnX, alX);               \
        __syncthreads();                                                                                                      \
        if ((t) + 1 < NT) { VMW(); SWRITE_H(SB); }                                                                            \
        RESC(alX); __syncthreads(); } while (0)
    for (int t = 1; t + 1 < NT; t += 2) {
#ifdef ALOOP_ALIGN
        asm volatile(".p2align 6\n\t.rept " ALOOP_ALIGN "\n\ts_nop 0\n\t.endr");
#endif
#ifdef ALOOP_ALIGN3
        if constexpr (C::DQK == 192) asm volatile(".p2align 6\n\t.rept " ALOOP_M "\n\ts_nop 0\n\t.endr"); else if constexpr (C::JMIN == 0) asm volatile(".p2align 6\n\t.rept " ALOOP_A "\n\ts_nop 0\n\t.endr"); else asm volatile(".p2align 6\n\t.rept " ALOOP_B "\n\ts_nop 0\n\t.endr");
#endif
        HALF_STEP(pB0, pB1, mnB, alB, pA0, pA1, alA, t, 1, 0, 0);
        HALF_STEP(pA0, pA1, mnA, alA, pB0, pB1, alB, t + 1, 0, 1, 1);
    }
    {
    int lane2_; asm volatile("v_mbcnt_lo_u32_b32 %0, -1, 0\n\tv_mbcnt_hi_u32_b32 %0, -1, %0" : "=v"(lane2_));
    const int lane = lane2_, r32 = lane & 31, hi = lane >> 5, qm = qlo + r32 - 4 * hi;
    const unsigned voffQ = (unsigned)((wid * QBLK + r32) * C::QP + hi * 8) * 2u;
    lptr qlds = lds + C::OFF_QR + wid * 4096 + lane * 16; (void)qlds; (void)qm;
    const bool even = (NT & 1) == 0;
    if (even) { SBAR(); qkt<C, 1>(pB0, pB1, K_lds, r32, hi, S.qr, qlds); SBAR(); }
    SLOAD_H(nxt.K, nxt.V, kbn); SBAR();
#pragma unroll
    for (int d0 = 0; d0 < C::ND; ++d0) S.qr[d0] = ld8u(nxt.Q + d0 * 16, voffQ);
    SBAR();
    finishSM(pA0, pA1, alA, l_reg, pa0, pa1, pa2, pa3); SBAR();
    pv_tile<0>(o, vb0, pa0, pa1, pa2, pa3);
    if (even) { MASKT(pB0, pB1, NT - 1); partialSM<C>(pB0, pB1, m_reg, mnB, alB); __syncthreads(); RESC(alB);
        finishSM(pB0, pB1, alB, l_reg, pa0, pa1, pa2, pa3); SBAR(); pv_tile<1>(o, vb0, pa0, pa1, pa2, pa3); }
    SBAR(); SEAM_K0();
    if (hi == 0) li_l[r32] = l_reg; asm volatile("s_waitcnt lgkmcnt(0)" ::: "memory");
    float rli[16];
#pragma unroll
    for (int r = 0; r < 16; ++r) { const float lv = li_l[crow(r, hi)]; rli[r] = lv > 0.f ? __builtin_amdgcn_rcpf(lv) : 0.f; }
    if constexpr (C::LP > 0) { if (hi == 0) cur.lse[(size_t)(wid * QBLK + r32) * C::LP] = l_reg > 0.f ? m_reg * C::SCALE + __logf(l_reg) : -__builtin_inff(); }
    char* const Ou = (char*)cur.O;
    const unsigned ooff = (unsigned)((wid * QBLK + 4 * hi) * C::OP + r32) * 2u;
#pragma unroll
    for (int r = 0; r < 16; ++r) { const int orow = (r & 3) + 8 * (r >> 2);
#pragma unroll
        for (int d0 = 0; d0 < 4; ++d0) { const float v = o[d0][r] * rli[r];
            const float vn = __builtin_bit_cast(float, __builtin_amdgcn_mov_dpp(__builtin_bit_cast(int, v), 0xB1, 0xF, 0xF, true));
            if ((r32 & 1) == 0) *(unsigned*)(Ou + ooff + (unsigned)(orow * C::OP + d0 * 32) * 2u) = cvtpk(v, vn); } }
    }
    __syncthreads();
#undef RESC
#undef KBASE
#undef MASKT
#undef SEAM_K0
#undef HALF_STEP
}
#undef VMW
#undef VMWN
#undef SLOAD_H
#undef SWRITE_HK
#undef SWRITE_HV
#undef SWRITE_H
#undef ATT_IDX
#undef SBAR
}
constexpr int NWAVES = 8;
constexpr int S_ = 16384, DM = 2048, NLAYER = 2;
constexpr int WA = 1024, QLORA = 512, KVLORA = 256, ROPE = 64, INC = 3904, INP = 4096;
constexpr int C_QA = 0, C_KA = 1024, C_VA = 2048, C_CQ = 3072, C_CKV = 3584, C_KR = 3840;
constexpr int NH = 8, HD = 128, QKB = 192, NQB_ = 1536  , NKVB = 2048  ;
constexpr int FF = 5632, NEXP = 8, NGU = 2 * FF  , NT_GU = NGU / 256  , NT_D = DM / 256  ;
constexpr int MT_MAX = 136;
constexpr float EPS = 1e-6f;
constexpr int W_DIL = 2049;
constexpr int W_CAUSAL = 0x40000000;

constexpr size_t MiB = 1u << 20;
constexpr size_t WS_CTL = 0, CTL_ZERO_BYTES = 32 * 1024;
constexpr size_t WS_TBL = 1 * MiB;
constexpr size_t WS_POS = 1 * MiB + 512 * 1024;
constexpr size_t WS_LTOK = 2 * MiB;
constexpr size_t WS_LGATE = 2 * MiB + 512 * 1024;
constexpr size_t WS_SSQ0 = 3 * MiB;
constexpr size_t WS_SSQX = WS_SSQ0 + 64 * 1024;
constexpr size_t WS_SSQC = WS_SSQX + 1 * MiB;
static_assert(WS_SSQC + 256 * 1024 <= 6 * MiB, "ws map");
constexpr size_t WS_WIN = 6 * MiB;
constexpr size_t WS_WQB = WS_WIN + 32 * MiB;
constexpr size_t WS_WKVB = WS_WQB + 3 * MiB;
constexpr size_t WS_WOUT = WS_WKVB + 2 * MiB;
constexpr size_t WS_WGU = WS_WOUT + 16 * MiB;
constexpr size_t WS_WD = WS_WGU + 44 * MiB;
constexpr size_t WS_WGUE = WS_WD + 22 * MiB;
constexpr size_t WS_WDE = WS_WGUE + 352 * MiB;
constexpr size_t WS_H = WS_WDE + 176 * MiB;
constexpr size_t WS_ACTS = WS_H + 64 * MiB;
constexpr size_t WS_PROJ = WS_ACTS;
constexpr size_t WS_QM = WS_PROJ + 128 * MiB;
constexpr size_t WS_KVM = WS_QM + 48 * MiB;
constexpr size_t WS_KM = WS_KVM + 64 * MiB;
constexpr size_t WS_CQN = WS_KM + 48 * MiB;
constexpr size_t WS_CKVN = WS_CQN + 16 * MiB;
constexpr size_t WS_ATT = WS_CKVN + 8 * MiB;
constexpr size_t WS_OA = WS_ATT + 64 * MiB, WS_OB = WS_OA + 32 * MiB;
constexpr size_t WS_LSEA = WS_OB + 32 * MiB, WS_LSEB = WS_LSEA + 1 * MiB;
constexpr size_t WS_ACT = WS_ACTS;
constexpr size_t WS_Y = WS_ACT + 374 * MiB;
constexpr size_t WS_PT = WS_Y + 136 * MiB;
constexpr size_t WS_HN = WS_PT + 32 * MiB;
constexpr size_t WS_END = WS_HN + 64 * MiB;
static_assert(WS_LSEB + 1 * MiB <= WS_END, "ws map");
static_assert((size_t)MT_MAX * 256 * FF * 2 <= 374 * MiB && (size_t)MT_MAX * 256 * DM * 2 <= 136 * MiB, "ws map");
constexpr int CW_TMO = 0, CW_CODE = 1;
constexpr int CW_CNT = 64;
constexpr int CW_BAR = 4096;

constexpr int RING_OFF = 0, RING_BYTES = 131072;
constexpr int LDSCTL_OFF = RING_BYTES, MISC_OFF = LDSCTL_OFF + 320, XLDS_OFF = RING_BYTES + 1024;
constexpr int LDS_BYTES = 147456;
static_assert(MISC_OFF + 128 <= XLDS_OFF && XLDS_OFF + 8192 <= LDS_BYTES, "LDS map");

#define GAS __attribute__((address_space(1)))
#define LAS __attribute__((address_space(3)))
typedef unsigned short bf16;
typedef unsigned v4u __attribute__((ext_vector_type(4)));
typedef unsigned v2u __attribute__((ext_vector_type(2)));
typedef float f32x4 __attribute__((ext_vector_type(4)));
typedef GAS unsigned gu32;
#define RLX_AGENT __ATOMIC_RELAXED, __HIP_MEMORY_SCOPE_AGENT
#define LDS_WAIT() asm volatile("s_waitcnt lgkmcnt(0)" ::: "memory")
#define VM_WAIT() asm volatile("s_waitcnt vmcnt(0)" ::: "memory")
__device__ __forceinline__ unsigned f2bf(float f) { unsigned u = __builtin_bit_cast(unsigned, f); return (u + 0x7fffu + ((u >> 16) & 1u)) >> 16; }
__device__ __forceinline__ unsigned pk2(float lo, float hi) { return f2bf(lo) | (f2bf(hi) << 16); }
__device__ __forceinline__ float bflo(unsigned w) { return __builtin_bit_cast(float, w << 16); }
__device__ __forceinline__ float bfhi(unsigned w) { return __builtin_bit_cast(float, w & 0xffff0000u); }

#define XB_TMO      128
#define XB_XCNT(j)  (256  + 64 * (j))
#define XB_XSUB(j)  (1280 + 64 * (j))
#define XB_XGEN(j)  (2304 + 64 * (j))
#define XB_TOP      3328
#define XB_TOPGEN   3392
#define XCD_BAR_WORDS 3456
#define XB_SPIN_CAP (1u << 20)
static_assert((size_t)(CW_BAR + XCD_BAR_WORDS) * 4 <= CTL_ZERO_BYTES && (size_t)(CW_CNT + 8 * 32) * 4 <= (size_t)CW_BAR * 4, "control words inside the zeroed region");

__device__ __forceinline__ unsigned xb_ld(gu32* p)              { return __hip_atomic_load(p, __ATOMIC_RELAXED, __HIP_MEMORY_SCOPE_AGENT); }
__device__ __forceinline__ unsigned xb_add(gu32* p, unsigned v) { return __hip_atomic_fetch_add(p, v, __ATOMIC_RELAXED, __HIP_MEMORY_SCOPE_AGENT); }
__device__ __forceinline__ unsigned xb_xcc_id() { return (unsigned)__builtin_amdgcn_s_getreg((3 << 11) | 20) & 0xFu; }
#define XB_SPIN(cond, bar) do { unsigned _sp = 0; while (cond) { __builtin_amdgcn_s_sleep(1); \
    if ((++_sp & 255u) == 0u) { if (xb_ld(&(bar)[XB_TMO])) break; if (_sp > XB_SPIN_CAP) { xb_add(&(bar)[XB_TMO], 1u); break; } } } } while (0)

struct XcdBarrier {
    gu32* bar; unsigned x;
    volatile LAS unsigned* st;
};
__device__ __forceinline__ XcdBarrier xcd_barrier_post(gu32* bar, volatile LAS unsigned* st) {
    XcdBarrier b; b.bar = bar; b.x = xb_xcc_id(); b.st = st;
    if (threadIdx.x == 0) (void)xb_add(&bar[XB_XCNT(b.x)], 1u);
    return b;
}
__device__ __forceinline__ void xcd_barrier_complete(gu32* bar, unsigned x, unsigned& nloc, unsigned& nx) {
    const unsigned G = gridDim.x * gridDim.y * gridDim.z;
    unsigned sum, cnt, mine, sp = 0u;
    for (;;) {
        sum = 0u; cnt = 0u; mine = 0u;
#pragma unroll
        for (unsigned j = 0; j < 16; ++j) { const unsigned c = xb_ld(&bar[XB_XCNT(j)]); sum += c; cnt += (c > 0u) ? 1u : 0u; mine = (j == x) ? c : mine; }
        if (sum == G) break;
        __builtin_amdgcn_s_sleep(1);
        if ((++sp & 255u) == 0u) { if (xb_ld(&bar[XB_TMO])) break; if (sp > XB_SPIN_CAP) { xb_add(&bar[XB_TMO], 1u); break; } }
    }
    nloc = mine > 0u ? mine : 1u; nx = cnt > 0u ? cnt : 1u;
}
__device__ __forceinline__ void xcd_barrier(const XcdBarrier& b) {
    asm volatile("s_waitcnt vmcnt(0)" ::: "memory");
    __syncthreads();
    if (threadIdx.x == 0) {
        gu32* bar = b.bar;
        __builtin_amdgcn_s_waitcnt(0);
        unsigned nloc = b.st[0], nx = b.st[1];
        if (nloc == 0u) { xcd_barrier_complete(bar, b.x, nloc, nx); b.st[0] = nloc; b.st[1] = nx; }
        const unsigned old = xb_add(&bar[XB_XSUB(b.x)], 1u);
        const unsigned gen = old / nloc;
        if (old + 1u == (gen + 1u) * nloc) {
            __builtin_amdgcn_fence(__ATOMIC_RELEASE, "agent");
            asm volatile("s_waitcnt vmcnt(0)" ::: "memory");
            const unsigned og = xb_add(&bar[XB_TOP], 1u);
            const unsigned tg = og / nx;
            if (og + 1u == (tg + 1u) * nx) xb_add(&bar[XB_TOPGEN], 1u);
            else XB_SPIN(xb_ld(&bar[XB_TOPGEN]) == tg, bar);
            __builtin_amdgcn_fence(__ATOMIC_ACQUIRE, "agent");
            xb_add(&bar[XB_XGEN(b.x)], 1u);
            asm volatile("s_waitcnt vmcnt(0)" ::: "memory");
        } else {
            XB_SPIN(xb_ld(&bar[XB_XGEN(b.x)]) == gen, bar);
            __builtin_amdgcn_fence(__ATOMIC_ACQUIRE, "agent");
            asm volatile("s_waitcnt vmcnt(0)" ::: "memory");
        }
    }
    __syncthreads();
}

struct Args { const void* in[22]; float* out; unsigned char* ws; int ph_lo, ph_hi, use_bar, pad; };
struct ArgsD { const GAS void* in[22]; GAS float* out; GAS unsigned char* ws; int ph_lo, ph_hi, use_bar, pad; };
static_assert(sizeof(ArgsD) == sizeof(Args), "ArgsD");
typedef const __attribute__((address_space(4))) ArgsD* KArgs;
__device__ __forceinline__ KArgs kargs() { KArgs p = (KArgs)__builtin_amdgcn_kernarg_segment_ptr(); asm volatile("" : "+s"(p)); return p; }
struct Frame {
    LAS unsigned char* lds;
    int vcu, G, wave;
};
#define PH_IDX() int lane_; asm volatile("v_mbcnt_lo_u32_b32 %0, -1, 0\n\tv_mbcnt_hi_u32_b32 %0, -1, %0" : "=v"(lane_)); const int lane = lane_, wave = F.wave, tid = wave * 64 + lane; (void)tid; (void)lane; (void)wave
__device__ __forceinline__ float shx(float v, int lane, int o) { return __builtin_bit_cast(float, __builtin_amdgcn_ds_bpermute((lane ^ o) << 2, __builtin_bit_cast(int, v))); }
__device__ __forceinline__ float wave_sum(float v, int lane) {
#pragma unroll
    for (int o = 1; o < 64; o <<= 1) v += shx(v, lane, o);
    return v;
}

template <bool GAIN>
__device__ __forceinline__ void xpose_item(const float* W, int K, int N, bf16* WT, int k0, int n0, int drow0, LAS float* scr, int lane, const float* gk) {
    float gl = 1.0f, gh = 1.0f; if constexpr (GAIN) { gl = gk[k0 + (lane & 31)]; gh = gk[k0 + 32 + (lane & 31)]; }
    float w[32];
    const GAS float* src = (const GAS float*)W + (size_t)(k0 + (lane >> 5)) * N + n0 + (lane & 31);
#pragma unroll
    for (int i = 0; i < 32; ++i) w[i] = __builtin_nontemporal_load(src + (size_t)(2 * i) * N);
#pragma unroll
    for (int i = 0; i < 32; ++i) { const int kk = 2 * i + (lane >> 5); float v = w[i];
        if constexpr (GAIN) { const float gsel = (i >= 16) ? gh : gl; v *= __builtin_bit_cast(float, __builtin_amdgcn_ds_bpermute((kk & 31) << 2, __builtin_bit_cast(int, gsel))); }
        scr[kk * 33 + (lane & 31)] = v; }
    LDS_WAIT(); asm volatile("" ::: "memory");
    const int c = lane & 7;
#pragma unroll
    for (int j = 0; j < 4; ++j) { const int n = (lane >> 3) + 8 * j; const LAS float* s = scr + (8 * c) * 33 + n;
        v4u o; o.x = pk2(s[0 * 33], s[1 * 33]); o.y = pk2(s[2 * 33], s[3 * 33]); o.z = pk2(s[4 * 33], s[5 * 33]); o.w = pk2(s[6 * 33], s[7 * 33]);
        __builtin_nontemporal_store(o, (GAS v4u*)(WT + (size_t)(drow0 + n) * K + k0 + 8 * c)); }
    LDS_WAIT(); asm volatile("" ::: "memory");
}
constexpr int IT_WIN1 = 32 * 122, IT_WQB1 = 8 * 48, IT_WKVB1 = 4 * 64, IT_WOUT1 = 32 * 64, IT_GU1 = 32 * 176, IT_D1 = 88 * 64;
constexpr int IT_EARLY = IT_WIN1 + IT_WQB1 + IT_WKVB1;
constexpr int IT_LATE = IT_WIN1 + IT_WQB1 + IT_WKVB1 + 2 * IT_WOUT1 + 2 * IT_GU1 + IT_D1 + 16 * IT_GU1 + 8 * IT_D1, IT_TOTAL = IT_EARLY + IT_LATE;
static_assert(IT_LATE % 2 == 0, "late items split in two halves");
__device__ __forceinline__ void conv_item(KArgs a, int it, LAS float* scr, int lane) {
    unsigned char* ws = (unsigned char*)a->ws;
    const float* W; bf16* WT; int K, N, kb, nb, drow0; const float* gk = nullptr;
    int l = 0; if (it >= IT_EARLY) { it -= IT_EARLY; l = 1; }
    if (it < IT_WIN1) { const int r = it; kb = r / 122; nb = r % 122; K = DM; N = INC; W = (const float*)a->in[4] + (size_t)l * DM * INC; WT = (bf16*)(ws + WS_WIN) + (size_t)l * INP * DM; drow0 = 32 * nb; gk = (const float*)a->in[3] + l * DM; }
    else if ((it -= IT_WIN1) < IT_WQB1) { const int r = it; kb = r / 48; nb = r % 48; K = QLORA; N = NQB_; W = (const float*)a->in[7] + (size_t)l * QLORA * NQB_; WT = (bf16*)(ws + WS_WQB) + (size_t)l * NQB_ * QLORA; drow0 = 32 * nb; gk = (const float*)a->in[5] + l * QLORA; }
    else if ((it -= IT_WQB1) < IT_WKVB1) { const int r = it; kb = r / 64; nb = r % 64; K = KVLORA; N = NKVB; W = (const float*)a->in[8] + (size_t)l * KVLORA * NKVB; WT = (bf16*)(ws + WS_WKVB) + (size_t)l * NKVB * KVLORA; drow0 = 32 * nb; }
    else if ((it -= IT_WKVB1) < 2 * IT_WOUT1) { const int lo = it / IT_WOUT1, r = it % IT_WOUT1; kb = r / 64; nb = r % 64; K = DM; N = DM; W = (const float*)a->in[13] + (size_t)lo * DM * DM; WT = (bf16*)(ws + WS_WOUT) + (size_t)lo * DM * DM; drow0 = 32 * nb; }
    else if ((it -= 2 * IT_WOUT1) < 2 * IT_GU1) { const int isup = it / IT_GU1, r = it % IT_GU1; kb = r / 176; nb = r % 176; K = DM; N = FF;
        W = isup ? (const float*)a->in[16] : (const float*)a->in[15]; WT = (bf16*)(ws + WS_WGU);
        const int n0 = 32 * nb; drow0 = 256 * (n0 >> 7) + (n0 & 127) + (isup ? 128 : 0); gk = (const float*)a->in[14]; }
    else if ((it -= 2 * IT_GU1) < IT_D1) { const int r = it; kb = r / 64; nb = r % 64; K = FF; N = DM; W = (const float*)a->in[17]; WT = (bf16*)(ws + WS_WD); drow0 = 32 * nb; }
    else if ((it -= IT_D1) < 16 * IT_GU1) { const int m = it / IT_GU1, r = it % IT_GU1; kb = r / 176; nb = r % 176; const int isup = m >> 3, e = m & 7; K = DM; N = FF;
        W = (isup ? (const float*)a->in[20] : (const float*)a->in[19]) + (size_t)e * DM * FF; WT = (bf16*)(ws + WS_WGUE) + (size_t)e * NGU * DM;
        const int n0 = 32 * nb; drow0 = 256 * (n0 >> 7) + (n0 & 127) + (isup ? 128 : 0); }
    else { it -= 16 * IT_GU1; const int e = it / IT_D1, r = it % IT_D1; kb = r / 64; nb = r % 64; K = FF; N = DM;
        W = (const float*)a->in[21] + (size_t)e * FF * DM; WT = (bf16*)(ws + WS_WDE) + (size_t)e * DM * FF; drow0 = 32 * nb; }
    if (gk) xpose_item<true>(W, K, N, WT, 64 * kb, 32 * nb, drow0, scr, lane, gk); else xpose_item<false>(W, K, N, WT, 64 * kb, 32 * nb, drow0, scr, lane, gk);
}
__device__ __forceinline__ void late_convert(Frame& F, KArgs a, int part) {
    PH_IDX();
    LAS float* scr = (LAS float*)(F.lds + RING_OFF + wave * 16384);
    const int bx = (int)blockIdx.x, cgw = ((bx >> 3) * 4 + (bx & 3)) * NWAVES + wave, CNGW = (F.G / 2) * NWAVES;
    for (int it = IT_EARLY + part * (IT_LATE / 2) + cgw; it < IT_EARLY + (part + 1) * (IT_LATE / 2); it += CNGW) conv_item(a, it, scr, lane);
}
__device__ __forceinline__ void p0_prologue(Frame& F, KArgs a) {
    PH_IDX();
    unsigned char* ws = (unsigned char*)a->ws;
    LAS float* scr = (LAS float*)(F.lds + RING_OFF + wave * 16384);
    const int gw = F.vcu * NWAVES + wave, NGW = F.G * NWAVES;
    const int it_end = (F.G % 8 == 0) ? IT_EARLY : IT_TOTAL;
    for (int it0 = gw; it0 < it_end; it0 += NGW) conv_item(a, it0, scr, lane);
    for (int r = gw; r < 2 * (INP - INC); r += NGW) { const int l = r / (INP - INC), rr = INC + r % (INP - INC);
        GAS v4u* p = (GAS v4u*)((bf16*)(ws + WS_WIN) + ((size_t)l * INP + rr) * DM) + lane;
#pragma unroll
        for (int j = 0; j < 4; ++j) p[64 * j] = (v4u){0u, 0u, 0u, 0u}; }
    { const float* x = (const float*)a->in[0]; bf16* H = (bf16*)(ws + WS_H); float* ssq0 = (float*)(ws + WS_SSQ0);
      for (int m = gw; m < S_; m += NGW) { const GAS f32x4* xr = (const GAS f32x4*)(x + (size_t)m * DM) + lane; GAS v2u* o8 = (GAS v2u*)(H + (size_t)m * DM) + lane; float ss = 0.f;
          f32x4 v[8];
#pragma unroll
          for (int j = 0; j < 8; ++j) v[j] = __builtin_nontemporal_load(xr + 64 * j);
#pragma unroll
          for (int j = 0; j < 8; ++j) { ss += (v[j].x * v[j].x + v[j].y * v[j].y) + (v[j].z * v[j].z + v[j].w * v[j].w); o8[64 * j] = (v2u){pk2(v[j].x, v[j].y), pk2(v[j].z, v[j].w)}; }
          ss = wave_sum(ss, lane); if (lane == 0) ssq0[m] = ss; } }
    { const float* rb = (const float*)a->in[2]; float* tbl = (float*)(ws + WS_TBL);
      for (int i = gw * 64 + lane; i < 2 * NH * att::TBL_N; i += NGW * 64) {
          const int pass = i / (NH * att::TBL_N), ii = i % (NH * att::TBL_N), h = ii / att::TBL_N, u = ii % att::TBL_N, st = att::TBL_U0 - u; float v = -__builtin_inff();
          int dl = -1, mu = 0;
          if (pass == 0) { if (st >= 0 && st <= 512) { dl = st; mu = (dl <= 128 ? 1 : 0) + (((dl & 3) == 0) ? 1 : 0) + (((dl & 15) == 0) ? 1 : 0); } }
          else { if (st >= 33 && st <= 128) { dl = 16 * st; mu = 1; } }
          if (mu > 0) { int bk; if (dl < 16) bk = dl; else { bk = 16 + (int)(logf((float)dl * 0.0625f) / 4.852030263919617f * 16.0f); if (bk > 31) bk = 31; }
              v = (rb[bk * NH + h] + logf((float)mu)) * 11.313708498984761f; }
          tbl[i] = v; } }
}

template <bool ROUTE, bool XB = false>
__device__ __forceinline__ void norm_rows(Frame& F, const float* x, const float* g, bf16* H, KArgs a, bool dry = false) {
    PH_IDX();
    const int gw = F.vcu * NWAVES + wave, NGW = F.G * NWAVES;
    LAS float* wr_l = (LAS float*)(F.lds + RING_OFF);
    if constexpr (ROUTE) {
        const float* wrt = (const float*)a->in[18];
        for (int i0 = tid; i0 < DM * NEXP; i0 += 8 * NWAVES * 64) { float t[8];
#pragma unroll
            for (int q = 0; q < 8; ++q) t[q] = wrt[i0 + q * NWAVES * 64];
#pragma unroll
            for (int q = 0; q < 8; ++q) { const int i = i0 + q * NWAVES * 64, k = i >> 3, e = i & 7; wr_l[e * DM + k] = t[q]; } }
        LDS_WAIT(); __syncthreads();
    }
    f32x4 gv[8];
#pragma unroll
    for (int j = 0; j < 8; ++j) gv[j] = ((const GAS f32x4*)g)[lane + 64 * j];
    LAS unsigned* lcnt = (LAS unsigned*)(F.lds + RING_OFF + 65536); LAS unsigned* lbase = lcnt + 8; LAS int* rec = (LAS int*)(F.lds + RING_OFF + 65536 + 256);
    const int NIT = (S_ + NGW - 1) / NGW;
    for (int c0 = 0; c0 < NIT; c0 += 8) {
        const int c1 = c0 + 8 < NIT ? c0 + 8 : NIT;
        if constexpr (ROUTE) { if (tid < 8) lcnt[tid] = 0u; LDS_WAIT(); __syncthreads(); }
        v2u raw[8];
        for (int ci = c0; ci < c1; ++ci) {
            const int m = gw + ci * NGW;
            if (m >= S_) { if constexpr (ROUTE) { if (lane == 0) rec[(wave * 8 + (ci - c0)) * 8] = -1; } continue; }
            f32x4 v[8]; float ss = 0.f;
            if constexpr (XB) {
                if (ci == c0) { const GAS v2u* xr = (const GAS v2u*)((const bf16*)x + (size_t)m * DM) + lane;
#pragma unroll
                    for (int j = 0; j < 8; ++j) raw[j] = xr[64 * j]; }
#pragma unroll
                for (int j = 0; j < 8; ++j) { const v2u w = raw[j]; v[j] = (f32x4){bflo(w.x), bfhi(w.x), bflo(w.y), bfhi(w.y)}; }
            } else { const GAS f32x4* xr = (const GAS f32x4*)(x + (size_t)m * DM) + lane;
#pragma unroll
                for (int j = 0; j < 8; ++j) v[j] = xr[64 * j]; }
#pragma unroll
            for (int j = 0; j < 8; ++j) ss += (v[j].x * v[j].x + v[j].y * v[j].y) + (v[j].z * v[j].z + v[j].w * v[j].w);
            const float rstd = 1.0f / sqrtf(wave_sum(ss, lane) * (1.0f / DM) + EPS);
#pragma unroll
            for (int j = 0; j < 8; ++j) v[j] = v[j] * rstd * gv[j];
            GAS v2u* o8 = (GAS v2u*)(H + (size_t)m * DM) + lane;
#pragma unroll
            for (int j = 0; j < 8; ++j) o8[64 * j] = (v2u){pk2(v[j].x, v[j].y), pk2(v[j].z, v[j].w)};
            if constexpr (XB) { const int mn = m + NGW; if (ci + 1 < c1 && mn < S_) { const GAS v2u* xn = (const GAS v2u*)((const bf16*)x + (size_t)mn * DM) + lane;
#pragma unroll
                for (int j = 0; j < 8; ++j) raw[j] = xn[64 * j]; } }
            if constexpr (ROUTE) {
                float sd[8];
#pragma unroll
                for (int e = 0; e < 8; ++e) { float t = 0.f;
#pragma unroll
                    for (int j = 0; j < 8; ++j) { const f32x4 w = *(const LAS f32x4*)(wr_l + e * DM + 4 * (lane + 64 * j)); t += (v[j].x * w.x + v[j].y * w.y) + (v[j].z * w.z + v[j].w * w.w); }
                    sd[e] = t; }
                float ra[4], rb[2], rc;
#pragma unroll
                for (int i = 0; i < 4; ++i) { const bool up = (lane & 1) != 0; ra[i] = (up ? sd[4 + i] : sd[i]) + shx(up ? sd[i] : sd[4 + i], lane, 1); }
#pragma unroll
                for (int i = 0; i < 2; ++i) { const bool up = (lane & 2) != 0; rb[i] = (up ? ra[2 + i] : ra[i]) + shx(up ? ra[i] : ra[2 + i], lane, 2); }
                { const bool up = (lane & 4) != 0; rc = (up ? rb[1] : rb[0]) + shx(up ? rb[0] : rb[1], lane, 4); }
                rc += shx(rc, lane, 8); rc += shx(rc, lane, 16); rc += shx(rc, lane, 32);
                float v0 = -__builtin_inff(), v1 = -__builtin_inff(); int e0 = 0, e1 = 0;
#pragma unroll
                for (int e = 0; e < 8; ++e) { constexpr int BR[8] = {0, 4, 2, 6, 1, 5, 3, 7};
                    const float sv = __builtin_bit_cast(float, __builtin_amdgcn_readlane(__builtin_bit_cast(int, rc), BR[e]));
                    if (sv > v0) { v1 = v0; e1 = e0; v0 = sv; e0 = e; } else if (sv > v1) { v1 = sv; e1 = e; } }
                const float g0 = 1.0f / (1.0f + expf(v1 - v0)), g1 = 1.0f - g0;
                if (lane == 0) {
                    const unsigned o0 = __hip_atomic_fetch_add(lcnt + e0, 1u, __ATOMIC_RELAXED, __HIP_MEMORY_SCOPE_WORKGROUP), o1 = __hip_atomic_fetch_add(lcnt + e1, 1u, __ATOMIC_RELAXED, __HIP_MEMORY_SCOPE_WORKGROUP);
                    LAS int* r = rec + (wave * 8 + (ci - c0)) * 8;
                    r[0] = m; r[1] = e0; r[2] = e1; r[3] = __builtin_bit_cast(int, g0); r[4] = __builtin_bit_cast(int, g1); r[5] = (int)o0; r[6] = (int)o1; }
            }
        }
        if constexpr (ROUTE) {
            LDS_WAIT(); __syncthreads();
            if (tid < 8) { const unsigned c = lcnt[tid]; unsigned b = 0u; if (c && !dry) b = xb_add((gu32*)(a->ws + WS_CTL) + CW_CNT + tid * pg8::CNT_STRIDE, c); lbase[tid] = b; }
            LDS_WAIT(); __syncthreads();
            if (lane < c1 - c0 && !dry) { const LAS int* r = rec + (wave * 8 + lane) * 8; const int m = r[0];
                if (m >= 0) { const int e0 = r[1], e1 = r[2]; const int s0 = (int)lbase[e0] + r[5], s1 = (int)lbase[e1] + r[6];
                    int* ltok = (int*)(a->ws + WS_LTOK); float* lgate = (float*)(a->ws + WS_LGATE);
                    ltok[(size_t)e0 * S_ + s0] = m; lgate[(size_t)e0 * S_ + s0] = __builtin_bit_cast(float, r[3]);
                    ltok[(size_t)e1 * S_ + s1] = m; lgate[(size_t)e1 * S_ + s1] = __builtin_bit_cast(float, r[4]);
                    ((int4*)(a->ws + WS_POS))[m] = make_int4(e0, s0, e1, s1); } }
        }
    }
}

__device__ __forceinline__ void unpack8(const v4u w, float (&f)[8]) { f[0] = bflo(w.x); f[1] = bfhi(w.x); f[2] = bflo(w.y); f[3] = bfhi(w.y); f[4] = bflo(w.z); f[5] = bfhi(w.z); f[6] = bflo(w.w); f[7] = bfhi(w.w); }
__device__ __forceinline__ v4u pack8s(const float (&f)[8], float s, const float (&g)[8]) {
    v4u o; o.x = pk2(f[0] * s * g[0], f[1] * s * g[1]); o.y = pk2(f[2] * s * g[2], f[3] * s * g[3]); o.z = pk2(f[4] * s * g[4], f[5] * s * g[5]); o.w = pk2(f[6] * s * g[6], f[7] * s * g[7]); return o; }
__device__ __forceinline__ float ssq8(const float (&f)[8]) { return ((f[0] * f[0] + f[1] * f[1]) + (f[2] * f[2] + f[3] * f[3])) + ((f[4] * f[4] + f[5] * f[5]) + (f[6] * f[6] + f[7] * f[7])); }
__device__ __forceinline__ void prep2(Frame& F, KArgs a, int l, bool dry = false) {
    PH_IDX();
    const int gw = F.vcu * NWAVES + wave, NGW = F.G * NWAVES, h = lane >> 3, sub = lane & 7;
    bf16* PROJ = (bf16*)(a->ws + WS_PROJ); bf16* QM = (bf16*)(a->ws + WS_QM); bf16* KVM = (bf16*)(a->ws + WS_KVM); bf16* KM = (bf16*)(a->ws + WS_KM);
    const int* pos = (const int*)a->in[1];
    const float* gq = (const float*)a->in[11] + l * QKB; const float* gk = (const float*)a->in[12] + l * QKB;
    float g_q[3][8], g_k[3][8], inv[8];
#pragma unroll
    for (int i = 0; i < 3; ++i)
#pragma unroll
        for (int j = 0; j < 8; ++j) { g_q[i][j] = gq[64 * i + 8 * sub + j]; g_k[i][j] = gk[64 * i + 8 * sub + j]; }
#pragma unroll
    for (int j = 0; j < 8; ++j) inv[j] = powf(10000.0f, -(float)((sub & 3) * 8 + j) * (1.0f / 32.0f));
    for (int m = gw; m < S_; m += NGW) {
        const float p = (float)pos[m];
        float cs[8], sn[8];
#pragma unroll
        for (int j = 0; j < 8; ++j) { const float ang = p * inv[j]; sincosf(ang, &sn[j], &cs[j]); }
        const GAS v4u* qrow = (const GAS v4u*)(QM + (size_t)m * NQB_ + h * QKB);
        const GAS v4u* krow = (const GAS v4u*)(KVM + (size_t)m * NKVB + h * 256);
        const GAS v4u* rrow = (const GAS v4u*)(PROJ + (size_t)m * INP + C_KR);
        float fq[3][8], fk[3][8];
#pragma unroll
        for (int i = 0; i < 3; ++i) unpack8(qrow[sub + 8 * i], fq[i]);
        unpack8(krow[sub], fk[0]); unpack8(krow[8 + sub], fk[1]); unpack8(rrow[sub], fk[2]);
        float sq = ssq8(fq[0]) + ssq8(fq[1]) + ssq8(fq[2]), sk = ssq8(fk[0]) + ssq8(fk[1]) + ssq8(fk[2]);
#pragma unroll
        for (int o = 1; o < 8; o <<= 1) { sq += shx(sq, lane, o); sk += shx(sk, lane, o); }
        const float rq = 1.0f / sqrtf(sq * (1.0f / QKB) + EPS), rk = 1.0f / sqrtf(sk * (1.0f / QKB) + EPS);
        float nq[8], nk[8];
#pragma unroll
        for (int j = 0; j < 8; ++j) { nq[j] = fq[2][j] * rq * g_q[2][j]; nk[j] = fk[2][j] * rk * g_k[2][j]; }
        float oq[8], ok[8];
#pragma unroll
        for (int j = 0; j < 8; ++j) { const float pq = shx(nq[j], lane, 4), pk = shx(nk[j], lane, 4);
            oq[j] = (sub < 4) ? (nq[j] * cs[j] - pq * sn[j]) : (pq * sn[j] + nq[j] * cs[j]);
            ok[j] = (sub < 4) ? (nk[j] * cs[j] - pk * sn[j]) : (pk * sn[j] + nk[j] * cs[j]); }
        const float one[8] = {1.f, 1.f, 1.f, 1.f, 1.f, 1.f, 1.f, 1.f};
        const size_t dofs = dry ? (size_t)(400 * MiB) / 2 : 0; GAS v4u* qo = (GAS v4u*)(QM + dofs + (size_t)m * NQB_ + h * QKB); GAS v4u* ko = (GAS v4u*)(KM + dofs + (size_t)m * NQB_ + h * QKB);
        qo[sub] = pack8s(fq[0], rq, g_q[0]); qo[8 + sub] = pack8s(fq[1], rq, g_q[1]); qo[16 + sub] = pack8s(oq, 1.0f, one);
        ko[sub] = pack8s(fk[0], rk, g_k[0]); ko[8 + sub] = pack8s(fk[1], rk, g_k[1]); ko[16 + sub] = pack8s(ok, 1.0f, one);
    }
}
__device__ __forceinline__ void att_merge(Frame& F, KArgs a) {
    PH_IDX();
    const int gw = F.vcu * NWAVES + wave, NGW = F.G * NWAVES;
    const bf16* OA = (const bf16*)(a->ws + WS_OA); const bf16* OB = (const bf16*)(a->ws + WS_OB); const float* LA = (const float*)(a->ws + WS_LSEA); const float* LB = (const float*)(a->ws + WS_LSEB);
    bf16* ATT = (bf16*)(a->ws + WS_ATT);
    for (int m = gw; m < S_; m += NGW) {
        const GAS v4u* pa = (const GAS v4u*)(OA + (size_t)m * WA) + 2 * lane; const GAS v4u* pb = (const GAS v4u*)(OB + (size_t)m * WA) + 2 * lane;
        const float la = LA[(size_t)m * NH + (lane >> 3)], lb = LB[(size_t)m * NH + (lane >> 3)];
        const v4u qa[2] = {pa[0], pa[1]}, qb[2] = {pb[0], pb[1]};
        const float wb = 1.0f / (1.0f + expf(la - lb)), wa = 1.0f - wb;
        GAS v4u* po = (GAS v4u*)(ATT + (size_t)m * DM) + 2 * lane;
#pragma unroll
        for (int j = 0; j < 2; ++j) { float fa[8], fb[8]; unpack8(qa[j], fa); unpack8(qb[j], fb);
            v4u o; o.x = pk2(wa * fa[0] + wb * fb[0], wa * fa[1] + wb * fb[1]); o.y = pk2(wa * fa[2] + wb * fb[2], wa * fa[3] + wb * fb[3]);
            o.z = pk2(wa * fa[4] + wb * fb[4], wa * fa[5] + wb * fb[5]); o.w = pk2(wa * fa[6] + wb * fb[6], wa * fa[7] + wb * fb[7]); po[j] = o; }
    }
}
__device__ __forceinline__ void moe_tail_reduce(Frame& F, KArgs a, int T, int pm, int pnl) {
    PH_IDX();
    const int bx = (int)blockIdx.x; if (bx >= 4 * T) return;
    const int tu = bx >> 2, q = bx & 3;
    const bf16* P = (const bf16*)(a->ws + WS_PT) + (size_t)tu * 4 * 65536; bf16* Y = (bf16*)(a->ws + WS_Y);
    for (int rr = wave; rr < 64; rr += NWAVES) { const int r = 64 * q + rr;
        float s0 = 0.f, s1 = 0.f, s2 = 0.f, s3 = 0.f;
#pragma unroll
        for (int k = 0; k < 4; ++k) { const v2u w = *((const GAS v2u*)(P + (size_t)k * 65536 + (size_t)r * 256) + lane); s0 += bflo(w.x); s1 += bfhi(w.x); s2 += bflo(w.y); s3 += bfhi(w.y); }
        *((GAS v2u*)(Y + (size_t)(pm * 256 + r) * DM + pnl * 256) + lane) = (v2u){pk2(s0, s1), pk2(s2, s3)}; }
}
__device__ __forceinline__ void moe_tiles(KArgs a, int (&tb)[9]) {
    gu32* cnt = (gu32*)(a->ws + WS_CTL) + CW_CNT; int acc = 0;
    int lane_; asm volatile("v_mbcnt_lo_u32_b32 %0, -1, 0\n\tv_mbcnt_hi_u32_b32 %0, -1, %0" : "=v"(lane_));
    const int cv = (int)__hip_atomic_load(cnt + (lane_ & 7) * pg8::CNT_STRIDE, RLX_AGENT);
#pragma unroll
    for (int e = 0; e < 8; ++e) { tb[e] = acc; acc += (__builtin_amdgcn_readlane(cv, e) + 255) >> 8; }
    tb[8] = acc;
}
__device__ __forceinline__ void moe_combine(Frame& F, KArgs a, bool dry = false) {
    PH_IDX();
    const int gw = F.vcu * NWAVES + wave, NGW = F.G * NWAVES;
    int tb[9]; moe_tiles(a, tb);
    const bf16* Y = (const bf16*)(a->ws + WS_Y); const bf16* X3 = (const bf16*)(a->ws + WS_H); float* out = (float*)a->out; float* outw = dry ? (float*)(a->ws + WS_PROJ) : out;
    typedef int v4i __attribute__((ext_vector_type(4)));
    const GAS v4i* posr = (const GAS v4i*)(a->ws + WS_POS);
    v4i ps = posr[gw < S_ ? gw : 0];
    for (int m = gw; m < S_; m += NGW) {
        int b0 = 0, b1 = 0;
#pragma unroll
        for (int e = 0; e < 8; ++e) { b0 = (ps.x == e) ? tb[e] : b0; b1 = (ps.z == e) ? tb[e] : b1; }
        const GAS v2u* y0 = (const GAS v2u*)(Y + (size_t)(b0 * 256 + ps.y) * DM) + lane; const GAS v2u* y1 = (const GAS v2u*)(Y + (size_t)(b1 * 256 + ps.w) * DM) + lane;
        const GAS v2u* xr = (const GAS v2u*)(X3 + (size_t)m * DM) + lane; GAS f32x4* xw = (GAS f32x4*)(outw + (size_t)m * DM) + lane;
        v2u w0[8], w1[8], wx[8];
#pragma unroll
        for (int j = 0; j < 8; ++j) { w0[j] = y0[64 * j]; w1[j] = y1[64 * j]; wx[j] = xr[64 * j]; }
        { const int mn = m + NGW; ps = posr[mn < S_ ? mn : m]; }
#pragma unroll
        for (int j = 0; j < 8; ++j) { f32x4 v;
            v.x = bflo(wx[j].x) + (bflo(w0[j].x) + bflo(w1[j].x)); v.y = bfhi(wx[j].x) + (bfhi(w0[j].x) + bfhi(w1[j].x)); v.z = bflo(wx[j].y) + (bflo(w0[j].y) + bflo(w1[j].y)); v.w = bfhi(wx[j].y) + (bfhi(w0[j].y) + bfhi(w1[j].y));
            __builtin_nontemporal_store(v, xw + 64 * j); }
    }
}
#ifndef MK_PER_PHASE
#define MK_PER_PHASE 0
#endif
#ifndef DBG_STOP
#define DBG_STOP 23
#endif
#ifndef DUP_MASK
#define DUP_MASK 0u
#endif
constexpr int NPH = 20;
#undef DBG_STOP
#define DBG_STOP NPH

using CfgM = att::Cfg<192, NQB_, NQB_, NKVB, DM, false>;
using CfgA = att::Cfg<128, INP, INP, INP, WA, true, NH, 0>;
using CfgB = att::Cfg<128, 16 * INP, 16 * INP, 16 * INP, 16 * WA, true, 16 * NH, 33>;
constexpr int W_DILA = 513, W_DILB = 129;

__global__ void __launch_bounds__(NWAVES * 64, 2) mega_fwd(Args a_byval) {
    extern __shared__ __attribute__((aligned(16))) unsigned char lds[];
#ifdef PAD_NOPS
    asm volatile(".rept " PAD_NOPS "\n\ts_nop 0\n\t.endr");
#endif
    Frame F;
    F.lds = (LAS unsigned char*)lds;
    F.wave = __builtin_amdgcn_readfirstlane((int)threadIdx.x >> 6); asm volatile("" : "+s"(F.wave));
    F.G = gridDim.x; { const int bx = blockIdx.x; F.vcu = (F.G % 8 == 0) ? (bx % 8) * (F.G / 8) + bx / 8 : bx; }
    const int lo = a_byval.ph_lo, hi = a_byval.ph_hi, use_bar = a_byval.use_bar;
    GAS unsigned char* const ws0 = kargs()->ws;
    volatile LAS unsigned* MISC = (volatile LAS unsigned*)(F.lds + MISC_OFF);
    for (int u = threadIdx.x; u < (LDS_BYTES - LDSCTL_OFF) / 4; u += NWAVES * 64) ((LAS unsigned*)(F.lds + LDSCTL_OFF))[u] = 0u;
    __syncthreads();
    XcdBarrier bar; bar.bar = (gu32*)(ws0 + WS_CTL) + CW_BAR; bar.x = 0; bar.st = nullptr;
    if (use_bar) bar = xcd_barrier_post((gu32*)(ws0 + WS_CTL) + CW_BAR, MISC + 8);
#define IN(k) (lo <= (k) && (k) < hi)
#define REPS(k) (((DUP_MASK >> (k)) & 1u) ? 2 : 1)
#ifndef DUP_BAR
#define DUP_BAR 0
#endif
#define DUP(k) for (int rp_ = 0; rp_ < REPS(k); (DUP_BAR && use_bar && rp_ == 0 && REPS(k) > 1) ? (xcd_barrier(bar), 0) : 0, ++rp_)
#ifndef INPROJ_WGM
#define INPROJ_WGM 8
#endif
#ifndef GU_WGM
#define GU_WGM 8
#endif
#ifndef OUT_WGM
#define OUT_WGM 8
#endif
#ifndef DOWN_REV
#define DOWN_REV 1
#endif
#ifndef DOWN_WGM
#define DOWN_WGM 4
#endif
#ifndef PROBE_EPI
#define PROBE_EPI 0
#endif
#ifndef SEAM_REPS
#define SEAM_REPS 1
#endif
#define SEAM(k) do { if (use_bar && IN(k) && IN((k) + 1)) { for (int sr_ = 0; sr_ < SEAM_REPS; ++sr_) { XcdBarrier b_ = bar; asm volatile("" : "+s"(b_.bar)); xcd_barrier(b_); } } } while (0)
    LAS unsigned char* const ring = F.lds + RING_OFF;
    LAS float* const xlds = (LAS float*)(F.lds + XLDS_OFF);

    if (IN(0)) { DUP(0) p0_prologue(F, kargs()); SEAM(0); }

    for (int l = 0; l < NLAYER; ++l) {
        const int pb = l ? 9 : 1;
        int bx = (int)blockIdx.x, G_ = F.G; asm volatile("" : "+s"(bx), "+s"(G_));
        const KArgs a = kargs(); GAS unsigned char* ws = a->ws; asm volatile("" : "+s"(ws));
        bf16* const H = (bf16*)(ws + WS_H); bf16* const PROJ = (bf16*)(ws + WS_PROJ); bf16* const QM = (bf16*)(ws + WS_QM); bf16* const KVM = (bf16*)(ws + WS_KVM);
        bf16* const KM = (bf16*)(ws + WS_KM); bf16* const ATT = (bf16*)(ws + WS_ATT);
        bf16* const ACT = (bf16*)(ws + WS_ACT); bf16* const Y = (bf16*)(ws + WS_Y);
        float* const ssq0 = (float*)(ws + WS_SSQ0); float* const ssqx = (float*)(ws + WS_SSQX); float* const ssqc = (float*)(ws + WS_SSQC) + (size_t)l * S_ * 2;
        if (IN(pb + 0)) { DUP(pb + 0) {
            pg8::Gemm g{H, (const bf16*)(ws + WS_WIN) + (size_t)l * INP * DM, DM, DM}; pg8::TileOrder O; O.init(S_ / 256, INP / 256, G_, bx, INPROJ_WGM);
            pg8::EpiInProj E{PROJ, INP, l ? ssqx + (size_t)S_ * 8 : ssq0, l ? 8 : 1, (const float*)a->in[9] + l * HD, (const float*)a->in[10] + l * HD, (const float*)a->in[6] + l * KVLORA, ssqc, EPS};
            pg8::gemm_phase<pg8::EpiInProj, pg8::TileOrder, false>(ring, g, O, E, F.wave, xlds); }
            SEAM(pb + 0);
        }
        if (IN(pb + 1)) { DUP(pb + 1) {
            { pg8::Gemm g{PROJ + C_CQ, (const bf16*)(ws + WS_WQB) + (size_t)l * NQB_ * QLORA, QLORA, INP}; pg8::TileOrder O; O.init(S_ / 256, NQB_ / 256, G_, bx);
              pg8::EpiBf16 E{QM, NQB_, ssqc, 2, 1.0f / QLORA, EPS}; pg8::gemm_phase<pg8::EpiBf16, pg8::TileOrder, false>(ring, g, O, E, F.wave, xlds); }
            { pg8::Gemm g{PROJ + C_CKV, (const bf16*)(ws + WS_WKVB) + (size_t)l * NKVB * KVLORA, KVLORA, INP}; pg8::TileOrder O; O.init(S_ / 256, NKVB / 256, G_, bx);
              pg8::EpiBf16 E{KVM, NKVB, nullptr, 0, 0.f, 0.f}; pg8::gemm_phase<pg8::EpiBf16, pg8::TileOrder, false>(ring, g, O, E, F.wave, xlds); } }
            SEAM(pb + 1);
        }
        if (IN(pb + 2)) { if (REPS(pb + 2) > 1) prep2(F, a, l, true); prep2(F, a, l); SEAM(pb + 2); }
        if (IN(pb + 3)) { DUP(pb + 3) {
            att::lptr albs = (att::lptr)ring;
            const bool host = (l == 0) && (G_ % 8 == 0) && rp_ == 0;
            if (host && (bx & 4) == 0) { late_convert(F, a, 0); __syncthreads(); }
            if (F.wave >= 4) __builtin_amdgcn_s_setprio(1);
            {   att::Seam<CfgM> Sm;
                for (int it = bx; it < 256; it += G_) {
                    const int h = it & 7, x = it >> 3;
                    att::BlockRef b0, b1;
                    b0.P0 = (63 - x) * 256; b1.P0 = x * 256;
                    b0.K = b1.K = KM + h * QKB; b0.V = b1.V = KVM + h * 256 + 128;
                    b0.Q = QM + (size_t)b0.P0 * NQB_ + h * QKB; b1.Q = QM + (size_t)b1.P0 * NQB_ + h * QKB;
                    b0.O = ATT + (size_t)b0.P0 * DM + WA + h * HD; b1.O = ATT + (size_t)b1.P0 * DM + WA + h * HD; b0.lse = b1.lse = nullptr;
                    att::prime<CfgM>(b0, W_CAUSAL, albs, Sm, F.wave);
                    for (int pass = 0; pass < 2; ++pass) { const att::BlockRef cur = pass ? b1 : b0; att::block<CfgM>(cur, b1, S_, W_CAUSAL, albs, Sm, F.wave); }
                } }
            {   att::Seam<CfgA> Sa;
                bf16* const OA = (bf16*)(ws + WS_OA); float* const LA = (float*)(ws + WS_LSEA);
                for (int it = bx; it < 256; it += G_) {
                    const int h = it & 7, x = it >> 3;
                    { const float* tg = (const float*)(ws + WS_TBL) + h * att::TBL_N; LAS float* tl = (LAS float*)(ring + CfgA::OFF_TBL);
                      PH_IDX(); static_assert(att::TBL_N % 4 == 0 && att::TBL_N / 4 <= 2 * NWAVES * 64, "table copy"); const int i1 = tid + NWAVES * 64; const bool h1 = i1 < att::TBL_N / 4; const f32x4 t0 = ((const GAS f32x4*)tg)[tid], t1 = ((const GAS f32x4*)tg)[h1 ? i1 : tid]; ((LAS f32x4*)tl)[tid] = t0; if (h1) ((LAS f32x4*)tl)[i1] = t1; }
                    att::BlockRef b0, b1;
                    b0.P0 = x * 256; b1.P0 = (63 - x) * 256;
                    b0.K = b1.K = PROJ + C_KA + h * HD; b0.V = b1.V = PROJ + C_VA + h * HD;
                    b0.Q = PROJ + (size_t)b0.P0 * INP + C_QA + h * HD; b1.Q = PROJ + (size_t)b1.P0 * INP + C_QA + h * HD;
                    b0.O = OA + (size_t)b0.P0 * WA + h * HD; b1.O = OA + (size_t)b1.P0 * WA + h * HD;
                    b0.lse = LA + (size_t)b0.P0 * NH + h; b1.lse = LA + (size_t)b1.P0 * NH + h;
                    att::prime<CfgA>(b0, W_DILA, albs, Sa, F.wave);
                    for (int pass = 0; pass < 2; ++pass) { const att::BlockRef cur = pass ? b1 : b0; att::block<CfgA>(cur, b1, S_, W_DILA, albs, Sa, F.wave); }
                } }
            {   att::Seam<CfgB> Sb;
                bf16* const OB = (bf16*)(ws + WS_OB); float* const LB = (float*)(ws + WS_LSEB);
                for (int it = bx; it < 256; it += G_) {
                    const int h = it & 7, y = it >> 3;
                    { const float* tg = (const float*)(ws + WS_TBL) + (NH + h) * att::TBL_N; LAS float* tl = (LAS float*)(ring + CfgB::OFF_TBL);
                      PH_IDX(); static_assert(att::TBL_N % 4 == 0 && att::TBL_N / 4 <= 2 * NWAVES * 64, "table copy"); const int i1 = tid + NWAVES * 64; const bool h1 = i1 < att::TBL_N / 4; const f32x4 t0 = ((const GAS f32x4*)tg)[tid], t1 = ((const GAS f32x4*)tg)[h1 ? i1 : tid]; ((LAS f32x4*)tl)[tid] = t0; if (h1) ((LAS f32x4*)tl)[i1] = t1; }
                    att::BlockRef b0, b1;
                    const int i0 = 2 * y, i1 = 2 * y + 1, r0 = i0 >> 2, r1 = i1 >> 2;
                    b0.P0 = (i0 & 3) * 256; b1.P0 = (i1 & 3) * 256;
                    b0.K = PROJ + (size_t)r0 * INP + C_KA + h * HD; b1.K = PROJ + (size_t)r1 * INP + C_KA + h * HD;
                    b0.V = PROJ + (size_t)r0 * INP + C_VA + h * HD; b1.V = PROJ + (size_t)r1 * INP + C_VA + h * HD;
                    b0.Q = PROJ + ((size_t)b0.P0 * 16 + r0) * INP + C_QA + h * HD; b1.Q = PROJ + ((size_t)b1.P0 * 16 + r1) * INP + C_QA + h * HD;
                    b0.O = OB + ((size_t)b0.P0 * 16 + r0) * WA + h * HD; b1.O = OB + ((size_t)b1.P0 * 16 + r1) * WA + h * HD;
                    b0.lse = LB + ((size_t)b0.P0 * 16 + r0) * NH + h; b1.lse = LB + ((size_t)b1.P0 * 16 + r1) * NH + h;
                    att::prime<CfgB>(b0, W_DILB, albs, Sb, F.wave);
                    for (int pass = 0; pass < 2; ++pass) { const att::BlockRef cur = pass ? b1 : b0; att::block<CfgB>(cur, b1, S_ / 16, W_DILB, albs, Sb, F.wave); }
                } }
            __builtin_amdgcn_s_setprio(0);
            if (host && (bx & 4) != 0) { __syncthreads(); late_convert(F, a, 1); } }
            SEAM(pb + 3);
        }
        if (IN(pb + 4)) { att_merge(F, a); SEAM(pb + 4); }
        if (IN(pb + 5)) { for (int rp_ = 0; rp_ < (l == 0 ? REPS(6) : 1); ++rp_) {
            pg8::Gemm g{ATT, (const bf16*)(ws + WS_WOUT) + (size_t)l * DM * DM, DM, DM}; pg8::TileOrder O; O.init(S_ / 256, DM / 256, G_, bx, OUT_WGM);
            pg8::EpiRes E{l == 0 ? (const float*)a->in[0] : nullptr, H, nullptr, H, ssqx, DM};
            pg8::gemm_phase<pg8::EpiRes, pg8::TileOrder, false>(ring, g, O, E, F.wave, xlds); }
            SEAM(pb + 5);
        }
        if (l == 0) {
            if (IN(7)) { DUP(7) {
                pg8::Gemm g{H, (const bf16*)(ws + WS_WGU), DM, DM}; pg8::TileOrder O; O.init(S_ / 256, NT_GU, G_, bx, GU_WGM);
                pg8::EpiSwiGLU E{ACT, FF, NT_GU, ssqx, EPS, (REPS(7) > 1 && rp_ == 0) ? PROBE_EPI : 0};
                pg8::gemm_phase<pg8::EpiSwiGLU, pg8::TileOrder, false>(ring, g, O, E, F.wave, xlds); }
                SEAM(7);
            }
            if (IN(8)) { DUP(8) {
                const bool dry = REPS(8) > 1 && rp_ == 0;
                pg8::Gemm g{ACT, (const bf16*)(ws + WS_WD), FF, FF}; pg8::TileOrder O; O.init(S_ / 256, NT_D, G_, bx, DOWN_WGM);
                pg8::EpiRes E{nullptr, H, dry ? (float*)(ws + WS_END) : nullptr, dry ? nullptr : H, ssqx + (size_t)S_ * 8, DM};
                pg8::gemm_phase<pg8::EpiRes, pg8::TileOrder, false>(ring, g, O, E, F.wave, xlds); }
                SEAM(8);
            }
        } else {
            bf16* const HN = (bf16*)(ws + WS_HN);
            if (IN(15)) { if (REPS(15) > 1) norm_rows<true, true>(F, (const float*)H, (const float*)a->in[14] + l * DM, HN, a, true); norm_rows<true, true>(F, (const float*)H, (const float*)a->in[14] + l * DM, HN, a); SEAM(15); }
            if (IN(16)) { DUP(16) {
                int tb[9]; moe_tiles(a, tb);
                pg8::MoeOrder O; O.t.init(tb[8], NT_GU, G_, bx); O.t1 = tb[1]; O.t2 = tb[2]; O.t3 = tb[3]; O.t4 = tb[4]; O.t5 = tb[5]; O.t6 = tb[6]; O.t7 = tb[7];
                O.nNl = NT_GU; O.list = (const int*)(ws + WS_LTOK); O.cnt = (const int*)(ws + WS_CTL) + CW_CNT; O.S_cap = S_; O.R = -1; O.T = 0; O.nkt_full = DM / 64;
                pg8::Gemm g{HN, (const bf16*)(ws + WS_WGUE), DM, DM};
                pg8::EpiSwiGLU E{ACT, FF, NT_GU, nullptr, 0.f, (REPS(16) > 1 && rp_ == 0) ? PROBE_EPI : 0};
                pg8::gemm_phase<pg8::EpiSwiGLU, pg8::MoeOrder, true>(ring, g, O, E, F.wave, xlds); }
                SEAM(16);
            }
            if (IN(17)) { DUP(17) {
                int tb[9]; moe_tiles(a, tb);
                pg8::MoeOrder O; O.t.init(tb[8], NT_D, G_, bx, DOWN_WGM); O.t.rev = DOWN_REV; O.t1 = tb[1]; O.t2 = tb[2]; O.t3 = tb[3]; O.t4 = tb[4]; O.t5 = tb[5]; O.t6 = tb[6]; O.t7 = tb[7];
                O.nNl = NT_D; O.list = (const int*)(ws + WS_LTOK); O.cnt = (const int*)(ws + WS_CTL) + CW_CNT; O.S_cap = S_; O.nkt_full = FF / 64;
                { const int U = tb[8] * NT_D, Rr = U / G_, Tt = U - Rr * G_; const bool split = Tt > 0 && 4 * Tt <= G_; O.R = split ? Rr : -1; O.T = split ? Tt : 0; }
                pg8::Gemm g{ACT, (const bf16*)(ws + WS_WDE), FF, FF};
                pg8::EpiMoeDown E{Y, DM, NT_D, (const float*)(ws + WS_LGATE), (const int*)(ws + WS_CTL) + CW_CNT, S_, (bf16*)(ws + WS_PT)};
                pg8::gemm_phase<pg8::EpiMoeDown, pg8::MoeOrder, false, true>(ring, g, O, E, F.wave, xlds); }
                SEAM(17);
            }
            if (IN(18)) {
                int tb[9]; moe_tiles(a, tb);
                const int U = tb[8] * NT_D, Rr = U / G_, Tt = U - Rr * G_;
                if (Tt > 0 && 4 * Tt <= G_ && bx < 4 * Tt) {
                    pg8::TileOrder O; O.init(tb[8], NT_D, G_, bx, DOWN_WGM); O.rev = DOWN_REV; pg8::Unit u; O.at((long)Rr * G_ + (bx >> 2), u);
                    moe_tail_reduce(F, a, Tt, u.pm, u.pn); }
                SEAM(18);
            }
            if (IN(19)) { if (REPS(19) > 1) moe_combine(F, a, true); moe_combine(F, a); }
        }
    }
#undef IN
#undef SEAM
#undef REPS
#undef DUP
}

extern "C" void kernel_launch(void* const* d_in, const int* in_sizes, int n_in, void* d_out, int out_size, void* d_ws, size_t ws_size, hipStream_t stream) {
    static int grid = 0;
    if (grid == 0) {
        if (n_in != 22 || in_sizes[0] != S_ * DM || out_size != S_ * DM || ws_size < WS_END) { fprintf(stderr, "kernel_launch: shape/workspace mismatch (n_in %d, in0 %d, out %d, ws %zu, need %zu)\n", n_in, n_in > 0 ? in_sizes[0] : -1, out_size, ws_size, (size_t)WS_END); grid = -1; return; }
        int dev = 0, cus = 0, per_cu = 0;
        if (hipGetDevice(&dev) != hipSuccess || hipDeviceGetAttribute(&cus, hipDeviceAttributeMultiprocessorCount, dev) != hipSuccess) { grid = -1; return; }
        if (hipFuncSetAttribute((const void*)mega_fwd, hipFuncAttributeMaxDynamicSharedMemorySize, LDS_BYTES) != hipSuccess) { fprintf(stderr, "kernel_launch: hipFuncSetAttribute failed\n"); grid = -1; return; }
        if (hipOccupancyMaxActiveBlocksPerMultiprocessor(&per_cu, (const void*)mega_fwd, NWAVES * 64, LDS_BYTES) != hipSuccess || per_cu < 1) { fprintf(stderr, "kernel_launch: occupancy query reports %d\n", per_cu); }
        (void)hipGetLastError();
        grid = cus;
    }
    if (grid < 0) return;
    if (hipMemsetAsync((char*)d_ws + WS_CTL, 0, CTL_ZERO_BYTES, stream) != hipSuccess) return;
    Args a{};
    for (int i = 0; i < 22; ++i) a.in[i] = d_in[i];
    a.out = (float*)d_out; a.ws = (unsigned char*)d_ws; a.pad = 0;
#if MK_PER_PHASE
    for (int ph = 0; ph < DBG_STOP; ++ph) { a.ph_lo = ph; a.ph_hi = ph + 1; a.use_bar = 0;
        hipLaunchKernelGGL(mega_fwd, dim3(grid), dim3(NWAVES * 64), LDS_BYTES, stream, a); }
#else
    a.ph_lo = 0; a.ph_hi = DBG_STOP; a.use_bar = 1;
    hipLaunchKernelGGL(mega_fwd, dim3(grid), dim3(NWAVES * 64), LDS_BYTES, stream, a);
#endif
}
```

```cpp
#define KLOOP_ALIGN "4"
#define MOE_GU_WGM 12
#include <hip/hip_runtime.h>
#include <cstdio>
#include <cstdint>
namespace pg8 {
constexpr int CNT_STRIDE = 32;
#define PG8_LAS __attribute__((address_space(3)))
typedef unsigned short bf16_t;
typedef short bf16x8 __attribute__((ext_vector_type(8)));
typedef float f32x4 __attribute__((ext_vector_type(4)));
typedef unsigned u32x4 __attribute__((ext_vector_type(4)));
constexpr int BM = 256, BK = 64, HALF = 128, HTB = HALF * BK * 2  , STAGE_BYTES = 8 * HTB, NXCD = 8, WGM = 8;

__device__ __forceinline__ int lds_byte(int r, int c) { const int st = (r >> 4) * 2 + (c >> 5), rr = r & 15, cc = c & 31, ob = rr * 64 + cc * 2; return st * 1024 + (ob ^ (((ob >> 9) & 1) << 5)); }
__device__ __forceinline__ void stage_rc(int b, int& R, int& C) { const int st = b / 1024, sb = b % 1024, swz = sb ^ (((sb >> 9) & 1) << 5); R = (st >> 1) * 16 + swz / 64; C = (st & 1) * 32 + (swz % 64) / 2; }
__device__ __forceinline__ int perm32(int rho) { const int n = rho >> 4, i = rho & 15; return 8 * (i >> 2) + 4 * n + (i & 3); }

struct Unit { int pm, pn, e, lt, kt0, nkt, tail; };
struct Gemm { const bf16_t* A; const bf16_t* Bt; int K; int lda; };

struct TileOrder {
    int nM, nN, nwg, G, c, wgm, rev;
    __device__ __forceinline__ void init(int nM_, int nN_, int G_, int c_, int wgm_ = WGM) { nM = nM_; nN = nN_; nwg = nM * nN; G = G_; c = c_; wgm = wgm_; rev = 0; }
    __device__ __forceinline__ bool next(int i, Unit& u) const { return at((long)i * G + c, u); }
    __device__ __forceinline__ bool at(long L, Unit& u) const {
        if (L >= nwg) return false;
        int wgid = (int)L; { const int q = nwg / NXCD, r = nwg % NXCD, xcd = wgid % NXCD, off = wgid / NXCD; wgid = (xcd < r ? xcd * (q + 1) : r * (q + 1) + (xcd - r) * q) + off; }
        if (rev) wgid = nwg - 1 - wgid;
        const int nig = wgm * nN, gid = wgid / nig, fm = gid * wgm, gsz = (nM - fm) < wgm ? (nM - fm) : wgm;
        u.pm = fm + ((wgid % nig) % gsz); u.pn = (wgid % nig) / gsz; u.e = 0; u.lt = 0; u.kt0 = 0; u.nkt = 0; u.tail = 0; return true;
    }
    __device__ __forceinline__ unsigned a_off(const Unit&, int) const { return 0u; }
};
struct MoeOrder {
    TileOrder t; int t1, t2, t3, t4, t5, t6, t7; int nNl; const int* list; const int* cnt; int S_cap; int R, T, nkt_full;
    __device__ __forceinline__ void find(int pm, int& e, int& tb) const {
        e = (pm >= t1) + (pm >= t2) + (pm >= t3) + (pm >= t4) + (pm >= t5) + (pm >= t6) + (pm >= t7);
        tb = pm >= t7 ? t7 : pm >= t6 ? t6 : pm >= t5 ? t5 : pm >= t4 ? t4 : pm >= t3 ? t3 : pm >= t2 ? t2 : pm >= t1 ? t1 : 0;
    }
    __device__ __forceinline__ bool next(int i, Unit& u) const {
        if (R >= 0 && i >= R) {
            if (i > R || t.c >= 4 * T) return false;
            if (!t.at((long)R * t.G + (t.c >> 2), u)) return false;
            u.nkt = nkt_full / 4; u.kt0 = (t.c & 3) * u.nkt; u.tail = 1 + t.c;
        } else { if (!t.next(i, u)) return false; u.nkt = nkt_full; }
        int e, tb; find(u.pm, e, tb); u.e = e; u.lt = u.pm - tb; u.pn += e * nNl; return true;
    }
    __device__ __forceinline__ unsigned a_off(const Unit& u, int R) const {
        const int slot = u.lt * 256 + R; const int n = cnt[u.e * CNT_STRIDE];
        const int tok = list[(size_t)u.e * S_cap + (slot < n ? slot : 0)];
        return (unsigned)tok * 4096u;
    }
};

__device__ __forceinline__ unsigned cvt_pk_bf16(float lo, float hi) { unsigned r; asm volatile("v_cvt_pk_bf16_f32 %0, %1, %2" : "=v"(r) : "v"(lo), "v"(hi)); return r; }

__device__ __forceinline__ float shx(float v, int lane, int o) { return __builtin_bit_cast(float, __builtin_amdgcn_ds_bpermute((lane ^ o) << 2, __builtin_bit_cast(int, v))); }
__device__ __forceinline__ float sum_fq(float v, int lane) { v += shx(v, lane, 16); v += shx(v, lane, 32); return v; }
__device__ __forceinline__ float ssq4(const f32x4 a) { return (a[0] * a[0] + a[1] * a[1]) + (a[2] * a[2] + a[3] * a[3]); }
typedef float f32x2 __attribute__((ext_vector_type(2)));
template <int NS>
__device__ __forceinline__ void row_rs8(const float* ssq, int row0, float inv_n, float eps, float (&rs)[2][4]) {
    if constexpr (NS == 8) { f32x4 a[2][4], b[2][4];
#pragma unroll
        for (int ai = 0; ai < 2; ++ai)
#pragma unroll
            for (int m = 0; m < 4; ++m) { const float* p = ssq + (size_t)(row0 + ai * HALF + m * 16) * 8; a[ai][m] = *(const f32x4*)p; b[ai][m] = *(const f32x4*)(p + 4); }
#pragma unroll
        for (int ai = 0; ai < 2; ++ai)
#pragma unroll
            for (int m = 0; m < 4; ++m) { const f32x4 x = a[ai][m], y = b[ai][m]; rs[ai][m] = __builtin_amdgcn_rsqf((((x[0] + x[1]) + (x[2] + x[3])) + ((y[0] + y[1]) + (y[2] + y[3]))) * inv_n + eps); }
    } else if constexpr (NS == 2) { f32x2 a[2][4];
#pragma unroll
        for (int ai = 0; ai < 2; ++ai)
#pragma unroll
            for (int m = 0; m < 4; ++m) a[ai][m] = *(const f32x2*)(ssq + (size_t)(row0 + ai * HALF + m * 16) * 2);
#pragma unroll
        for (int ai = 0; ai < 2; ++ai)
#pragma unroll
            for (int m = 0; m < 4; ++m) rs[ai][m] = __builtin_amdgcn_rsqf((a[ai][m][0] + a[ai][m][1]) * inv_n + eps);
    } else { float a[2][4];
#pragma unroll
        for (int ai = 0; ai < 2; ++ai)
#pragma unroll
            for (int m = 0; m < 4; ++m) a[ai][m] = ssq[row0 + ai * HALF + m * 16];
#pragma unroll
        for (int ai = 0; ai < 2; ++ai)
#pragma unroll
            for (int m = 0; m < 4; ++m) rs[ai][m] = __builtin_amdgcn_rsqf(a[ai][m] * inv_n + eps);
    }
}
__device__ __forceinline__ void row_rs8n(const float* ssq, int ns, int row0, float inv_n, float eps, float (&rs)[2][4]) {
    if (ns == 8) row_rs8<8>(ssq, row0, inv_n, eps, rs); else if (ns == 2) row_rs8<2>(ssq, row0, inv_n, eps, rs); else row_rs8<1>(ssq, row0, inv_n, eps, rs);
}
__device__ __forceinline__ void ones8(float (&rs)[2][4]) {
#pragma unroll
    for (int ai = 0; ai < 2; ++ai)
#pragma unroll
        for (int m = 0; m < 4; ++m) rs[ai][m] = 1.0f;
}
struct EpiBf16 {
    static constexpr bool PERM = true;
    bf16_t* O; int ldc; const float* ssq; int ns; float inv_n, eps;
    __device__ __forceinline__ void operator()(const f32x4 (&acc)[2][2][4][2], const Unit& u, int wr, int wc, int fr, int fq, int lane, PG8_LAS float* xl) const {
        const int row0 = u.pm * BM + wr * 64 + fr, col0 = u.pn * BM + wc * 32 + 8 * fq;
        float rsv[2][4];
        if (ssq) row_rs8n(ssq, ns, row0, inv_n, eps, rsv); else ones8(rsv);
#pragma unroll
        for (int ai = 0; ai < 2; ++ai)
#pragma unroll
            for (int m = 0; m < 4; ++m) { const int grow = row0 + ai * HALF + m * 16; bf16_t* rowp = O + (size_t)grow * ldc + col0;
                const float rs = rsv[ai][m];
#pragma unroll
                for (int bj = 0; bj < 2; ++bj) { const f32x4 v0 = acc[ai][bj][m][0] * rs, v1 = acc[ai][bj][m][1] * rs;
                    u32x4 w; w.x = cvt_pk_bf16(v0[0], v0[1]); w.y = cvt_pk_bf16(v0[2], v0[3]); w.z = cvt_pk_bf16(v1[0], v1[1]); w.w = cvt_pk_bf16(v1[2], v1[3]);
                    *(u32x4*)(rowp + bj * HALF) = w; } }
    }
};
struct EpiInProj {
    static constexpr bool PERM = true;
    bf16_t* O; int ldc; const float* ssq_x; int ns_x; const float* gq; const float* gk; const float* gckv; float* ssq_cq; float eps;
    __device__ __forceinline__ void operator()(const f32x4 (&acc)[2][2][4][2], const Unit& u, int wr, int wc, int fr, int fq, int lane, PG8_LAS float* xl) const {
        const int row0 = u.pm * BM + wr * 64 + fr, col0 = u.pn * BM + wc * 32 + 8 * fq, pn = u.pn;
        const bool headn = pn < 8, ckvn = pn == 14, cq = (pn == 12 || pn == 13);
        f32x4 v[2][4][2][2];
        float rsxv[2][4]; row_rs8n(ssq_x, ns_x, row0, 1.0f / 2048.0f, eps, rsxv);
#pragma unroll
        for (int ai = 0; ai < 2; ++ai)
#pragma unroll
            for (int m = 0; m < 4; ++m) { const float rsx = rsxv[ai][m];
#pragma unroll
                for (int bj = 0; bj < 2; ++bj)
#pragma unroll
                    for (int n = 0; n < 2; ++n) v[ai][m][bj][n] = acc[ai][bj][m][n] * rsx; }
        if (headn || ckvn) {
#pragma unroll
            for (int ai = 0; ai < 2; ++ai)
#pragma unroll
                for (int m = 0; m < 4; ++m)
#pragma unroll
                    for (int bj = 0; bj < 2; ++bj) { const float s = sum_fq(ssq4(v[ai][m][bj][0]) + ssq4(v[ai][m][bj][1]), lane);
                        if (fq == 0) xl[((ai * HALF + wr * 64 + m * 16 + fr) * 2 + bj) * 4 + wc] = s; }
            asm volatile("s_waitcnt lgkmcnt(0)" ::: "memory"); __builtin_amdgcn_s_barrier(); asm volatile("" ::: "memory");
            f32x4 gg[2][2];
            { const int go = wc * 32 + 8 * fq;
              if (ckvn) { gg[0][0] = *(const f32x4*)(gckv + go); gg[0][1] = *(const f32x4*)(gckv + go + 4); gg[1][0] = *(const f32x4*)(gckv + HALF + go); gg[1][1] = *(const f32x4*)(gckv + HALF + go + 4); }
              else if (pn < 4) { gg[0][0] = *(const f32x4*)(gq + go); gg[0][1] = *(const f32x4*)(gq + go + 4); gg[1][0] = gg[0][0]; gg[1][1] = gg[0][1]; }
              else { gg[0][0] = *(const f32x4*)(gk + go); gg[0][1] = *(const f32x4*)(gk + go + 4); gg[1][0] = gg[0][0]; gg[1][1] = gg[0][1]; } }
#pragma unroll
            for (int ai = 0; ai < 2; ++ai)
#pragma unroll
                for (int m = 0; m < 4; ++m) { const int r = ai * HALF + wr * 64 + m * 16 + fr;
                    const f32x4 p0 = *(const PG8_LAS f32x4*)(xl + (r * 2 + 0) * 4), p1 = *(const PG8_LAS f32x4*)(xl + (r * 2 + 1) * 4);
                    const float t0 = (p0[0] + p0[1]) + (p0[2] + p0[3]), t1 = (p1[0] + p1[1]) + (p1[2] + p1[3]);
                    const float r0 = ckvn ? __builtin_amdgcn_rsqf((t0 + t1) * (1.0f / 256.0f) + eps) : __builtin_amdgcn_rsqf(t0 * (1.0f / 128.0f) + eps);
                    const float r1 = ckvn ? r0 : __builtin_amdgcn_rsqf(t1 * (1.0f / 128.0f) + eps);
#pragma unroll
                    for (int n = 0; n < 2; ++n) { v[ai][m][0][n] = v[ai][m][0][n] * r0 * gg[0][n]; v[ai][m][1][n] = v[ai][m][1][n] * r1 * gg[1][n]; } }
        } else if (cq) {
#pragma unroll
            for (int ai = 0; ai < 2; ++ai)
#pragma unroll
                for (int m = 0; m < 4; ++m) { const float s = sum_fq((ssq4(v[ai][m][0][0]) + ssq4(v[ai][m][0][1])) + (ssq4(v[ai][m][1][0]) + ssq4(v[ai][m][1][1])), lane);
                    if (fq == 0) xl[(ai * HALF + wr * 64 + m * 16 + fr) * 4 + wc] = s; }
            asm volatile("s_waitcnt lgkmcnt(0)" ::: "memory"); __builtin_amdgcn_s_barrier(); asm volatile("" ::: "memory");
            if (wc == 0 && fq == 0) {
#pragma unroll
                for (int ai = 0; ai < 2; ++ai)
#pragma unroll
                    for (int m = 0; m < 4; ++m) { const int r = ai * HALF + wr * 64 + m * 16 + fr; const f32x4 p = *(const PG8_LAS f32x4*)(xl + r * 4);
                        ssq_cq[(size_t)(u.pm * BM + r) * 2 + (pn - 12)] = (p[0] + p[1]) + (p[2] + p[3]); } }
        }
#pragma unroll
        for (int ai = 0; ai < 2; ++ai)
#pragma unroll
            for (int m = 0; m < 4; ++m) { bf16_t* rowp = O + (size_t)(row0 + ai * HALF + m * 16) * ldc + col0;
#pragma unroll
                for (int bj = 0; bj < 2; ++bj) { const f32x4 v0 = v[ai][m][bj][0], v1 = v[ai][m][bj][1];
                    u32x4 w; w.x = cvt_pk_bf16(v0[0], v0[1]); w.y = cvt_pk_bf16(v0[2], v0[3]); w.z = cvt_pk_bf16(v1[0], v1[1]); w.w = cvt_pk_bf16(v1[2], v1[3]);
                    *(u32x4*)(rowp + bj * HALF) = w; } }
    }
};
struct EpiRes {
    static constexpr bool PERM = true;
    const float* base32; const bf16_t* base16; float* out32; bf16_t* xb; float* ssq; int ldc;
    __device__ __forceinline__ void operator()(const f32x4 (&acc)[2][2][4][2], const Unit& u, int wr, int wc, int fr, int fq, int lane, PG8_LAS float* xl) const {
        const int row0 = u.pm * BM + wr * 64 + fr, col0 = u.pn * BM + wc * 32 + 8 * fq;
        float sr[2][4];
#define PG8_RES_ROW(ai, m, B00, B01, B10, B11) do { const size_t off = (size_t)(row0 + (ai) * HALF + (m) * 16) * ldc + col0; float s = 0.f;                      \
            { const f32x4 o0 = (B00) + acc[ai][0][m][0], o1 = (B01) + acc[ai][0][m][1];                                                                     \
              if (out32) { *(f32x4*)(out32 + off) = o0; *(f32x4*)(out32 + off + 4) = o1; }                                                                  \
              if (xb) { s += ssq4(o0) + ssq4(o1); u32x4 w; w.x = cvt_pk_bf16(o0[0], o0[1]); w.y = cvt_pk_bf16(o0[2], o0[3]); w.z = cvt_pk_bf16(o1[0], o1[1]); w.w = cvt_pk_bf16(o1[2], o1[3]); *(u32x4*)(xb + off) = w; } } \
            { const f32x4 o0 = (B10) + acc[ai][1][m][0], o1 = (B11) + acc[ai][1][m][1];                                                                     \
              if (out32) { *(f32x4*)(out32 + off + HALF) = o0; *(f32x4*)(out32 + off + HALF + 4) = o1; }                                                    \
              if (xb) { s += ssq4(o0) + ssq4(o1); u32x4 w; w.x = cvt_pk_bf16(o0[0], o0[1]); w.y = cvt_pk_bf16(o0[2], o0[3]); w.z = cvt_pk_bf16(o1[0], o1[1]); w.w = cvt_pk_bf16(o1[2], o1[3]); *(u32x4*)(xb + off + HALF) = w; } } \
            sr[ai][m] = s; } while (0)
#define PG8_BF_LO(q_) ((f32x4){__builtin_bit_cast(float, (q_).x << 16), __builtin_bit_cast(float, (q_).x & 0xffff0000u), __builtin_bit_cast(float, (q_).y << 16), __builtin_bit_cast(float, (q_).y & 0xffff0000u)})
#define PG8_BF_HI(q_) ((f32x4){__builtin_bit_cast(float, (q_).z << 16), __builtin_bit_cast(float, (q_).z & 0xffff0000u), __builtin_bit_cast(float, (q_).w << 16), __builtin_bit_cast(float, (q_).w & 0xffff0000u)})
        if (base32) {
#pragma unroll
            for (int ai = 0; ai < 2; ++ai) { f32x4 b[4][2][2];
#pragma unroll
                for (int m = 0; m < 4; ++m) { const size_t off = (size_t)(row0 + ai * HALF + m * 16) * ldc + col0;
#pragma unroll
                    for (int bj = 0; bj < 2; ++bj) { b[m][bj][0] = *(const f32x4*)(base32 + off + bj * HALF); b[m][bj][1] = *(const f32x4*)(base32 + off + bj * HALF + 4); } }
#pragma unroll
                for (int m = 0; m < 4; ++m) PG8_RES_ROW(ai, m, b[m][0][0], b[m][0][1], b[m][1][0], b[m][1][1]); }
        } else {
            u32x4 w[2][4][2];
#pragma unroll
            for (int ai = 0; ai < 2; ++ai)
#pragma unroll
                for (int m = 0; m < 4; ++m) { const size_t off = (size_t)(row0 + ai * HALF + m * 16) * ldc + col0; w[ai][m][0] = *(const u32x4*)(base16 + off); w[ai][m][1] = *(const u32x4*)(base16 + off + HALF); }
#pragma unroll
            for (int ai = 0; ai < 2; ++ai)
#pragma unroll
                for (int m = 0; m < 4; ++m) PG8_RES_ROW(ai, m, PG8_BF_LO(w[ai][m][0]), PG8_BF_HI(w[ai][m][0]), PG8_BF_LO(w[ai][m][1]), PG8_BF_HI(w[ai][m][1]));
        }
#undef PG8_RES_ROW
#undef PG8_BF_LO
#undef PG8_BF_HI
        if (xb) {
#pragma unroll
            for (int ai = 0; ai < 2; ++ai)
#pragma unroll
                for (int m = 0; m < 4; ++m) { const float s = sum_fq(sr[ai][m], lane); if (fq == 0) xl[(ai * HALF + wr * 64 + m * 16 + fr) * 4 + wc] = s; }
            asm volatile("s_waitcnt lgkmcnt(0)" ::: "memory"); __builtin_amdgcn_s_barrier(); asm volatile("" ::: "memory");
            if (wc == 0 && fq == 0) {
#pragma unroll
                for (int ai = 0; ai < 2; ++ai)
#pragma unroll
                    for (int m = 0; m < 4; ++m) { const int r = ai * HALF + wr * 64 + m * 16 + fr; const f32x4 p = *(const PG8_LAS f32x4*)(xl + r * 4);
                        ssq[(size_t)(u.pm * BM + r) * 8 + u.pn] = (p[0] + p[1]) + (p[2] + p[3]); } }
        }
    }
};
__device__ __forceinline__ float silu_mul(float g, float u) { return g * u * __builtin_amdgcn_rcpf(1.0f + __builtin_amdgcn_exp2f(-1.4426950408889634f * g)); }
struct EpiSwiGLU {
    static constexpr bool PERM = true;
    bf16_t* O; int ldc; int nNl; const float* ssq; float eps; int probe;
    __device__ __forceinline__ void operator()(const f32x4 (&acc)[2][2][4][2], const Unit& u, int wr, int wc, int fr, int fq, int lane, PG8_LAS float* xl) const {
        const int pnl = u.pn - u.e * nNl;
        if (probe == 2) return;
        const int row0 = u.pm * BM + wr * 64 + fr, col0 = pnl * HALF + wc * 32 + 8 * fq;
        float rsv[2][4];
        if (ssq) row_rs8<8>(ssq, row0, 1.0f / 2048.0f, eps, rsv); else ones8(rsv);
#pragma unroll
        for (int ai = 0; ai < 2; ++ai)
#pragma unroll
            for (int m = 0; m < 4; ++m) { const int grow = row0 + ai * HALF + m * 16; bf16_t* rowp = O + (size_t)grow * ldc + col0;
                const float rs = rsv[ai][m];
                const f32x4 g0 = acc[ai][0][m][0] * rs, g1 = acc[ai][0][m][1] * rs, u0 = acc[ai][1][m][0] * rs, u1 = acc[ai][1][m][1] * rs;
                u32x4 w; w.x = cvt_pk_bf16(silu_mul(g0[0], u0[0]), silu_mul(g0[1], u0[1])); w.y = cvt_pk_bf16(silu_mul(g0[2], u0[2]), silu_mul(g0[3], u0[3]));
                w.z = cvt_pk_bf16(silu_mul(g1[0], u1[0]), silu_mul(g1[1], u1[1])); w.w = cvt_pk_bf16(silu_mul(g1[2], u1[2]), silu_mul(g1[3], u1[3]));
                if (probe != 1 || w.x == 0x12345678u) *(u32x4*)rowp = w; }
    }
};
struct EpiMoeDown {
    static constexpr bool PERM = true;
    bf16_t* Y; int ldc; int nNl; const float* glist; const int* cnt; int S_cap; bf16_t* P;
    __device__ __forceinline__ void operator()(const f32x4 (&acc)[2][2][4][2], const Unit& u, int wr, int wc, int fr, int fq, int lane, PG8_LAS float* xl) const {
        const int pnl = u.pn - u.e * nNl; const int n = cnt[u.e * CNT_STRIDE];
        const int r0 = wr * 64 + fr;
        char* const tbase = u.tail ? (char*)(P + (size_t)(u.tail - 1) * BM * BM) : (char*)(Y + (size_t)u.pm * BM * ldc + pnl * BM);
        const unsigned pitch = u.tail ? (unsigned)BM : (unsigned)ldc;
        float gtv[2][4];
#pragma unroll
        for (int ai = 0; ai < 2; ++ai)
#pragma unroll
            for (int m = 0; m < 4; ++m) { const int slot = u.lt * 256 + r0 + ai * HALF + m * 16; gtv[ai][m] = slot < n ? glist[(size_t)u.e * S_cap + slot] : 0.f; }
#pragma unroll
        for (int ai = 0; ai < 2; ++ai)
#pragma unroll
            for (int m = 0; m < 4; ++m) { const int r = r0 + ai * HALF + m * 16;
                const float gt = gtv[ai][m];
                bf16_t* rowp = (bf16_t*)(tbase + ((unsigned)r * pitch + (unsigned)(wc * 32 + 8 * fq)) * 2u);
#pragma unroll
                for (int bj = 0; bj < 2; ++bj) { const f32x4 v0 = acc[ai][bj][m][0] * gt, v1 = acc[ai][bj][m][1] * gt;
                    u32x4 w; w.x = cvt_pk_bf16(v0[0], v0[1]); w.y = cvt_pk_bf16(v0[2], v0[3]); w.z = cvt_pk_bf16(v1[0], v1[1]); w.w = cvt_pk_bf16(v1[2], v1[3]);
                    *(u32x4*)(rowp + bj * HALF) = w; } }
    }
};

template <class Epi, class Sched, bool GATHER, bool KS = false>
__device__ __forceinline__ void gemm_phase(PG8_LAS unsigned char* lds, const Gemm g, const Sched& S, const Epi& E, const int wid_in, PG8_LAS float* xlds) {
    int wid_ = wid_in; asm volatile("" : "+s"(wid_)); const int wid = wid_;
    int lane_; asm volatile("v_mbcnt_lo_u32_b32 %0, -1, 0\n\tv_mbcnt_hi_u32_b32 %0, -1, %0" : "=v"(lane_));
    const int lane = lane_, tid = wid * 64 + lane, wr = wid >> 2, wc = wid & 3, fr = lane & 15, fq = lane >> 4;
    const int K = g.K; int nt = K / BK;
    unsigned voffA[2], voffB[2]; int Rg[2];
#pragma unroll
    for (int i = 0; i < 2; ++i) { int R, C; stage_rc(tid * 16 + i * 8192, R, C); const int Rb = Epi::PERM ? ((R & ~31) + perm32(R & 31)) : R;
        voffA[i] = GATHER ? (unsigned)(C * 2) : (unsigned)(R * g.lda + C) * 2u; voffB[i] = (unsigned)(Rb * K + C) * 2u; Rg[i] = R; }
    const size_t kstep = (size_t)(BK * 2);
    const size_t hstep = (size_t)HALF * K * 2;
    const size_t tstep = 2 * hstep;
    const size_t hstepA = (size_t)HALF * g.lda * 2, tstepA = 2 * hstepA;
    const unsigned ldsw = (unsigned)wid * 1024u;
    const int aoff = lds_byte(wr * 64 + fr, fq * 8), boff = lds_byte(wc * 32 + fr, fq * 8);
#define PG8_SA(b, h) (((b) * 2 + (h)) * HTB)
#define PG8_SB(b, h) ((4 + (b) * 2 + (h)) * HTB)
#define PG8_STAGE(bufoff, gbase, voff) do { _Pragma("unroll") for (int _i = 0; _i < 2; ++_i) \
        __builtin_amdgcn_global_load_lds((const unsigned*)((const char*)(gbase) + (voff)[_i]), (PG8_LAS unsigned*)(lds + (bufoff) + ldsw + _i * 8192), 16, 0, 0); } while (0)
#define PG8_STA(bufoff, pbase, gbase, half, goff) do { if constexpr (GATHER) PG8_STAGE(bufoff, gbase, (goff)[half]); else PG8_STAGE(bufoff, (pbase) + (half) * hstepA, voffA); } while (0)
#define PG8_LDA(dst, b, h) do { _Pragma("unroll") for (int m = 0; m < 4; ++m) _Pragma("unroll") for (int k = 0; k < 2; ++k) dst[m][k] = *(const PG8_LAS bf16x8*)(lds + PG8_SA(b, h) + aoff + m * 2048 + k * 1024); } while (0)
#define PG8_LDB(dst, b, h) do { _Pragma("unroll") for (int n = 0; n < 2; ++n) _Pragma("unroll") for (int k = 0; k < 2; ++k) dst[n][k] = *(const PG8_LAS bf16x8*)(lds + PG8_SB(b, h) + boff + n * 2048 + k * 1024); } while (0)
#define PG8_MMA(ai, bj, At, Bt) do { __builtin_amdgcn_s_setprio(1); _Pragma("unroll") for (int m = 0; m < 4; ++m) _Pragma("unroll") for (int n = 0; n < 2; ++n) _Pragma("unroll") for (int k = 0; k < 2; ++k) \
        acc[ai][bj][m][n] = __builtin_amdgcn_mfma_f32_16x16x32_bf16(Bt[n][k], At[m][k], acc[ai][bj][m][n], 0, 0, 0); __builtin_amdgcn_s_setprio(0); } while (0)
#define PG8_WAIT_V(n) asm volatile("s_waitcnt vmcnt(" #n ")" ::: "memory")
#define PG8_WAIT_L(n) asm volatile("s_waitcnt lgkmcnt(" #n ")" ::: "memory")
#define PG8_BAR __builtin_amdgcn_s_barrier()
#define PG8_SCHED __builtin_amdgcn_sched_barrier(0)
#define PG8_GFILL(u, o) do { _Pragma("unroll") for (int _h = 0; _h < 2; ++_h) _Pragma("unroll") for (int _i = 0; _i < 2; ++_i) (o)[_h][_i] = S.a_off(u, _h * HALF + Rg[_i]) + voffA[_i]; } while (0)
    Unit cur, nxt; int ui = 0;
    if (!S.next(0, cur)) return;
    f32x4 acc[2][2][4][2];
#pragma unroll
    for (int a = 0; a < 2; ++a)
#pragma unroll
        for (int b = 0; b < 2; ++b)
#pragma unroll
            for (int m = 0; m < 4; ++m)
#pragma unroll
                for (int n = 0; n < 2; ++n) acc[a][b][m][n] = (f32x4){0.f, 0.f, 0.f, 0.f};
    bf16x8 At[4][2], B0[2][2], B1[2][2];
    unsigned gc[2][2] = {{0u, 0u}, {0u, 0u}}, gn[2][2] = {{0u, 0u}, {0u, 0u}};
    if constexpr (GATHER) PG8_GFILL(cur, gc);
    if constexpr (KS) nt = cur.nkt;
    const char* const gA = (const char*)g.A;
    const char* cA = GATHER ? gA : gA + (size_t)cur.pm * tstepA + (KS ? (size_t)cur.kt0 * kstep : 0); const char* cB = (const char*)g.Bt + (size_t)cur.pn * tstep + (KS ? (size_t)cur.kt0 * kstep : 0);
    PG8_STAGE(PG8_SB(0, 0), cB, voffB); PG8_STAGE(PG8_SB(0, 1), cB + hstep, voffB); PG8_STA(PG8_SA(0, 0), cA, gA, 0, gc); PG8_STA(PG8_SA(0, 1), cA, gA, 1, gc);
    if (wr == 1) PG8_BAR;
    PG8_WAIT_V(2); PG8_BAR;
    PG8_STAGE(PG8_SB(1, 0), cB + kstep, voffB); PG8_STA(PG8_SA(1, 0), cA + kstep, gA + kstep, 0, gc); PG8_STAGE(PG8_SB(1, 1), cB + hstep + kstep, voffB);
    PG8_WAIT_V(6); PG8_BAR;
    for (;;) {
        const bool has_next = S.next(ui + 1, nxt);
        if constexpr (GATHER) { if (has_next) PG8_GFILL(nxt, gn); else {
#pragma unroll
            for (int h = 0; h < 2; ++h)
#pragma unroll
                for (int i = 0; i < 2; ++i) gn[h][i] = gc[h][i]; } }
        const char* nA = (has_next && !GATHER) ? gA + (size_t)nxt.pm * tstepA + (KS ? (size_t)nxt.kt0 * kstep : 0) : cA; const char* nB = has_next ? (const char*)g.Bt + (size_t)nxt.pn * tstep + (KS ? (size_t)nxt.kt0 * kstep : 0) : cB;
        for (int t = 0; t < nt; t += 2) {
#ifdef KLOOP_ALIGN
            asm volatile(".p2align 6\n\t.rept " KLOOP_ALIGN "\n\ts_nop 0\n\t.endr");
#endif
            const bool last = (t == nt - 2);
            const char* a1 = cA + (size_t)(t + 1) * kstep;
            const char* a2 = last ? nA : cA + (size_t)(t + 2) * kstep; const char* b2 = last ? nB : cB + (size_t)(t + 2) * kstep;
            const char* a3 = a2 + kstep; const char* b3 = b2 + kstep;
            unsigned gs[2][2];
#pragma unroll
            for (int h = 0; h < 2; ++h)
#pragma unroll
                for (int i = 0; i < 2; ++i) gs[h][i] = last ? gn[h][i] : gc[h][i];
            PG8_LDB(B0, 0, 0); PG8_LDB(B1, 0, 1); PG8_SCHED; PG8_LDA(At, 0, 0); PG8_STA(PG8_SA(1, 1), a1, a1, 1, gc);
            PG8_WAIT_V(8); PG8_WAIT_L(0); PG8_BAR; PG8_MMA(0, 0, At, B0); PG8_MMA(0, 1, At, B1); PG8_BAR; PG8_SCHED;
            PG8_LDA(At, 0, 1); PG8_STAGE(PG8_SB(0, 0), b2, voffB); PG8_STAGE(PG8_SB(0, 1), b2 + hstep, voffB); PG8_STA(PG8_SA(0, 0), a2, a2, 0, gs);
            PG8_WAIT_V(8); PG8_WAIT_L(0); PG8_BAR; PG8_MMA(1, 0, At, B0); PG8_MMA(1, 1, At, B1); PG8_BAR; PG8_SCHED;
            PG8_LDB(B0, 1, 0); PG8_LDB(B1, 1, 1); PG8_SCHED; PG8_LDA(At, 1, 0); PG8_STA(PG8_SA(0, 1), a2, a2, 1, gs);
            PG8_WAIT_V(8); PG8_WAIT_L(0); PG8_BAR; PG8_MMA(0, 0, At, B0); PG8_MMA(0, 1, At, B1); PG8_BAR; PG8_SCHED;
            PG8_LDA(At, 1, 1); PG8_STAGE(PG8_SB(1, 0), b3, voffB); PG8_STAGE(PG8_SB(1, 1), b3 + hstep, voffB); PG8_STA(PG8_SA(1, 0), a3, a3, 0, gs);
            PG8_WAIT_V(8); PG8_WAIT_L(0); PG8_BAR; PG8_MMA(1, 0, At, B0); PG8_MMA(1, 1, At, B1); PG8_BAR; PG8_SCHED;
        }
        if (wr == 0) PG8_BAR;
        E(acc, cur, wr, wc, fr, fq, lane, xlds);
        if (!has_next) break;
#pragma unroll
        for (int a = 0; a < 2; ++a)
#pragma unroll
            for (int b = 0; b < 2; ++b)
#pragma unroll
                for (int m = 0; m < 4; ++m)
#pragma unroll
                    for (int n = 0; n < 2; ++n) acc[a][b][m][n] = (f32x4){0.f, 0.f, 0.f, 0.f};
        cur = nxt; cA = nA; cB = nB; ++ui; if constexpr (KS) nt = cur.nkt;
#pragma unroll
        for (int h = 0; h < 2; ++h)
#pragma unroll
            for (int i = 0; i < 2; ++i) gc[h][i] = gn[h][i];
        if (wr == 1) PG8_BAR;
    }
    PG8_WAIT_V(0);
    PG8_BAR;
#undef PG8_SA
#undef PG8_SB
#undef PG8_STAGE
#undef PG8_STA
#undef PG8_LDA
#undef PG8_LDB
#undef PG8_MMA
#undef PG8_WAIT_V
#undef PG8_WAIT_L
#undef PG8_BAR
#undef PG8_SCHED
#undef PG8_GFILL
}
}
namespace att {
#define ALAS __attribute__((address_space(3)))
typedef unsigned short bf16_t;
typedef short bf16x8 __attribute__((ext_vector_type(8)));
typedef short s16x4 __attribute__((ext_vector_type(4)));
typedef float f32x16 __attribute__((ext_vector_type(16)));
typedef float f32x4 __attribute__((ext_vector_type(4)));
typedef unsigned u32x4 __attribute__((ext_vector_type(4)));
typedef ALAS char* lptr;
constexpr int NW = 8, QBLK = 32, KVBLK = 64, QB = NW * QBLK;
constexpr int SHM_V = KVBLK * 128 * 2;
constexpr int TBL_U0 = 2400, TBL_N = 2688;
constexpr float THR = 8.f;

template <int DQK_, int QP_, int KP_, int VP_, int OP_, bool TBL_, int LP_ = 0, int JMIN_ = 0> struct Cfg {
    static constexpr int DQK = DQK_, QP = QP_, KP = KP_, VP = VP_, OP = OP_, LP = LP_, JMIN = JMIN_; static constexpr bool TBL = TBL_;
    static constexpr int ND = DQK / 16, NKC = DQK / 64, KROW = DQK * 2, SHM_K = KVBLK * DQK * 2;
    static constexpr float SCALE = (DQK == 128) ? 0.08838834764831845f : 0.07216878364870323f;
    static constexpr int OFF_K = 0, OFF_V = 2 * SHM_K, OFF_WS = 2 * SHM_V + 2 * SHM_K;
    static constexpr int OFF_TBL = OFF_WS + NW * 64 * 4, OFF_QR = OFF_TBL + (TBL ? TBL_N * 4 : 0), LDS_BYTES = OFF_QR + (DQK > 128 ? NW * 4096 : 0);
    static_assert(LDS_BYTES <= 131072, "attention LDS");
};

#define SBAR() __builtin_amdgcn_sched_barrier(0)
__device__ __forceinline__ int v_st(int k, int c) { const int kk = (k & ~0xC) | ((k & 4) << 1) | ((k & 8) >> 1); return ((kk >> 3) * 4 + (c >> 5)) * 512 + ((kk & 7) * 32 + (c & 31)) * 2; }
__device__ __forceinline__ int v_rd_base(int lane) { return ((lane & 3) << 3) | (((lane >> 2) & 3) << 6) | (((lane >> 4) & 1) << 5) | (((lane >> 5) & 1) << 8); }
constexpr int v_rd_off(int d0, int ks, int half) { return d0 * 512 + ks * 4096 + half * 2048; }
__device__ __forceinline__ int crow(int r, int hi) { return (r & 3) + 8 * (r >> 2) + 4 * hi; }
__device__ __forceinline__ unsigned cvtpk(float lo, float hi) { unsigned r; asm volatile("v_cvt_pk_bf16_f32 %0, %1, %2" : "=v"(r) : "v"(lo), "v"(hi)); return r; }
__device__ __forceinline__ bf16x8 ld8(const bf16_t* p) { return *reinterpret_cast<const bf16x8*>(p); }
__device__ __forceinline__ bf16x8 ld8u(const bf16_t* ubase, unsigned boff) { return *reinterpret_cast<const bf16x8*>((const char*)ubase + boff); }

__device__ __forceinline__ void mask_tile(f32x16& p0, f32x16& p1, int dq) {
    const float NEG = -__builtin_inff();
#pragma unroll
    for (int r = 0; r < 16; ++r) {
        const int c = (r & 3) + 8 * (r >> 2);
        if (dq - c < 0) p0[r] = NEG;
        if (dq - c - 32 < 0) p1[r] = NEG;
    }
}
__device__ __forceinline__ void table_tile(f32x16& p0, f32x16& p1, const ALAS float* tb) {
#pragma unroll
    for (int r = 0; r < 16; ++r) {
        const int c = (r & 3) + 8 * (r >> 2);
        p0[r] += tb[c]; p1[r] += tb[c + 32];
    }
}
template <class C>
__device__ __forceinline__ void partialSM(f32x16& p0, f32x16& p1, float& m_reg, float& mn, float& alpha) {
    float pmax = p0[0];
#pragma unroll
    for (int r = 1; r < 16; ++r) pmax = fmaxf(pmax, p0[r]);
#pragma unroll
    for (int r = 0; r < 16; ++r) pmax = fmaxf(pmax, p1[r]);
    { auto rr = __builtin_amdgcn_permlane32_swap(__float_as_uint(pmax), __float_as_uint(pmax), false, false);
      pmax = fmaxf(__uint_as_float(rr[0]), __uint_as_float(rr[1])); }
    constexpr float C2 = 1.4426950408889634f * C::SCALE;
    if (__builtin_expect(__all((pmax - m_reg) * C::SCALE <= THR), 1)) { mn = m_reg; alpha = 1.f; }
    else { mn = fmaxf(m_reg, pmax); alpha = __builtin_amdgcn_exp2f((m_reg - mn) * C2); m_reg = mn; }
    const float mnL = -mn * C2;
#pragma unroll
    for (int r = 0; r < 16; ++r) p0[r] = fmaf(p0[r], C2, mnL);
#pragma unroll
    for (int r = 0; r < 16; ++r) p1[r] = fmaf(p1[r], C2, mnL);
#pragma unroll
    for (int r = 0; r < 16; ++r) p0[r] = __builtin_amdgcn_exp2f(p0[r]);
}
__device__ __forceinline__ void finishSM(f32x16& p0, f32x16& p1, float alpha, float& l_reg, bf16x8& pa0, bf16x8& pa1, bf16x8& pa2, bf16x8& pa3) {
#pragma unroll
    for (int r = 0; r < 16; ++r) p1[r] = __builtin_amdgcn_exp2f(p1[r]);
    float ps = 0;
#pragma unroll
    for (int r = 0; r < 16; ++r) ps += p0[r];
#pragma unroll
    for (int r = 0; r < 16; ++r) ps += p1[r];
    { auto rr = __builtin_amdgcn_permlane32_swap(__float_as_uint(ps), __float_as_uint(ps), false, false);
      ps = __uint_as_float(rr[0]) + __uint_as_float(rr[1]); }
    l_reg = l_reg * alpha + ps;
#define PK4(P, B_, OUT) do { unsigned a0 = cvtpk(P[B_+0], P[B_+1]), a1 = cvtpk(P[B_+2], P[B_+3]);                          \
        unsigned b0 = cvtpk(P[B_+4], P[B_+5]), b1 = cvtpk(P[B_+6], P[B_+7]);                                             \
        auto r0 = __builtin_amdgcn_permlane32_swap(a0, b0, false, false); auto r1 = __builtin_amdgcn_permlane32_swap(a1, b1, false, false); \
        u32x4 w = {r0[0], r1[0], r0[1], r1[1]}; OUT = *reinterpret_cast<bf16x8*>(&w); } while (0)
    PK4(p0, 0, pa0); PK4(p0, 8, pa1); PK4(p1, 0, pa2); PK4(p1, 8, pa3);
#undef PK4
}
template <class C, int KB>
__device__ __forceinline__ void qkt(f32x16& p0, f32x16& p1, lptr K_lds, int r32, int hi, const bf16x8* qr, lptr qlds) {
    p0 = f32x16{}; p1 = f32x16{};
    lptr kb[4];
#pragma unroll
    for (int dd = 0; dd < 4; ++dd) {
        const int sw = (C::DQK == 128) ? (r32 & 7) : ((r32 >> 1) & 7);
        kb[dd] = K_lds + KB * C::SHM_K + r32 * C::KROW + 16 * ((2 * dd + hi) ^ sw);
    }
#pragma unroll
    for (int d0 = 0; d0 < C::ND; ++d0) { lptr a = kb[d0 & 3] + (d0 >> 2) * 128;
        bf16x8 b0 = *reinterpret_cast<const ALAS bf16x8*>(a);
        bf16x8 b1 = *reinterpret_cast<const ALAS bf16x8*>(a + 32 * C::KROW);
        bf16x8 q; if (d0 < 8) q = qr[d0]; else q = *reinterpret_cast<const ALAS bf16x8*>(qlds + (d0 - 8) * 1024);
        p0 = __builtin_amdgcn_mfma_f32_32x32x16_bf16(b0, q, p0, 0, 0, 0);
        p1 = __builtin_amdgcn_mfma_f32_32x32x16_bf16(b1, q, p1, 0, 0, 0); }
}
template <int VB>
__device__ __forceinline__ void pv_tile(f32x16* o, int vb0, bf16x8 pa0, bf16x8 pa1, bf16x8 pa2, bf16x8 pa3) {
#define TRRD(dst, off) asm volatile("ds_read_b64_tr_b16 %0, %1 offset:%2" : "=&v"(dst) : "v"(vb0), "i"(off) : "memory")
#define PV_D0(d0) do { s16x4 l0, l1, l2, l3, h0, h1, h2, h3; constexpr int b_ = VB * SHM_V + v_rd_off(d0, 0, 0); \
        TRRD(l0, b_); TRRD(h0, b_ + 2048); TRRD(l1, b_ + 4096); TRRD(h1, b_ + 6144); TRRD(l2, b_ + 8192); TRRD(h2, b_ + 10240); TRRD(l3, b_ + 12288); TRRD(h3, b_ + 14336); \
        asm volatile("s_waitcnt lgkmcnt(0)" ::: "memory"); SBAR();   \
        o[d0] = __builtin_amdgcn_mfma_f32_32x32x16_bf16(pa0, (bf16x8){l0[0], l0[1], l0[2], l0[3], h0[0], h0[1], h0[2], h0[3]}, o[d0], 0, 0, 0);   \
        o[d0] = __builtin_amdgcn_mfma_f32_32x32x16_bf16(pa1, (bf16x8){l1[0], l1[1], l1[2], l1[3], h1[0], h1[1], h1[2], h1[3]}, o[d0], 0, 0, 0);   \
        o[d0] = __builtin_amdgcn_mfma_f32_32x32x16_bf16(pa2, (bf16x8){l2[0], l2[1], l2[2], l2[3], h2[0], h2[1], h2[2], h2[3]}, o[d0], 0, 0, 0);   \
        o[d0] = __builtin_amdgcn_mfma_f32_32x32x16_bf16(pa3, (bf16x8){l3[0], l3[1], l3[2], l3[3], h3[0], h3[1], h3[2], h3[3]}, o[d0], 0, 0, 0); } while (0)
    PV_D0(0); PV_D0(1); PV_D0(2); PV_D0(3);
#undef PV_D0
#undef TRRD
}

struct BlockRef { const bf16_t* Q; const bf16_t* K; const bf16_t* V; bf16_t* O; float* lse; int P0; };
template <class C> struct Seam { bf16x8 qr[C::ND]; bf16x8 st_v0, st_v1; bf16x8 st_k[C::NKC]; };
__device__ __forceinline__ int swa_jlo(int P0, int W) { const int lowk = P0 - W + 1; return lowk > 0 ? lowk / KVBLK : 0; }

#define VMW() asm volatile("s_waitcnt vmcnt(0)" ::: "memory")
#define VMWN(n) asm volatile("s_waitcnt vmcnt(%0)" :: "i"(n) : "memory")
#define SLOAD_H(Kp, Vp, k0) do { const bf16_t* vu_ = (Vp) + (size_t)(k0) * C::VP; const bf16_t* ku_ = (Kp) + (size_t)(k0) * C::KP;                        \
        S.st_v0 = ld8u(vu_, voffV); S.st_v1 = ld8u(vu_ + 32 * C::VP, voffV);     \
        if constexpr (C::DQK == 128) { S.st_k[0] = ld8u(ku_, voffK); S.st_k[1] = ld8u(ku_ + 32 * C::KP, voffK); } \
        else { _Pragma("unroll") for (int i_ = 0; i_ < 3; ++i_) S.st_k[i_] = ld8u(ku_ + 64 * i_, voffK); } } while (0)
#define SWRITE_HK(bf) do { if constexpr (C::DQK == 128) { *(ALAS bf16x8*)(K_lds + (bf) * C::SHM_K + kws) = S.st_k[0]; *(ALAS bf16x8*)(K_lds + (bf) * C::SHM_K + kws + 32 * 256) = S.st_k[1]; } \
        else { _Pragma("unroll") for (int i_ = 0; i_ < 3; ++i_) *(ALAS bf16x8*)(K_lds + (bf) * C::SHM_K + kws + 128 * i_) = S.st_k[i_]; } } while (0)
#define SWRITE_HV(bf) do { *(ALAS bf16x8*)(V_lds + (bf) * SHM_V + vst0) = S.st_v0; *(ALAS bf16x8*)(V_lds + (bf) * SHM_V + vst1) = S.st_v1; } while (0)
#define SWRITE_H(bf) do { SWRITE_HV(bf); SWRITE_HK(bf); } while (0)
#define ATT_IDX() int lane_; asm volatile("v_mbcnt_lo_u32_b32 %0, -1, 0\n\tv_mbcnt_hi_u32_b32 %0, -1, %0" : "=v"(lane_)); const int lane = lane_, tid = wid * 64 + lane, r32 = lane & 31, hi = lane >> 5; \
    const int sr = tid >> 4, sc = (tid & 15) * 8, kr = tid >> 3, kc = (tid & 7) * 8; \
    const int kws = (C::DQK == 128) ? (sr * 256 + ((sc * 2) ^ ((sr & 7) << 4))) : (kr * 384 + 16 * ((tid & 7) ^ ((kr >> 1) & 7))); \
    const unsigned voffV = (unsigned)(sr * C::VP + sc) * 2u, voffK = (C::DQK == 128) ? (unsigned)(sr * C::KP + sc) * 2u : (unsigned)(kr * C::KP + kc) * 2u, voffQ = (unsigned)((wid * QBLK + r32) * C::QP + hi * 8) * 2u; \
    (void)wid; (void)lane; (void)r32; (void)hi; (void)kr; (void)kc; (void)sr; (void)sc; (void)kws; (void)voffV; (void)voffK; (void)voffQ

template <class C>
__device__ __forceinline__ void prime(const BlockRef& cur, int W, lptr lds, Seam<C>& S, const int wid) {
    ATT_IDX(); lptr K_lds = lds + C::OFF_K;
    const int kb0 = swa_jlo(cur.P0, W) * KVBLK;
#pragma unroll
    for (int d0 = 0; d0 < C::ND; ++d0) S.qr[d0] = ld8u(cur.Q + d0 * 16, voffQ);
    SLOAD_H(cur.K, cur.V, kb0); VMW(); SWRITE_HK(0);
    __syncthreads();
}
template <class C>
__device__ __forceinline__ void block(const BlockRef& cur, const BlockRef& nxt, int skv, int W, lptr lds, Seam<C>& S, const int wid) {
    ATT_IDX();
    const int j_lo = swa_jlo(cur.P0, W);
    int j_hi = (cur.P0 + QB - 1 - C::JMIN) / KVBLK + 1; if (j_hi > skv / KVBLK) j_hi = skv / KVBLK;
    const int NT = j_hi - j_lo;
    const int kbn = swa_jlo(nxt.P0, W) * KVBLK;
    const int qlo = cur.P0 + wid * QBLK, qm = qlo + r32 - 4 * hi;
    lptr V_lds = lds + C::OFF_V; lptr K_lds = lds + C::OFF_K;
    ALAS float* ws = (ALAS float*)(lds + C::OFF_WS) + wid * 64; ALAS float* li_l = ws; ALAS float* al_l = ws + 32;
    const ALAS float* tbl = (const ALAS float*)(lds + C::OFF_TBL);
    float m_reg = -1e30f, l_reg = 0; f32x16 o[4] = {};
    const int vst0 = v_st(sr, sc), vst1 = v_st(32 + sr, sc);
    const int vb0 = (int)(unsigned)(uintptr_t)V_lds + v_rd_base(lane);
    const bf16_t* Kh = cur.K; const bf16_t* Vh = cur.V;
#define RESC(a) do { if (__any((a) < 1.f)) { if (hi == 0) al_l[r32] = (a); asm volatile("s_waitcnt lgkmcnt(0)" ::: "memory");              \
                     _Pragma("unroll") for (int d_ = 0; d_ < 4; ++d_) _Pragma("unroll") for (int r = 0; r < 16; ++r) o[d_][r] *= al_l[crow(r, hi)]; } } while (0)
#define KBASE(t) ((j_lo + (t)) * KVBLK)
#define MASKT(P0_, P1_, t) do { const int kb_ = KBASE(t); if constexpr (C::TBL) { table_tile(P0_, P1_, tbl + (TBL_U0 - (qm - kb_))); } \
                                else { if (kb_ + KVBLK - 1 > qlo) mask_tile(P0_, P1_, qm - kb_); } } while (0)
#define SEAM_K0() do { VMWN(C::ND); SWRITE_HK(0); SBAR(); } while (0)
    f32x16 pA0, pA1, pB0, pB1; float mnA, mnB, alA, alB; bf16x8 pa0, pa1, pa2, pa3;
    lptr qlds = lds + C::OFF_QR + wid * 4096 + lane * 16;
    if constexpr (C::DQK > 128) {
#pragma unroll
        for (int d0 = 8; d0 < C::ND; ++d0) *reinterpret_cast<ALAS bf16x8*>(qlds + (d0 - 8) * 1024) = S.qr[d0]; }
    SWRITE_HV(0); SBAR();
    if (NT > 1) { SLOAD_H(Kh, Vh, KBASE(1)); }
    SBAR(); qkt<C, 0>(pA0, pA1, K_lds, r32, hi, S.qr, qlds);
    MASKT(pA0, pA1, 0); partialSM<C>(pA0, pA1, m_reg, mnA, alA);
    if (NT > 1) { VMW(); SWRITE_H(1); }
    __syncthreads();
#define HALF_STEP(PX0, PX1, mnX, alX, PY0, PY1, alY, t, KB, VB, SB) do {                                                      \
        SBAR(); qkt<C, KB>(PX0, PX1, K_lds, r32, hi, S.qr, qlds);                                                                   \
        finishSM(PY0, PY1, alY, l_reg, pa0, pa1, pa2, pa3); SBAR();                                                           \
        if ((t) + 1 < NT) { SLOAD_H(Kh, Vh, KBASE((t) + 1)); SBAR(); }                                                        \
        pv_tile<VB>(o, vb0, pa0, pa1, pa2, pa3); MASKT(PX0, PX1, (t)); partialSM<C>(PX0, PX1, m_reg, mnX, alX);               \
        __syncthreads();                                                                                                      \
        if ((t) + 1 < NT) { VMW(); SWRITE_H(SB); }                                                                            \
        RESC(alX); __syncthreads(); } while (0)
    for (int t = 1; t + 1 < NT; t += 2) {
#ifdef ALOOP_ALIGN
        asm volatile(".p2align 6\n\t.rept " ALOOP_ALIGN "\n\ts_nop 0\n\t.endr");
#endif
#ifdef ALOOP_ALIGN3
        if constexpr (C::DQK == 192) asm volatile(".p2align 6\n\t.rept " ALOOP_M "\n\ts_nop 0\n\t.endr"); else if constexpr (C::JMIN == 0) asm volatile(".p2align 6\n\t.rept " ALOOP_A "\n\ts_nop 0\n\t.endr"); else asm volatile(".p2align 6\n\t.rept " ALOOP_B "\n\ts_nop 0\n\t.endr");
#endif
        HALF_STEP(pB0, pB1, mnB, alB, pA0, pA1, alA, t, 1, 0, 0);
        HALF_STEP(pA0, pA1, mnA, alA, pB0, pB1, alB, t + 1, 0, 1, 1);
    }
    {
    int lane2_; asm volatile("v_mbcnt_lo_u32_b32 %0, -1, 0\n\tv_mbcnt_hi_u32_b32 %0, -1, %0" : "=v"(lane2_));
    const int lane = lane2_, r32 = lane & 31, hi = lane >> 5, qm = qlo + r32 - 4 * hi;
    const unsigned voffQ = (unsigned)((wid * QBLK + r32) * C::QP + hi * 8) * 2u;
    lptr qlds = lds + C::OFF_QR + wid * 4096 + lane * 16; (void)qlds; (void)qm;
    const bool even = (NT & 1) == 0;
    if (even) { SBAR(); qkt<C, 1>(pB0, pB1, K_lds, r32, hi, S.qr, qlds); SBAR(); }
    SLOAD_H(nxt.K, nxt.V, kbn); SBAR();
#pragma unroll
    for (int d0 = 0; d0 < C::ND; ++d0) S.qr[d0] = ld8u(nxt.Q + d0 * 16, voffQ);
    SBAR();
    finishSM(pA0, pA1, alA, l_reg, pa0, pa1, pa2, pa3); SBAR();
    pv_tile<0>(o, vb0, pa0, pa1, pa2, pa3);
    if (even) { MASKT(pB0, pB1, NT - 1); partialSM<C>(pB0, pB1, m_reg, mnB, alB); __syncthreads(); RESC(alB);
        finishSM(pB0, pB1, alB, l_reg, pa0, pa1, pa2, pa3); SBAR(); pv_tile<1>(o, vb0, pa0, pa1, pa2, pa3); }
    SBAR(); SEAM_K0();
    if (hi == 0) li_l[r32] = l_reg; asm volatile("s_waitcnt lgkmcnt(0)" ::: "memory");
    float rli[16];
#pragma unroll
    for (int r = 0; r < 16; ++r) { const float lv = li_l[crow(r, hi)]; rli[r] = lv > 0.f ? __builtin_amdgcn_rcpf(lv) : 0.f; }
    if constexpr (C::LP > 0) { if (hi == 0) cur.lse[(size_t)(wid * QBLK + r32) * C::LP] = l_reg > 0.f ? m_reg * C::SCALE + __logf(l_reg) : -__builtin_inff(); }
    char* const Ou = (char*)cur.O;
    const unsigned ooff = (unsigned)((wid * QBLK + 4 * hi) * C::OP + r32) * 2u;
#pragma unroll
    for (int r = 0; r < 16; ++r) { const int orow = (r & 3) + 8 * (r >> 2);
#pragma unroll
        for (int d0 = 0; d0 < 4; ++d0) { const float v = o[d0][r] * rli[r];
            const float vn = __builtin_bit_cast(float, __builtin_amdgcn_mov_dpp(__builtin_bit_cast(int, v), 0xB1, 0xF, 0xF, true));
            if ((r32 & 1) == 0) *(unsigned*)(Ou + ooff + (unsigned)(orow * C::OP + d0 * 32) * 2u) = cvtpk(v, vn); } }
    }
    __syncthreads();
#undef RESC
#undef KBASE
#undef MASKT
#undef SEAM_K0
#undef HALF_STEP
}
#undef VMW
#undef VMWN
#undef SLOAD_H
#undef SWRITE_HK
#undef SWRITE_HV
#undef SWRITE_H
#undef ATT_IDX
#undef SBAR
}
constexpr int NWAVES = 8;
constexpr int S_ = 16384, DM = 2048, NLAYER = 2;
constexpr int WA = 1024, QLORA = 512, KVLORA = 256, ROPE = 64, INC = 3904, INP = 4096;
constexpr int C_QA = 0, C_KA = 1024, C_VA = 2048, C_CQ = 3072, C_CKV = 3584, C_KR = 3840;
constexpr int NH = 8, HD = 128, QKB = 192, NQB_ = 1536  , NKVB = 2048  ;
constexpr int FF = 5632, NEXP = 8, NGU = 2 * FF  , NT_GU = NGU / 256  , NT_D = DM / 256  ;
constexpr int MT_MAX = 136;
constexpr float EPS = 1e-6f;
constexpr int W_DIL = 2049;
constexpr int W_CAUSAL = 0x40000000;

constexpr size_t MiB = 1u << 20;
constexpr size_t WS_CTL = 0, CTL_ZERO_BYTES = 32 * 1024;
constexpr size_t WS_TBL = 1 * MiB;
constexpr size_t WS_POS = 1 * MiB + 512 * 1024;
constexpr size_t WS_LTOK = 2 * MiB;
constexpr size_t WS_LGATE = 2 * MiB + 512 * 1024;
constexpr size_t WS_SSQ0 = 3 * MiB;
constexpr size_t WS_SSQX = WS_SSQ0 + 64 * 1024;
constexpr size_t WS_SSQC = WS_SSQX + 1 * MiB;
static_assert(WS_SSQC + 256 * 1024 <= 6 * MiB, "ws map");
constexpr size_t WS_WIN = 6 * MiB;
constexpr size_t WS_WQB = WS_WIN + 32 * MiB;
constexpr size_t WS_WKVB = WS_WQB + 3 * MiB;
constexpr size_t WS_WOUT = WS_WKVB + 2 * MiB;
constexpr size_t WS_WGU = WS_WOUT + 16 * MiB;
constexpr size_t WS_WD = WS_WGU + 44 * MiB;
constexpr size_t WS_WGUE = WS_WD + 22 * MiB;
constexpr size_t WS_WDE = WS_WGUE + 352 * MiB;
constexpr size_t WS_H = WS_WDE + 176 * MiB;
constexpr size_t WS_ACTS = WS_H + 64 * MiB;
constexpr size_t WS_PROJ = WS_ACTS;
constexpr size_t WS_QM = WS_PROJ + 128 * MiB;
constexpr size_t WS_KVM = WS_QM + 48 * MiB;
constexpr size_t WS_KM = WS_KVM + 64 * MiB;
constexpr size_t WS_CQN = WS_KM + 48 * MiB;
constexpr size_t WS_CKVN = WS_CQN + 16 * MiB;
constexpr size_t WS_ATT = WS_CKVN + 8 * MiB;
constexpr size_t WS_OA = WS_ATT + 64 * MiB, WS_OB = WS_OA + 32 * MiB;
constexpr size_t WS_LSEA = WS_OB + 32 * MiB, WS_LSEB = WS_LSEA + 1 * MiB;
constexpr size_t WS_ACT = WS_ACTS;
constexpr size_t WS_Y = WS_ACT + 374 * MiB;
constexpr size_t WS_PT = WS_Y + 136 * MiB;
constexpr size_t WS_HN = WS_PT + 32 * MiB;
constexpr size_t WS_END = WS_HN + 64 * MiB;
static_assert(WS_LSEB + 1 * MiB <= WS_END, "ws map");
static_assert((size_t)MT_MAX * 256 * FF * 2 <= 374 * MiB && (size_t)MT_MAX * 256 * DM * 2 <= 136 * MiB, "ws map");
constexpr int CW_TMO = 0, CW_CODE = 1;
constexpr int CW_CNT = 64;
constexpr int CW_BAR = 4096;

constexpr int RING_OFF = 0, RING_BYTES = 131072;
constexpr int LDSCTL_OFF = RING_BYTES, MISC_OFF = LDSCTL_OFF + 320, XLDS_OFF = RING_BYTES + 1024;
constexpr int LDS_BYTES = 147456;
static_assert(MISC_OFF + 128 <= XLDS_OFF && XLDS_OFF + 8192 <= LDS_BYTES, "LDS map");

#define GAS __attribute__((address_space(1)))
#define LAS __attribute__((address_space(3)))
typedef unsigned short bf16;
typedef unsigned v4u __attribute__((ext_vector_type(4)));
typedef unsigned v2u __attribute__((ext_vector_type(2)));
typedef float f32x4 __attribute__((ext_vector_type(4)));
typedef GAS unsigned gu32;
#define RLX_AGENT __ATOMIC_RELAXED, __HIP_MEMORY_SCOPE_AGENT
#define LDS_WAIT() asm volatile("s_waitcnt lgkmcnt(0)" ::: "memory")
#define VM_WAIT() asm volatile("s_waitcnt vmcnt(0)" ::: "memory")
__device__ __forceinline__ unsigned f2bf(float f) { unsigned u = __builtin_bit_cast(unsigned, f); return (u + 0x7fffu + ((u >> 16) & 1u)) >> 16; }
__device__ __forceinline__ unsigned pk2(float lo, float hi) { return f2bf(lo) | (f2bf(hi) << 16); }
__device__ __forceinline__ float bflo(unsigned w) { return __builtin_bit_cast(float, w << 16); }
__device__ __forceinline__ float bfhi(unsigned w) { return __builtin_bit_cast(float, w & 0xffff0000u); }

#define XB_TMO      128
#define XB_XCNT(j)  (256  + 64 * (j))
#define XB_XSUB(j)  (1280 + 64 * (j))
#define XB_XGEN(j)  (2304 + 64 * (j))
#define XB_TOP      3328
#define XB_TOPGEN   3392
#define XCD_BAR_WORDS 3456
#define XB_SPIN_CAP (1u << 20)
static_assert((size_t)(CW_BAR + XCD_BAR_WORDS) * 4 <= CTL_ZERO_BYTES && (size_t)(CW_CNT + 8 * 32) * 4 <= (size_t)CW_BAR * 4, "control words inside the zeroed region");

__device__ __forceinline__ unsigned xb_ld(gu32* p)              { return __hip_atomic_load(p, __ATOMIC_RELAXED, __HIP_MEMORY_SCOPE_AGENT); }
__device__ __forceinline__ unsigned xb_add(gu32* p, unsigned v) { return __hip_atomic_fetch_add(p, v, __ATOMIC_RELAXED, __HIP_MEMORY_SCOPE_AGENT); }
__device__ __forceinline__ unsigned xb_xcc_id() { return (unsigned)__builtin_amdgcn_s_getreg((3 << 11) | 20) & 0xFu; }
#define XB_SPIN(cond, bar) do { unsigned _sp = 0; while (cond) { __builtin_amdgcn_s_sleep(1); \
    if ((++_sp & 255u) == 0u) { if (xb_ld(&(bar)[XB_TMO])) break; if (_sp > XB_SPIN_CAP) { xb_add(&(bar)[XB_TMO], 1u); break; } } } } while (0)

struct XcdBarrier {
    gu32* bar; unsigned x;
    volatile LAS unsigned* st;
};
__device__ __forceinline__ XcdBarrier xcd_barrier_post(gu32* bar, volatile LAS unsigned* st) {
    XcdBarrier b; b.bar = bar; b.x = xb_xcc_id(); b.st = st;
    if (threadIdx.x == 0) (void)xb_add(&bar[XB_XCNT(b.x)], 1u);
    return b;
}
__device__ __forceinline__ void xcd_barrier_complete(gu32* bar, unsigned x, unsigned& nloc, unsigned& nx) {
    const unsigned G = gridDim.x * gridDim.y * gridDim.z;
    unsigned sum, cnt, mine, sp = 0u;
    for (;;) {
        sum = 0u; cnt = 0u; mine = 0u;
#pragma unroll
        for (unsigned j = 0; j < 16; ++j) { const unsigned c = xb_ld(&bar[XB_XCNT(j)]); sum += c; cnt += (c > 0u) ? 1u : 0u; mine = (j == x) ? c : mine; }
        if (sum == G) break;
        __builtin_amdgcn_s_sleep(1);
        if ((++sp & 255u) == 0u) { if (xb_ld(&bar[XB_TMO])) break; if (sp > XB_SPIN_CAP) { xb_add(&bar[XB_TMO], 1u); break; } }
    }
    nloc = mine > 0u ? mine : 1u; nx = cnt > 0u ? cnt : 1u;
}
__device__ __forceinline__ void xcd_barrier(const XcdBarrier& b) {
    asm volatile("s_waitcnt vmcnt(0)" ::: "memory");
    __syncthreads();
    if (threadIdx.x == 0) {
        gu32* bar = b.bar;
        __builtin_amdgcn_s_waitcnt(0);
        unsigned nloc = b.st[0], nx = b.st[1];
        if (nloc == 0u) { xcd_barrier_complete(bar, b.x, nloc, nx); b.st[0] = nloc; b.st[1] = nx; }
        const unsigned old = xb_add(&bar[XB_XSUB(b.x)], 1u);
        const unsigned gen = old / nloc;
        if (old + 1u == (gen + 1u) * nloc) {
            __builtin_amdgcn_fence(__ATOMIC_RELEASE, "agent");
            asm volatile("s_waitcnt vmcnt(0)" ::: "memory");
            const unsigned og = xb_add(&bar[XB_TOP], 1u);
            const unsigned tg = og / nx;
            if (og + 1u == (tg + 1u) * nx) xb_add(&bar[XB_TOPGEN], 1u);
            else XB_SPIN(xb_ld(&bar[XB_TOPGEN]) == tg, bar);
            __builtin_amdgcn_fence(__ATOMIC_ACQUIRE, "agent");
            xb_add(&bar[XB_XGEN(b.x)], 1u);
            asm volatile("s_waitcnt vmcnt(0)" ::: "memory");
        } else {
            XB_SPIN(xb_ld(&bar[XB_XGEN(b.x)]) == gen, bar);
            __builtin_amdgcn_fence(__ATOMIC_ACQUIRE, "agent");
            asm volatile("s_waitcnt vmcnt(0)" ::: "memory");
        }
    }
    __syncthreads();
}

struct Args { const void* in[22]; float* out; unsigned char* ws; int ph_lo, ph_hi, use_bar, pad; };
struct ArgsD { const GAS void* in[22]; GAS float* out; GAS unsigned char* ws; int ph_lo, ph_hi, use_bar, pad; };
static_assert(sizeof(ArgsD) == sizeof(Args), "ArgsD");
typedef const __attribute__((address_space(4))) ArgsD* KArgs;
__device__ __forceinline__ KArgs kargs() { KArgs p = (KArgs)__builtin_amdgcn_kernarg_segment_ptr(); asm volatile("" : "+s"(p)); return p; }
struct Frame {
    LAS unsigned char* lds;
    int vcu, G, wave;
};
#define PH_IDX() int lane_; asm volatile("v_mbcnt_lo_u32_b32 %0, -1, 0\n\tv_mbcnt_hi_u32_b32 %0, -1, %0" : "=v"(lane_)); const int lane = lane_, wave = F.wave, tid = wave * 64 + lane; (void)tid; (void)lane; (void)wave
__device__ __forceinline__ float shx(float v, int lane, int o) { return __builtin_bit_cast(float, __builtin_amdgcn_ds_bpermute((lane ^ o) << 2, __builtin_bit_cast(int, v))); }
__device__ __forceinline__ float wave_sum(float v, int lane) {
#pragma unroll
    for (int o = 1; o < 64; o <<= 1) v += shx(v, lane, o);
    return v;
}

template <bool GAIN>
__device__ __forceinline__ void xpose_item(const float* W, int K, int N, bf16* WT, int k0, int n0, int drow0, LAS float* scr, int lane, const float* gk) {
    float gl = 1.0f, gh = 1.0f; if constexpr (GAIN) { gl = gk[k0 + (lane & 31)]; gh = gk[k0 + 32 + (lane & 31)]; }
    float w[32];
    const GAS float* src = (const GAS float*)W + (size_t)(k0 + (lane >> 5)) * N + n0 + (lane & 31);
#pragma unroll
    for (int i = 0; i < 32; ++i) w[i] = __builtin_nontemporal_load(src + (size_t)(2 * i) * N);
#pragma unroll
    for (int i = 0; i < 32; ++i) { const int kk = 2 * i + (lane >> 5); float v = w[i];
        if constexpr (GAIN) { const float gsel = (i >= 16) ? gh : gl; v *= __builtin_bit_cast(float, __builtin_amdgcn_ds_bpermute((kk & 31) << 2, __builtin_bit_cast(int, gsel))); }
        scr[kk * 33 + (lane & 31)] = v; }
    LDS_WAIT(); asm volatile("" ::: "memory");
    const int c = lane & 7;
#pragma unroll
    for (int j = 0; j < 4; ++j) { const int n = (lane >> 3) + 8 * j; const LAS float* s = scr + (8 * c) * 33 + n;
        v4u o; o.x = pk2(s[0 * 33], s[1 * 33]); o.y = pk2(s[2 * 33], s[3 * 33]); o.z = pk2(s[4 * 33], s[5 * 33]); o.w = pk2(s[6 * 33], s[7 * 33]);
        __builtin_nontemporal_store(o, (GAS v4u*)(WT + (size_t)(drow0 + n) * K + k0 + 8 * c)); }
    LDS_WAIT(); asm volatile("" ::: "memory");
}
constexpr int IT_WIN1 = 32 * 122, IT_WQB1 = 8 * 48, IT_WKVB1 = 4 * 64, IT_WOUT1 = 32 * 64, IT_GU1 = 32 * 176, IT_D1 = 88 * 64;
constexpr int IT_EARLY = IT_WIN1 + IT_WQB1 + IT_WKVB1;
constexpr int IT_LATE = IT_WIN1 + IT_WQB1 + IT_WKVB1 + 2 * IT_WOUT1 + 2 * IT_GU1 + IT_D1 + 16 * IT_GU1 + 8 * IT_D1, IT_TOTAL = IT_EARLY + IT_LATE;
static_assert(IT_LATE % 2 == 0, "late items split in two halves");
__device__ __forceinline__ void conv_item(KArgs a, int it, LAS float* scr, int lane) {
    unsigned char* ws = (unsigned char*)a->ws;
    const float* W; bf16* WT; int K, N, kb, nb, drow0; const float* gk = nullptr;
    int l = 0; if (it >= IT_EARLY) { it -= IT_EARLY; l = 1; }
    if (it < IT_WIN1) { const int r = it; kb = r / 122; nb = r % 122; K = DM; N = INC; W = (const float*)a->in[4] + (size_t)l * DM * INC; WT = (bf16*)(ws + WS_WIN) + (size_t)l * INP * DM; drow0 = 32 * nb; gk = (const float*)a->in[3] + l * DM; }
    else if ((it -= IT_WIN1) < IT_WQB1) { const int r = it; kb = r / 48; nb = r % 48; K = QLORA; N = NQB_; W = (const float*)a->in[7] + (size_t)l * QLORA * NQB_; WT = (bf16*)(ws + WS_WQB) + (size_t)l * NQB_ * QLORA; drow0 = 32 * nb; gk = (const float*)a->in[5] + l * QLORA; }
    else if ((it -= IT_WQB1) < IT_WKVB1) { const int r = it; kb = r / 64; nb = r % 64; K = KVLORA; N = NKVB; W = (const float*)a->in[8] + (size_t)l * KVLORA * NKVB; WT = (bf16*)(ws + WS_WKVB) + (size_t)l * NKVB * KVLORA; drow0 = 32 * nb; }
    else if ((it -= IT_WKVB1) < 2 * IT_WOUT1) { const int lo = it / IT_WOUT1, r = it % IT_WOUT1; kb = r / 64; nb = r % 64; K = DM; N = DM; W = (const float*)a->in[13] + (size_t)lo * DM * DM; WT = (bf16*)(ws + WS_WOUT) + (size_t)lo * DM * DM; drow0 = 32 * nb; }
    else if ((it -= 2 * IT_WOUT1) < 2 * IT_GU1) { const int isup = it / IT_GU1, r = it % IT_GU1; kb = r / 176; nb = r % 176; K = DM; N = FF;
        W = isup ? (const float*)a->in[16] : (const float*)a->in[15]; WT = (bf16*)(ws + WS_WGU);
        const int n0 = 32 * nb; drow0 = 256 * (n0 >> 7) + (n0 & 127) + (isup ? 128 : 0); gk = (const float*)a->in[14]; }
    else if ((it -= 2 * IT_GU1) < IT_D1) { const int r = it; kb = r / 64; nb = r % 64; K = FF; N = DM; W = (const float*)a->in[17]; WT = (bf16*)(ws + WS_WD); drow0 = 32 * nb; }
    else if ((it -= IT_D1) < 16 * IT_GU1) { const int m = it / IT_GU1, r = it % IT_GU1; kb = r / 176; nb = r % 176; const int isup = m >> 3, e = m & 7; K = DM; N = FF;
        W = (isup ? (const float*)a->in[20] : (const float*)a->in[19]) + (size_t)e * DM * FF; WT = (bf16*)(ws + WS_WGUE) + (size_t)e * NGU * DM;
        const int n0 = 32 * nb; drow0 = 256 * (n0 >> 7) + (n0 & 127) + (isup ? 128 : 0); }
    else { it -= 16 * IT_GU1; const int e = it / IT_D1, r = it % IT_D1; kb = r / 64; nb = r % 64; K = FF; N = DM;
        W = (const float*)a->in[21] + (size_t)e * FF * DM; WT = (bf16*)(ws + WS_WDE) + (size_t)e * DM * FF; drow0 = 32 * nb; }
    if (gk) xpose_item<true>(W, K, N, WT, 64 * kb, 32 * nb, drow0, scr, lane, gk); else xpose_item<false>(W, K, N, WT, 64 * kb, 32 * nb, drow0, scr, lane, gk);
}
__device__ __forceinline__ void late_convert(Frame& F, KArgs a, int part) {
    PH_IDX();
    LAS float* scr = (LAS float*)(F.lds + RING_OFF + wave * 16384);
    const int bx = (int)blockIdx.x, cgw = ((bx >> 3) * 4 + (bx & 3)) * NWAVES + wave, CNGW = (F.G / 2) * NWAVES;
    for (int it = IT_EARLY + part * (IT_LATE / 2) + cgw; it < IT_EARLY + (part + 1) * (IT_LATE / 2); it += CNGW) conv_item(a, it, scr, lane);
}
__device__ __forceinline__ void p0_prologue(Frame& F, KArgs a) {
    PH_IDX();
    unsigned char* ws = (unsigned char*)a->ws;
    LAS float* scr = (LAS float*)(F.lds + RING_OFF + wave * 16384);
    const int gw = F.vcu * NWAVES + wave, NGW = F.G * NWAVES;
    const int it_end = (F.G % 8 == 0) ? IT_EARLY : IT_TOTAL;
    for (int it0 = gw; it0 < it_end; it0 += NGW) conv_item(a, it0, scr, lane);
    for (int r = gw; r < 2 * (INP - INC); r += NGW) { const int l = r / (INP - INC), rr = INC + r % (INP - INC);
        GAS v4u* p = (GAS v4u*)((bf16*)(ws + WS_WIN) + ((size_t)l * INP + rr) * DM) + lane;
#pragma unroll
        for (int j = 0; j < 4; ++j) p[64 * j] = (v4u){0u, 0u, 0u, 0u}; }
    { const float* x = (const float*)a->in[0]; bf16* H = (bf16*)(ws + WS_H); float* ssq0 = (float*)(ws + WS_SSQ0);
      for (int m = gw; m < S_; m += NGW) { const GAS f32x4* xr = (const GAS f32x4*)(x + (size_t)m * DM) + lane; GAS v2u* o8 = (GAS v2u*)(H + (size_t)m * DM) + lane; float ss = 0.f;
          f32x4 v[8];
#pragma unroll
          for (int j = 0; j < 8; ++j) v[j] = __builtin_nontemporal_load(xr + 64 * j);
#pragma unroll
          for (int j = 0; j < 8; ++j) { ss += (v[j].x * v[j].x + v[j].y * v[j].y) + (v[j].z * v[j].z + v[j].w * v[j].w); o8[64 * j] = (v2u){pk2(v[j].x, v[j].y), pk2(v[j].z, v[j].w)}; }
          ss = wave_sum(ss, lane); if (lane == 0) ssq0[m] = ss; } }
    { const float* rb = (const float*)a->in[2]; float* tbl = (float*)(ws + WS_TBL);
      for (int i = gw * 64 + lane; i < 2 * NH * att::TBL_N; i += NGW * 64) {
          const int pass = i / (NH * att::TBL_N), ii = i % (NH * att::TBL_N), h = ii / att::TBL_N, u = ii % att::TBL_N, st = att::TBL_U0 - u; float v = -__builtin_inff();
          int dl = -1, mu = 0;
          if (pass == 0) { if (st >= 0 && st <= 512) { dl = st; mu = (dl <= 128 ? 1 : 0) + (((dl & 3) == 0) ? 1 : 0) + (((dl & 15) == 0) ? 1 : 0); } }
          else { if (st >= 33 && st <= 128) { dl = 16 * st; mu = 1; } }
          if (mu > 0) { int bk; if (dl < 16) bk = dl; else { bk = 16 + (int)(logf((float)dl * 0.0625f) / 4.852030263919617f * 16.0f); if (bk > 31) bk = 31; }
              v = (rb[bk * NH + h] + logf((float)mu)) * 11.313708498984761f; }
          tbl[i] = v; } }
}

template <bool ROUTE, bool XB = false>
__device__ __forceinline__ void norm_rows(Frame& F, const float* x, const float* g, bf16* H, KArgs a, bool dry = false) {
    PH_IDX();
    const int gw = F.vcu * NWAVES + wave, NGW = F.G * NWAVES;
    LAS float* wr_l = (LAS float*)(F.lds + RING_OFF);
    if constexpr (ROUTE) {
        const float* wrt = (const float*)a->in[18];
        for (int i0 = tid; i0 < DM * NEXP; i0 += 8 * NWAVES * 64) { float t[8];
#pragma unroll
            for (int q = 0; q < 8; ++q) t[q] = wrt[i0 + q * NWAVES * 64];
#pragma unroll
            for (int q = 0; q < 8; ++q) { const int i = i0 + q * NWAVES * 64, k = i >> 3, e = i & 7; wr_l[e * DM + k] = t[q]; } }
        LDS_WAIT(); __syncthreads();
    }
    f32x4 gv[8];
#pragma unroll
    for (int j = 0; j < 8; ++j) gv[j] = ((const GAS f32x4*)g)[lane + 64 * j];
    LAS unsigned* lcnt = (LAS unsigned*)(F.lds + RING_OFF + 65536); LAS unsigned* lbase = lcnt + 8; LAS int* rec = (LAS int*)(F.lds + RING_OFF + 65536 + 256);
    const int NIT = (S_ + NGW - 1) / NGW;
    for (int c0 = 0; c0 < NIT; c0 += 8) {
        const int c1 = c0 + 8 < NIT ? c0 + 8 : NIT;
        if constexpr (ROUTE) { if (tid < 8) lcnt[tid] = 0u; LDS_WAIT(); __syncthreads(); }
        v2u raw[8];
        for (int ci = c0; ci < c1; ++ci) {
            const int m = gw + ci * NGW;
            if (m >= S_) { if constexpr (ROUTE) { if (lane == 0) rec[(wave * 8 + (ci - c0)) * 8] = -1; } continue; }
            f32x4 v[8]; float ss = 0.f;
            if constexpr (XB) {
                if (ci == c0) { const GAS v2u* xr = (const GAS v2u*)((const bf16*)x + (size_t)m * DM) + lane;
#pragma unroll
                    for (int j = 0; j < 8; ++j) raw[j] = xr[64 * j]; }
#pragma unroll
                for (int j = 0; j < 8; ++j) { const v2u w = raw[j]; v[j] = (f32x4){bflo(w.x), bfhi(w.x), bflo(w.y), bfhi(w.y)}; }
            } else { const GAS f32x4* xr = (const GAS f32x4*)(x + (size_t)m * DM) + lane;
#pragma unroll
                for (int j = 0; j < 8; ++j) v[j] = xr[64 * j]; }
#pragma unroll
            for (int j = 0; j < 8; ++j) ss += (v[j].x * v[j].x + v[j].y * v[j].y) + (v[j].z * v[j].z + v[j].w * v[j].w);
            const float rstd = 1.0f / sqrtf(wave_sum(ss, lane) * (1.0f / DM) + EPS);
#pragma unroll
            for (int j = 0; j < 8; ++j) v[j] = v[j] * rstd * gv[j];
            GAS v2u* o8 = (GAS v2u*)(H + (size_t)m * DM) + lane;
#pragma unroll
            for (int j = 0; j < 8; ++j) o8[64 * j] = (v2u){pk2(v[j].x, v[j].y), pk2(v[j].z, v[j].w)};
            if constexpr (XB) { const int mn = m + NGW; if (ci + 1 < c1 && mn < S_) { const GAS v2u* xn = (const GAS v2u*)((const bf16*)x + (size_t)mn * DM) + lane;
#pragma unroll
                for (int j = 0; j < 8; ++j) raw[j] = xn[64 * j]; } }
            if constexpr (ROUTE) {
                float sd[8];
#pragma unroll
                for (int e = 0; e < 8; ++e) { float t = 0.f;
#pragma unroll
                    for (int j = 0; j < 8; ++j) { const f32x4 w = *(const LAS f32x4*)(wr_l + e * DM + 4 * (lane + 64 * j)); t += (v[j].x * w.x + v[j].y * w.y) + (v[j].z * w.z + v[j].w * w.w); }
                    sd[e] = t; }
                float ra[4], rb[2], rc;
#pragma unroll
                for (int i = 0; i < 4; ++i) { const bool up = (lane & 1) != 0; ra[i] = (up ? sd[4 + i] : sd[i]) + shx(up ? sd[i] : sd[4 + i], lane, 1); }
#pragma unroll
                for (int i = 0; i < 2; ++i) { const bool up = (lane & 2) != 0; rb[i] = (up ? ra[2 + i] : ra[i]) + shx(up ? ra[i] : ra[2 + i], lane, 2); }
                { const bool up = (lane & 4) != 0; rc = (up ? rb[1] : rb[0]) + shx(up ? rb[0] : rb[1], lane, 4); }
                rc += shx(rc, lane, 8); rc += shx(rc, lane, 16); rc += shx(rc, lane, 32);
                float v0 = -__builtin_inff(), v1 = -__builtin_inff(); int e0 = 0, e1 = 0;
#pragma unroll
                for (int e = 0; e < 8; ++e) { constexpr int BR[8] = {0, 4, 2, 6, 1, 5, 3, 7};
                    const float sv = __builtin_bit_cast(float, __builtin_amdgcn_readlane(__builtin_bit_cast(int, rc), BR[e]));
                    if (sv > v0) { v1 = v0; e1 = e0; v0 = sv; e0 = e; } else if (sv > v1) { v1 = sv; e1 = e; } }
                const float g0 = 1.0f / (1.0f + expf(v1 - v0)), g1 = 1.0f - g0;
                if (lane == 0) {
                    const unsigned o0 = __hip_atomic_fetch_add(lcnt + e0, 1u, __ATOMIC_RELAXED, __HIP_MEMORY_SCOPE_WORKGROUP), o1 = __hip_atomic_fetch_add(lcnt + e1, 1u, __ATOMIC_RELAXED, __HIP_MEMORY_SCOPE_WORKGROUP);
                    LAS int* r = rec + (wave * 8 + (ci - c0)) * 8;
                    r[0] = m; r[1] = e0; r[2] = e1; r[3] = __builtin_bit_cast(int, g0); r[4] = __builtin_bit_cast(int, g1); r[5] = (int)o0; r[6] = (int)o1; }
            }
        }
        if constexpr (ROUTE) {
            LDS_WAIT(); __syncthreads();
            if (tid < 8) { const unsigned c = lcnt[tid]; unsigned b = 0u; if (c && !dry) b = xb_add((gu32*)(a->ws + WS_CTL) + CW_CNT + tid * pg8::CNT_STRIDE, c); lbase[tid] = b; }
            LDS_WAIT(); __syncthreads();
            if (lane < c1 - c0 && !dry) { const LAS int* r = rec + (wave * 8 + lane) * 8; const int m = r[0];
                if (m >= 0) { const int e0 = r[1], e1 = r[2]; const int s0 = (int)lbase[e0] + r[5], s1 = (int)lbase[e1] + r[6];
                    int* ltok = (int*)(a->ws + WS_LTOK); float* lgate = (float*)(a->ws + WS_LGATE);
                    ltok[(size_t)e0 * S_ + s0] = m; lgate[(size_t)e0 * S_ + s0] = __builtin_bit_cast(float, r[3]);
                    ltok[(size_t)e1 * S_ + s1] = m; lgate[(size_t)e1 * S_ + s1] = __builtin_bit_cast(float, r[4]);
                    ((int4*)(a->ws + WS_POS))[m] = make_int4(e0, s0, e1, s1); } }
        }
    }
}

__device__ __forceinline__ void unpack8(const v4u w, float (&f)[8]) { f[0] = bflo(w.x); f[1] = bfhi(w.x); f[2] = bflo(w.y); f[3] = bfhi(w.y); f[4] = bflo(w.z); f[5] = bfhi(w.z); f[6] = bflo(w.w); f[7] = bfhi(w.w); }
__device__ __forceinline__ v4u pack8s(const float (&f)[8], float s, const float (&g)[8]) {
    v4u o; o.x = pk2(f[0] * s * g[0], f[1] * s * g[1]); o.y = pk2(f[2] * s * g[2], f[3] * s * g[3]); o.z = pk2(f[4] * s * g[4], f[5] * s * g[5]); o.w = pk2(f[6] * s * g[6], f[7] * s * g[7]); return o; }
__device__ __forceinline__ float ssq8(const float (&f)[8]) { return ((f[0] * f[0] + f[1] * f[1]) + (f[2] * f[2] + f[3] * f[3])) + ((f[4] * f[4] + f[5] * f[5]) + (f[6] * f[6] + f[7] * f[7])); }
__device__ __forceinline__ void prep2(Frame& F, KArgs a, int l, bool dry = false) {
    PH_IDX();
    const int gw = F.vcu * NWAVES + wave, NGW = F.G * NWAVES, h = lane >> 3, sub = lane & 7;
    bf16* PROJ = (bf16*)(a->ws + WS_PROJ); bf16* QM = (bf16*)(a->ws + WS_QM); bf16* KVM = (bf16*)(a->ws + WS_KVM); bf16* KM = (bf16*)(a->ws + WS_KM);
    const int* pos = (const int*)a->in[1];
    const float* gq = (const float*)a->in[11] + l * QKB; const float* gk = (const float*)a->in[12] + l * QKB;
    float g_q[3][8], g_k[3][8], inv[8];
#pragma unroll
    for (int i = 0; i < 3; ++i)
#pragma unroll
        for (int j = 0; j < 8; ++j) { g_q[i][j] = gq[64 * i + 8 * sub + j]; g_k[i][j] = gk[64 * i + 8 * sub + j]; }
#pragma unroll
    for (int j = 0; j < 8; ++j) inv[j] = powf(10000.0f, -(float)((sub & 3) * 8 + j) * (1.0f / 32.0f));
    for (int m = gw; m < S_; m += NGW) {
        const float p = (float)pos[m];
        float cs[8], sn[8];
#pragma unroll
        for (int j = 0; j < 8; ++j) { const float ang = p * inv[j]; sincosf(ang, &sn[j], &cs[j]); }
        const GAS v4u* qrow = (const GAS v4u*)(QM + (size_t)m * NQB_ + h * QKB);
        const GAS v4u* krow = (const GAS v4u*)(KVM + (size_t)m * NKVB + h * 256);
        const GAS v4u* rrow = (const GAS v4u*)(PROJ + (size_t)m * INP + C_KR);
        float fq[3][8], fk[3][8];
#pragma unroll
        for (int i = 0; i < 3; ++i) unpack8(qrow[sub + 8 * i], fq[i]);
        unpack8(krow[sub], fk[0]); unpack8(krow[8 + sub], fk[1]); unpack8(rrow[sub], fk[2]);
        float sq = ssq8(fq[0]) + ssq8(fq[1]) + ssq8(fq[2]), sk = ssq8(fk[0]) + ssq8(fk[1]) + ssq8(fk[2]);
#pragma unroll
        for (int o = 1; o < 8; o <<= 1) { sq += shx(sq, lane, o); sk += shx(sk, lane, o); }
        const float rq = 1.0f / sqrtf(sq * (1.0f / QKB) + EPS), rk = 1.0f / sqrtf(sk * (1.0f / QKB) + EPS);
        float nq[8], nk[8];
#pragma unroll
        for (int j = 0; j < 8; ++j) { nq[j] = fq[2][j] * rq * g_q[2][j]; nk[j] = fk[2][j] * rk * g_k[2][j]; }
        float oq[8], ok[8];
#pragma unroll
        for (int j = 0; j < 8; ++j) { const float pq = shx(nq[j], lane, 4), pk = shx(nk[j], lane, 4);
            oq[j] = (sub < 4) ? (nq[j] * cs[j] - pq * sn[j]) : (pq * sn[j] + nq[j] * cs[j]);
            ok[j] = (sub < 4) ? (nk[j] * cs[j] - pk * sn[j]) : (pk * sn[j] + nk[j] * cs[j]); }
        const float one[8] = {1.f, 1.f, 1.f, 1.f, 1.f, 1.f, 1.f, 1.f};
        const size_t dofs = dry ? (size_t)(400 * MiB) / 2 : 0; GAS v4u* qo = (GAS v4u*)(QM + dofs + (size_t)m * NQB_ + h * QKB); GAS v4u* ko = (GAS v4u*)(KM + dofs + (size_t)m * NQB_ + h * QKB);
        qo[sub] = pack8s(fq[0], rq, g_q[0]); qo[8 + sub] = pack8s(fq[1], rq, g_q[1]); qo[16 + sub] = pack8s(oq, 1.0f, one);
        ko[sub] = pack8s(fk[0], rk, g_k[0]); ko[8 + sub] = pack8s(fk[1], rk, g_k[1]); ko[16 + sub] = pack8s(ok, 1.0f, one);
    }
}
__device__ __forceinline__ void att_merge(Frame& F, KArgs a) {
    PH_IDX();
    const int gw = F.vcu * NWAVES + wave, NGW = F.G * NWAVES;
    const bf16* OA = (const bf16*)(a->ws + WS_OA); const bf16* OB = (const bf16*)(a->ws + WS_OB); const float* LA = (const float*)(a->ws + WS_LSEA); const float* LB = (const float*)(a->ws + WS_LSEB);
    bf16* ATT = (bf16*)(a->ws + WS_ATT);
    for (int m = gw; m < S_; m += NGW) {
        const GAS v4u* pa = (const GAS v4u*)(OA + (size_t)m * WA) + 2 * lane; const GAS v4u* pb = (const GAS v4u*)(OB + (size_t)m * WA) + 2 * lane;
        const float la = LA[(size_t)m * NH + (lane >> 3)], lb = LB[(size_t)m * NH + (lane >> 3)];
        const v4u qa[2] = {pa[0], pa[1]}, qb[2] = {pb[0], pb[1]};
        const float wb = 1.0f / (1.0f + expf(la - lb)), wa = 1.0f - wb;
        GAS v4u* po = (GAS v4u*)(ATT + (size_t)m * DM) + 2 * lane;
#pragma unroll
        for (int j = 0; j < 2; ++j) { float fa[8], fb[8]; unpack8(qa[j], fa); unpack8(qb[j], fb);
            v4u o; o.x = pk2(wa * fa[0] + wb * fb[0], wa * fa[1] + wb * fb[1]); o.y = pk2(wa * fa[2] + wb * fb[2], wa * fa[3] + wb * fb[3]);
            o.z = pk2(wa * fa[4] + wb * fb[4], wa * fa[5] + wb * fb[5]); o.w = pk2(wa * fa[6] + wb * fb[6], wa * fa[7] + wb * fb[7]); po[j] = o; }
    }
}
__device__ __forceinline__ void moe_tail_reduce(Frame& F, KArgs a, int T, int pm, int pnl) {
    PH_IDX();
    const int bx = (int)blockIdx.x; if (bx >= 4 * T) return;
    const int tu = bx >> 2, q = bx & 3;
    const bf16* P = (const bf16*)(a->ws + WS_PT) + (size_t)tu * 4 * 65536; bf16* Y = (bf16*)(a->ws + WS_Y);
    for (int rr = wave; rr < 64; rr += NWAVES) { const int r = 64 * q + rr;
        float s0 = 0.f, s1 = 0.f, s2 = 0.f, s3 = 0.f;
#pragma unroll
        for (int k = 0; k < 4; ++k) { const v2u w = *((const GAS v2u*)(P + (size_t)k * 65536 + (size_t)r * 256) + lane); s0 += bflo(w.x); s1 += bfhi(w.x); s2 += bflo(w.y); s3 += bfhi(w.y); }
        *((GAS v2u*)(Y + (size_t)(pm * 256 + r) * DM + pnl * 256) + lane) = (v2u){pk2(s0, s1), pk2(s2, s3)}; }
}
__device__ __forceinline__ void moe_tiles(KArgs a, int (&tb)[9]) {
    gu32* cnt = (gu32*)(a->ws + WS_CTL) + CW_CNT; int acc = 0;
    int lane_; asm volatile("v_mbcnt_lo_u32_b32 %0, -1, 0\n\tv_mbcnt_hi_u32_b32 %0, -1, %0" : "=v"(lane_));
    const int cv = (int)__hip_atomic_load(cnt + (lane_ & 7) * pg8::CNT_STRIDE, RLX_AGENT);
#pragma unroll
    for (int e = 0; e < 8; ++e) { tb[e] = acc; acc += (__builtin_amdgcn_readlane(cv, e) + 255) >> 8; }
    tb[8] = acc;
}
__device__ __forceinline__ void moe_combine(Frame& F, KArgs a, bool dry = false) {
    PH_IDX();
    const int gw = F.vcu * NWAVES + wave, NGW = F.G * NWAVES;
    int tb[9]; moe_tiles(a, tb);
    const bf16* Y = (const bf16*)(a->ws + WS_Y); const bf16* X3 = (const bf16*)(a->ws + WS_H); float* out = (float*)a->out; float* outw = dry ? (float*)(a->ws + WS_PROJ) : out;
    typedef int v4i __attribute__((ext_vector_type(4)));
    const GAS v4i* posr = (const GAS v4i*)(a->ws + WS_POS);
    v4i ps = posr[gw < S_ ? gw : 0];
    for (int m = gw; m < S_; m += NGW) {
        int b0 = 0, b1 = 0;
#pragma unroll
        for (int e = 0; e < 8; ++e) { b0 = (ps.x == e) ? tb[e] : b0; b1 = (ps.z == e) ? tb[e] : b1; }
        const GAS v2u* y0 = (const GAS v2u*)(Y + (size_t)(b0 * 256 + ps.y) * DM) + lane; const GAS v2u* y1 = (const GAS v2u*)(Y + (size_t)(b1 * 256 + ps.w) * DM) + lane;
        const GAS v2u* xr = (const GAS v2u*)(X3 + (size_t)m * DM) + lane; GAS f32x4* xw = (GAS f32x4*)(outw + (size_t)m * DM) + lane;
        v2u w0[8], w1[8], wx[8];
#pragma unroll
        for (int j = 0; j < 8; ++j) { w0[j] = y0[64 * j]; w1[j] = y1[64 * j]; wx[j] = xr[64 * j]; }
        { const int mn = m + NGW; ps = posr[mn < S_ ? mn : m]; }
#pragma unroll
        for (int j = 0; j < 8; ++j) { f32x4 v;
            v.x = bflo(wx[j].x) + (bflo(w0[j].x) + bflo(w1[j].x)); v.y = bfhi(wx[j].x) + (bfhi(w0[j].x) + bfhi(w1[j].x)); v.z = bflo(wx[j].y) + (bflo(w0[j].y) + bflo(w1[j].y)); v.w = bfhi(wx[j].y) + (bfhi(w0[j].y) + bfhi(w1[j].y));
            __builtin_nontemporal_store(v, xw + 64 * j); }
    }
}
#ifndef MK_PER_PHASE
#define MK_PER_PHASE 0
#endif
#ifndef DBG_STOP
#define DBG_STOP 23
#endif
#ifndef DUP_MASK
#define DUP_MASK 0u
#endif
constexpr int NPH = 20;
#undef DBG_STOP
#define DBG_STOP NPH

using CfgM = att::Cfg<192, NQB_, NQB_, NKVB, DM, false>;
using CfgA = att::Cfg<128, INP, INP, INP, WA, true, NH, 0>;
using CfgB = att::Cfg<128, 16 * INP, 16 * INP, 16 * INP, 16 * WA, true, 16 * NH, 33>;
constexpr int W_DILA = 513, W_DILB = 129;

__global__ void __launch_bounds__(NWAVES * 64, 2) mega_fwd(Args a_byval) {
    extern __shared__ __attribute__((aligned(16))) unsigned char lds[];
#ifdef PAD_NOPS
    asm volatile(".rept " PAD_NOPS "\n\ts_nop 0\n\t.endr");
#endif
    Frame F;
    F.lds = (LAS unsigned char*)lds;
    F.wave = __builtin_amdgcn_readfirstlane((int)threadIdx.x >> 6); asm volatile("" : "+s"(F.wave));
    F.G = gridDim.x; { const int bx = blockIdx.x; F.vcu = (F.G % 8 == 0) ? (bx % 8) * (F.G / 8) + bx / 8 : bx; }
    const int lo = a_byval.ph_lo, hi = a_byval.ph_hi, use_bar = a_byval.use_bar;
    GAS unsigned char* const ws0 = kargs()->ws;
    volatile LAS unsigned* MISC = (volatile LAS unsigned*)(F.lds + MISC_OFF);
    for (int u = threadIdx.x; u < (LDS_BYTES - LDSCTL_OFF) / 4; u += NWAVES * 64) ((LAS unsigned*)(F.lds + LDSCTL_OFF))[u] = 0u;
    __syncthreads();
    XcdBarrier bar; bar.bar = (gu32*)(ws0 + WS_CTL) + CW_BAR; bar.x = 0; bar.st = nullptr;
    if (use_bar) bar = xcd_barrier_post((gu32*)(ws0 + WS_CTL) + CW_BAR, MISC + 8);
#define IN(k) (lo <= (k) && (k) < hi)
#define REPS(k) (((DUP_MASK >> (k)) & 1u) ? 2 : 1)
#ifndef DUP_BAR
#define DUP_BAR 0
#endif
#define DUP(k) for (int rp_ = 0; rp_ < REPS(k); (DUP_BAR && use_bar && rp_ == 0 && REPS(k) > 1) ? (xcd_barrier(bar), 0) : 0, ++rp_)
#ifndef INPROJ_WGM
#define INPROJ_WGM 8
#endif
#ifndef GU_WGM
#define GU_WGM 8
#endif
#ifndef OUT_WGM
#define OUT_WGM 8
#endif
#ifndef MOE_GU_WGM
#define MOE_GU_WGM 8
#endif
#ifndef DOWN_REV
#define DOWN_REV 1
#endif
#ifndef DOWN_WGM
#define DOWN_WGM 4
#endif
#ifndef PROBE_EPI
#define PROBE_EPI 0
#endif
#ifndef SEAM_REPS
#define SEAM_REPS 1
#endif
#define SEAM(k) do { if (use_bar && IN(k) && IN((k) + 1)) { for (int sr_ = 0; sr_ < SEAM_REPS; ++sr_) { XcdBarrier b_ = bar; asm volatile("" : "+s"(b_.bar)); xcd_barrier(b_); } } } while (0)
    LAS unsigned char* const ring = F.lds + RING_OFF;
    LAS float* const xlds = (LAS float*)(F.lds + XLDS_OFF);

    if (IN(0)) { DUP(0) p0_prologue(F, kargs()); SEAM(0); }

    for (int l = 0; l < NLAYER; ++l) {
        const int pb = l ? 9 : 1;
        int bx = (int)blockIdx.x, G_ = F.G; asm volatile("" : "+s"(bx), "+s"(G_));
        const KArgs a = kargs(); GAS unsigned char* ws = a->ws; asm volatile("" : "+s"(ws));
        bf16* const H = (bf16*)(ws + WS_H); bf16* const PROJ = (bf16*)(ws + WS_PROJ); bf16* const QM = (bf16*)(ws + WS_QM); bf16* const KVM = (bf16*)(ws + WS_KVM);
        bf16* const KM = (bf16*)(ws + WS_KM); bf16* const ATT = (bf16*)(ws + WS_ATT);
        bf16* const ACT = (bf16*)(ws + WS_ACT); bf16* const Y = (bf16*)(ws + WS_Y);
        float* const ssq0 = (float*)(ws + WS_SSQ0); float* const ssqx = (float*)(ws + WS_SSQX); float* const ssqc = (float*)(ws + WS_SSQC) + (size_t)l * S_ * 2;
        if (IN(pb + 0)) { DUP(pb + 0) {
            pg8::Gemm g{H, (const bf16*)(ws + WS_WIN) + (size_t)l * INP * DM, DM, DM}; pg8::TileOrder O; O.init(S_ / 256, INP / 256, G_, bx, INPROJ_WGM);
            pg8::EpiInProj E{PROJ, INP, l ? ssqx + (size_t)S_ * 8 : ssq0, l ? 8 : 1, (const float*)a->in[9] + l * HD, (const float*)a->in[10] + l * HD, (const float*)a->in[6] + l * KVLORA, ssqc, EPS};
            pg8::gemm_phase<pg8::EpiInProj, pg8::TileOrder, false>(ring, g, O, E, F.wave, xlds); }
            SEAM(pb + 0);
        }
        if (IN(pb + 1)) { DUP(pb + 1) {
            { pg8::Gemm g{PROJ + C_CQ, (const bf16*)(ws + WS_WQB) + (size_t)l * NQB_ * QLORA, QLORA, INP}; pg8::TileOrder O; O.init(S_ / 256, NQB_ / 256, G_, bx);
              pg8::EpiBf16 E{QM, NQB_, ssqc, 2, 1.0f / QLORA, EPS}; pg8::gemm_phase<pg8::EpiBf16, pg8::TileOrder, false>(ring, g, O, E, F.wave, xlds); }
            { pg8::Gemm g{PROJ + C_CKV, (const bf16*)(ws + WS_WKVB) + (size_t)l * NKVB * KVLORA, KVLORA, INP}; pg8::TileOrder O; O.init(S_ / 256, NKVB / 256, G_, bx);
              pg8::EpiBf16 E{KVM, NKVB, nullptr, 0, 0.f, 0.f}; pg8::gemm_phase<pg8::EpiBf16, pg8::TileOrder, false>(ring, g, O, E, F.wave, xlds); } }
            SEAM(pb + 1);
        }
        if (IN(pb + 2)) { if (REPS(pb + 2) > 1) prep2(F, a, l, true); prep2(F, a, l); SEAM(pb + 2); }
        if (IN(pb + 3)) { DUP(pb + 3) {
            att::lptr albs = (att::lptr)ring;
            const bool host = (l == 0) && (G_ % 8 == 0) && rp_ == 0;
            if (host && (bx & 4) == 0) { late_convert(F, a, 0); __syncthreads(); }
            if (F.wave >= 4) __builtin_amdgcn_s_setprio(1);
            {   att::Seam<CfgM> Sm;
                for (int it = bx; it < 256; it += G_) {
                    const int h = it & 7, x = it >> 3;
                    att::BlockRef b0, b1;
                    b0.P0 = (63 - x) * 256; b1.P0 = x * 256;
                    b0.K = b1.K = KM + h * QKB; b0.V = b1.V = KVM + h * 256 + 128;
                    b0.Q = QM + (size_t)b0.P0 * NQB_ + h * QKB; b1.Q = QM + (size_t)b1.P0 * NQB_ + h * QKB;
                    b0.O = ATT + (size_t)b0.P0 * DM + WA + h * HD; b1.O = ATT + (size_t)b1.P0 * DM + WA + h * HD; b0.lse = b1.lse = nullptr;
                    att::prime<CfgM>(b0, W_CAUSAL, albs, Sm, F.wave);
                    for (int pass = 0; pass < 2; ++pass) { const att::BlockRef cur = pass ? b1 : b0; att::block<CfgM>(cur, b1, S_, W_CAUSAL, albs, Sm, F.wave); }
                } }
            {   att::Seam<CfgA> Sa;
                bf16* const OA = (bf16*)(ws + WS_OA); float* const LA = (float*)(ws + WS_LSEA);
                for (int it = bx; it < 256; it += G_) {
                    const int h = it & 7, x = it >> 3;
                    { const float* tg = (const float*)(ws + WS_TBL) + h * att::TBL_N; LAS float* tl = (LAS float*)(ring + CfgA::OFF_TBL);
                      PH_IDX(); static_assert(att::TBL_N % 4 == 0 && att::TBL_N / 4 <= 2 * NWAVES * 64, "table copy"); const int i1 = tid + NWAVES * 64; const bool h1 = i1 < att::TBL_N / 4; const f32x4 t0 = ((const GAS f32x4*)tg)[tid], t1 = ((const GAS f32x4*)tg)[h1 ? i1 : tid]; ((LAS f32x4*)tl)[tid] = t0; if (h1) ((LAS f32x4*)tl)[i1] = t1; }
                    att::BlockRef b0, b1;
                    b0.P0 = x * 256; b1.P0 = (63 - x) * 256;
                    b0.K = b1.K = PROJ + C_KA + h * HD; b0.V = b1.V = PROJ + C_VA + h * HD;
                    b0.Q = PROJ + (size_t)b0.P0 * INP + C_QA + h * HD; b1.Q = PROJ + (size_t)b1.P0 * INP + C_QA + h * HD;
                    b0.O = OA + (size_t)b0.P0 * WA + h * HD; b1.O = OA + (size_t)b1.P0 * WA + h * HD;
                    b0.lse = LA + (size_t)b0.P0 * NH + h; b1.lse = LA + (size_t)b1.P0 * NH + h;
                    att::prime<CfgA>(b0, W_DILA, albs, Sa, F.wave);
                    for (int pass = 0; pass < 2; ++pass) { const att::BlockRef cur = pass ? b1 : b0; att::block<CfgA>(cur, b1, S_, W_DILA, albs, Sa, F.wave); }
                } }
            {   att::Seam<CfgB> Sb;
                bf16* const OB = (bf16*)(ws + WS_OB); float* const LB = (float*)(ws + WS_LSEB);
                for (int it = bx; it < 256; it += G_) {
                    const int h = it & 7, y = it >> 3;
                    { const float* tg = (const float*)(ws + WS_TBL) + (NH + h) * att::TBL_N; LAS float* tl = (LAS float*)(ring + CfgB::OFF_TBL);
                      PH_IDX(); static_assert(att::TBL_N % 4 == 0 && att::TBL_N / 4 <= 2 * NWAVES * 64, "table copy"); const int i1 = tid + NWAVES * 64; const bool h1 = i1 < att::TBL_N / 4; const f32x4 t0 = ((const GAS f32x4*)tg)[tid], t1 = ((const GAS f32x4*)tg)[h1 ? i1 : tid]; ((LAS f32x4*)tl)[tid] = t0; if (h1) ((LAS f32x4*)tl)[i1] = t1; }
                    att::BlockRef b0, b1;
                    const int i0 = 2 * y, i1 = 2 * y + 1, r0 = i0 >> 2, r1 = i1 >> 2;
                    b0.P0 = (i0 & 3) * 256; b1.P0 = (i1 & 3) * 256;
                    b0.K = PROJ + (size_t)r0 * INP + C_KA + h * HD; b1.K = PROJ + (size_t)r1 * INP + C_KA + h * HD;
                    b0.V = PROJ + (size_t)r0 * INP + C_VA + h * HD; b1.V = PROJ + (size_t)r1 * INP + C_VA + h * HD;
                    b0.Q = PROJ + ((size_t)b0.P0 * 16 + r0) * INP + C_QA + h * HD; b1.Q = PROJ + ((size_t)b1.P0 * 16 + r1) * INP + C_QA + h * HD;
                    b0.O = OB + ((size_t)b0.P0 * 16 + r0) * WA + h * HD; b1.O = OB + ((size_t)b1.P0 * 16 + r1) * WA + h * HD;
                    b0.lse = LB + ((size_t)b0.P0 * 16 + r0) * NH + h; b1.lse = LB + ((size_t)b1.P0 * 16 + r1) * NH + h;
                    att::prime<CfgB>(b0, W_DILB, albs, Sb, F.wave);
                    for (int pass = 0; pass < 2; ++pass) { const att::BlockRef cur = pass ? b1 : b0; att::block<CfgB>(cur, b1, S_ / 16, W_DILB, albs, Sb, F.wave); }
                } }
            __builtin_amdgcn_s_setprio(0);
            if (host && (bx & 4) != 0) { __syncthreads(); late_convert(F, a, 1); } }
            SEAM(pb + 3);
        }
        if (IN(pb + 4)) { att_merge(F, a); SEAM(pb + 4); }
        if (IN(pb + 5)) { for (int rp_ = 0; rp_ < (l == 0 ? REPS(6) : 1); ++rp_) {
            pg8::Gemm g{ATT, (const bf16*)(ws + WS_WOUT) + (size_t)l * DM * DM, DM, DM}; pg8::TileOrder O; O.init(S_ / 256, DM / 256, G_, bx, OUT_WGM);
            pg8::EpiRes E{l == 0 ? (const float*)a->in[0] : nullptr, H, nullptr, H, ssqx, DM};
            pg8::gemm_phase<pg8::EpiRes, pg8::TileOrder, false>(ring, g, O, E, F.wave, xlds); }
            SEAM(pb + 5);
        }
        if (l == 0) {
            if (IN(7)) { DUP(7) {
                pg8::Gemm g{H, (const bf16*)(ws + WS_WGU), DM, DM}; pg8::TileOrder O; O.init(S_ / 256, NT_GU, G_, bx, GU_WGM);
                pg8::EpiSwiGLU E{ACT, FF, NT_GU, ssqx, EPS, (REPS(7) > 1 && rp_ == 0) ? PROBE_EPI : 0};
                pg8::gemm_phase<pg8::EpiSwiGLU, pg8::TileOrder, false>(ring, g, O, E, F.wave, xlds); }
                SEAM(7);
            }
            if (IN(8)) { DUP(8) {
                const bool dry = REPS(8) > 1 && rp_ == 0;
                pg8::Gemm g{ACT, (const bf16*)(ws + WS_WD), FF, FF}; pg8::TileOrder O; O.init(S_ / 256, NT_D, G_, bx, DOWN_WGM);
                pg8::EpiRes E{nullptr, H, dry ? (float*)(ws + WS_END) : nullptr, dry ? nullptr : H, ssqx + (size_t)S_ * 8, DM};
                pg8::gemm_phase<pg8::EpiRes, pg8::TileOrder, false>(ring, g, O, E, F.wave, xlds); }
                SEAM(8);
            }
        } else {
            bf16* const HN = (bf16*)(ws + WS_HN);
            if (IN(15)) { if (REPS(15) > 1) norm_rows<true, true>(F, (const float*)H, (const float*)a->in[14] + l * DM, HN, a, true); norm_rows<true, true>(F, (const float*)H, (const float*)a->in[14] + l * DM, HN, a); SEAM(15); }
            if (IN(16)) { DUP(16) {
                int tb[9]; moe_tiles(a, tb);
                pg8::MoeOrder O; O.t.init(tb[8], NT_GU, G_, bx, MOE_GU_WGM); O.t1 = tb[1]; O.t2 = tb[2]; O.t3 = tb[3]; O.t4 = tb[4]; O.t5 = tb[5]; O.t6 = tb[6]; O.t7 = tb[7];
                O.nNl = NT_GU; O.list = (const int*)(ws + WS_LTOK); O.cnt = (const int*)(ws + WS_CTL) + CW_CNT; O.S_cap = S_; O.R = -1; O.T = 0; O.nkt_full = DM / 64;
                pg8::Gemm g{HN, (const bf16*)(ws + WS_WGUE), DM, DM};
                pg8::EpiSwiGLU E{ACT, FF, NT_GU, nullptr, 0.f, (REPS(16) > 1 && rp_ == 0) ? PROBE_EPI : 0};
                pg8::gemm_phase<pg8::EpiSwiGLU, pg8::MoeOrder, true>(ring, g, O, E, F.wave, xlds); }
                SEAM(16);
            }
            if (IN(17)) { DUP(17) {
                int tb[9]; moe_tiles(a, tb);
                pg8::MoeOrder O; O.t.init(tb[8], NT_D, G_, bx, DOWN_WGM); O.t.rev = DOWN_REV; O.t1 = tb[1]; O.t2 = tb[2]; O.t3 = tb[3]; O.t4 = tb[4]; O.t5 = tb[5]; O.t6 = tb[6]; O.t7 = tb[7];
                O.nNl = NT_D; O.list = (const int*)(ws + WS_LTOK); O.cnt = (const int*)(ws + WS_CTL) + CW_CNT; O.S_cap = S_; O.nkt_full = FF / 64;
                { const int U = tb[8] * NT_D, Rr = U / G_, Tt = U - Rr * G_; const bool split = Tt > 0 && 4 * Tt <= G_; O.R = split ? Rr : -1; O.T = split ? Tt : 0; }
                pg8::Gemm g{ACT, (const bf16*)(ws + WS_WDE), FF, FF};
                pg8::EpiMoeDown E{Y, DM, NT_D, (const float*)(ws + WS_LGATE), (const int*)(ws + WS_CTL) + CW_CNT, S_, (bf16*)(ws + WS_PT)};
                pg8::gemm_phase<pg8::EpiMoeDown, pg8::MoeOrder, false, true>(ring, g, O, E, F.wave, xlds); }
                SEAM(17);
            }
            if (IN(18)) {
                int tb[9]; moe_tiles(a, tb);
                const int U = tb[8] * NT_D, Rr = U / G_, Tt = U - Rr * G_;
                if (Tt > 0 && 4 * Tt <= G_ && bx < 4 * Tt) {
                    pg8::TileOrder O; O.init(tb[8], NT_D, G_, bx, DOWN_WGM); O.rev = DOWN_REV; pg8::Unit u; O.at((long)Rr * G_ + (bx >> 2), u);
                    moe_tail_reduce(F, a, Tt, u.pm, u.pn); }
                SEAM(18);
            }
            if (IN(19)) { if (REPS(19) > 1) moe_combine(F, a, true); moe_combine(F, a); }
        }
    }
#undef IN
#undef SEAM
#undef REPS
#undef DUP
}

extern "C" void kernel_launch(void* const* d_in, const int* in_sizes, int n_in, void* d_out, int out_size, void* d_ws, size_t ws_size, hipStream_t stream) {
    static int grid = 0;
    if (grid == 0) {
        if (n_in != 22 || in_sizes[0] != S_ * DM || out_size != S_ * DM || ws_size < WS_END) { fprintf(stderr, "kernel_launch: shape/workspace mismatch (n_in %d, in0 %d, out %d, ws %zu, need %zu)\n", n_in, n_in > 0 ? in_sizes[0] : -1, out_size, ws_size, (size_t)WS_END); grid = -1; return; }
        int dev = 0, cus = 0, per_cu = 0;
        if (hipGetDevice(&dev) != hipSuccess || hipDeviceGetAttribute(&cus, hipDeviceAttributeMultiprocessorCount, dev) != hipSuccess) { grid = -1; return; }
        if (hipFuncSetAttribute((const void*)mega_fwd, hipFuncAttributeMaxDynamicSharedMemorySize, LDS_BYTES) != hipSuccess) { fprintf(stderr, "kernel_launch: hipFuncSetAttribute failed\n"); grid = -1; return; }
        if (hipOccupancyMaxActiveBlocksPerMultiprocessor(&per_cu, (const void*)mega_fwd, NWAVES * 64, LDS_BYTES) != hipSuccess || per_cu < 1) { fprintf(stderr, "kernel_launch: occupancy query reports %d\n", per_cu); }
        (void)hipGetLastError();
        grid = cus;
    }
    if (grid < 0) return;
    if (hipMemsetAsync((char*)d_ws + WS_CTL, 0, CTL_ZERO_BYTES, stream) != hipSuccess) return;
    Args a{};
    for (int i = 0; i < 22; ++i) a.in[i] = d_in[i];
    a.out = (float*)d_out; a.ws = (unsigned char*)d_ws; a.pad = 0;
#if MK_PER_PHASE
    for (int ph = 0; ph < DBG_STOP; ++ph) { a.ph_lo = ph; a.ph_hi = ph + 1; a.use_bar = 0;
        hipLaunchKernelGGL(mega_fwd, dim3(grid), dim3(NWAVES * 64), LDS_BYTES, stream, a); }
#else
    a.ph_lo = 0; a.ph_hi = DBG_STOP; a.use_bar = 1;
    hipLaunchKernelGGL(mega_fwd, dim3(grid), dim3(NWAVES * 64), LDS_BYTES, stream, a);
#endif
}
```

```cpp
#define KLOOP_ALIGN "4"
#define MOE_GU_WGM 6
#include <hip/hip_runtime.h>
#include <cstdio>
#include <cstdint>
namespace pg8 {
constexpr int CNT_STRIDE = 32;
#define PG8_LAS __attribute__((address_space(3)))
typedef unsigned short bf16_t;
typedef short bf16x8 __attribute__((ext_vector_type(8)));
typedef float f32x4 __attribute__((ext_vector_type(4)));
typedef unsigned u32x4 __attribute__((ext_vector_type(4)));
constexpr int BM = 256, BK = 64, HALF = 128, HTB = HALF * BK * 2  , STAGE_BYTES = 8 * HTB, NXCD = 8, WGM = 8;

__device__ __forceinline__ int lds_byte(int r, int c) { const int st = (r >> 4) * 2 + (c >> 5), rr = r & 15, cc = c & 31, ob = rr * 64 + cc * 2; return st * 1024 + (ob ^ (((ob >> 9) & 1) << 5)); }
__device__ __forceinline__ void stage_rc(int b, int& R, int& C) { const int st = b / 1024, sb = b % 1024, swz = sb ^ (((sb >> 9) & 1) << 5); R = (st >> 1) * 16 + swz / 64; C = (st & 1) * 32 + (swz % 64) / 2; }
__device__ __forceinline__ int perm32(int rho) { const int n = rho >> 4, i = rho & 15; return 8 * (i >> 2) + 4 * n + (i & 3); }

struct Unit { int pm, pn, e, lt, kt0, nkt, tail; };
struct Gemm { const bf16_t* A; const bf16_t* Bt; int K; int lda; };

struct TileOrder {
    int nM, nN, nwg, G, c, wgm, rev;
    __device__ __forceinline__ void init(int nM_, int nN_, int G_, int c_, int wgm_ = WGM) { nM = nM_; nN = nN_; nwg = nM * nN; G = G_; c = c_; wgm = wgm_; rev = 0; }
    __device__ __forceinline__ bool next(int i, Unit& u) const { return at((long)i * G + c, u); }
    __device__ __forceinline__ bool at(long L, Unit& u) const {
        if (L >= nwg) return false;
        int wgid = (int)L; { const int q = nwg / NXCD, r = nwg % NXCD, xcd = wgid % NXCD, off = wgid / NXCD; wgid = (xcd < r ? xcd * (q + 1) : r * (q + 1) + (xcd - r) * q) + off; }
        if (rev) wgid = nwg - 1 - wgid;
        const int nig = wgm * nN, gid = wgid / nig, fm = gid * wgm, gsz = (nM - fm) < wgm ? (nM - fm) : wgm;
        u.pm = fm + ((wgid % nig) % gsz); u.pn = (wgid % nig) / gsz; u.e = 0; u.lt = 0; u.kt0 = 0; u.nkt = 0; u.tail = 0; return true;
    }
    __device__ __forceinline__ unsigned a_off(const Unit&, int) const { return 0u; }
};
struct MoeOrder {
    TileOrder t; int t1, t2, t3, t4, t5, t6, t7; int nNl; const int* list; const int* cnt; int S_cap; int R, T, nkt_full;
    __device__ __forceinline__ void find(int pm, int& e, int& tb) const {
        e = (pm >= t1) + (pm >= t2) + (pm >= t3) + (pm >= t4) + (pm >= t5) + (pm >= t6) + (pm >= t7);
        tb = pm >= t7 ? t7 : pm >= t6 ? t6 : pm >= t5 ? t5 : pm >= t4 ? t4 : pm >= t3 ? t3 : pm >= t2 ? t2 : pm >= t1 ? t1 : 0;
    }
    __device__ __forceinline__ bool next(int i, Unit& u) const {
        if (R >= 0 && i >= R) {
            if (i > R || t.c >= 4 * T) return false;
            if (!t.at((long)R * t.G + (t.c >> 2), u)) return false;
            u.nkt = nkt_full / 4; u.kt0 = (t.c & 3) * u.nkt; u.tail = 1 + t.c;
        } else { if (!t.next(i, u)) return false; u.nkt = nkt_full; }
        int e, tb; find(u.pm, e, tb); u.e = e; u.lt = u.pm - tb; u.pn += e * nNl; return true;
    }
    __device__ __forceinline__ unsigned a_off(const Unit& u, int R) const {
        const int slot = u.lt * 256 + R; const int n = cnt[u.e * CNT_STRIDE];
        const int tok = list[(size_t)u.e * S_cap + (slot < n ? slot : 0)];
        return (unsigned)tok * 4096u;
    }
};

__device__ __forceinline__ unsigned cvt_pk_bf16(float lo, float hi) { unsigned r; asm volatile("v_cvt_pk_bf16_f32 %0, %1, %2" : "=v"(r) : "v"(lo), "v"(hi)); return r; }

__device__ __forceinline__ float shx(float v, int lane, int o) { return __builtin_bit_cast(float, __builtin_amdgcn_ds_bpermute((lane ^ o) << 2, __builtin_bit_cast(int, v))); }
__device__ __forceinline__ float sum_fq(float v, int lane) { v += shx(v, lane, 16); v += shx(v, lane, 32); return v; }
__device__ __forceinline__ float ssq4(const f32x4 a) { return (a[0] * a[0] + a[1] * a[1]) + (a[2] * a[2] + a[3] * a[3]); }
typedef float f32x2 __attribute__((ext_vector_type(2)));
template <int NS>
__device__ __forceinline__ void row_rs8(const float* ssq, int row0, float inv_n, float eps, float (&rs)[2][4]) {
    if constexpr (NS == 8) { f32x4 a[2][4], b[2][4];
#pragma unroll
        for (int ai = 0; ai < 2; ++ai)
#pragma unroll
            for (int m = 0; m < 4; ++m) { const float* p = ssq + (size_t)(row0 + ai * HALF + m * 16) * 8; a[ai][m] = *(const f32x4*)p; b[ai][m] = *(const f32x4*)(p + 4); }
#pragma unroll
        for (int ai = 0; ai < 2; ++ai)
#pragma unroll
            for (int m = 0; m < 4; ++m) { const f32x4 x = a[ai][m], y = b[ai][m]; rs[ai][m] = __builtin_amdgcn_rsqf((((x[0] + x[1]) + (x[2] + x[3])) + ((y[0] + y[1]) + (y[2] + y[3]))) * inv_n + eps); }
    } else if constexpr (NS == 2) { f32x2 a[2][4];
#pragma unroll
        for (int ai = 0; ai < 2; ++ai)
#pragma unroll
            for (int m = 0; m < 4; ++m) a[ai][m] = *(const f32x2*)(ssq + (size_t)(row0 + ai * HALF + m * 16) * 2);
#pragma unroll
        for (int ai = 0; ai < 2; ++ai)
#pragma unroll
            for (int m = 0; m < 4; ++m) rs[ai][m] = __builtin_amdgcn_rsqf((a[ai][m][0] + a[ai][m][1]) * inv_n + eps);
    } else { float a[2][4];
#pragma unroll
        for (int ai = 0; ai < 2; ++ai)
#pragma unroll
            for (int m = 0; m < 4; ++m) a[ai][m] = ssq[row0 + ai * HALF + m * 16];
#pragma unroll
        for (int ai = 0; ai < 2; ++ai)
#pragma unroll
            for (int m = 0; m < 4; ++m) rs[ai][m] = __builtin_amdgcn_rsqf(a[ai][m] * inv_n + eps);
    }
}
__device__ __forceinline__ void row_rs8n(const float* ssq, int ns, int row0, float inv_n, float eps, float (&rs)[2][4]) {
    if (ns == 8) row_rs8<8>(ssq, row0, inv_n, eps, rs); else if (ns == 2) row_rs8<2>(ssq, row0, inv_n, eps, rs); else row_rs8<1>(ssq, row0, inv_n, eps, rs);
}
__device__ __forceinline__ void ones8(float (&rs)[2][4]) {
#pragma unroll
    for (int ai = 0; ai < 2; ++ai)
#pragma unroll
        for (int m = 0; m < 4; ++m) rs[ai][m] = 1.0f;
}
struct EpiBf16 {
    static constexpr bool PERM = true;
    bf16_t* O; int ldc; const float* ssq; int ns; float inv_n, eps;
    __device__ __forceinline__ void operator()(const f32x4 (&acc)[2][2][4][2], const Unit& u, int wr, int wc, int fr, int fq, int lane, PG8_LAS float* xl) const {
        const int row0 = u.pm * BM + wr * 64 + fr, col0 = u.pn * BM + wc * 32 + 8 * fq;
        float rsv[2][4];
        if (ssq) row_rs8n(ssq, ns, row0, inv_n, eps, rsv); else ones8(rsv);
#pragma unroll
        for (int ai = 0; ai < 2; ++ai)
#pragma unroll
            for (int m = 0; m < 4; ++m) { const int grow = row0 + ai * HALF + m * 16; bf16_t* rowp = O + (size_t)grow * ldc + col0;
                const float rs = rsv[ai][m];
#pragma unroll
                for (int bj = 0; bj < 2; ++bj) { const f32x4 v0 = acc[ai][bj][m][0] * rs, v1 = acc[ai][bj][m][1] * rs;
                    u32x4 w; w.x = cvt_pk_bf16(v0[0], v0[1]); w.y = cvt_pk_bf16(v0[2], v0[3]); w.z = cvt_pk_bf16(v1[0], v1[1]); w.w = cvt_pk_bf16(v1[2], v1[3]);
                    *(u32x4*)(rowp + bj * HALF) = w; } }
    }
};
struct EpiInProj {
    static constexpr bool PERM = true;
    bf16_t* O; int ldc; const float* ssq_x; int ns_x; const float* gq; const float* gk; const float* gckv; float* ssq_cq; float eps;
    __device__ __forceinline__ void operator()(const f32x4 (&acc)[2][2][4][2], const Unit& u, int wr, int wc, int fr, int fq, int lane, PG8_LAS float* xl) const {
        const int row0 = u.pm * BM + wr * 64 + fr, col0 = u.pn * BM + wc * 32 + 8 * fq, pn = u.pn;
        const bool headn = pn < 8, ckvn = pn == 14, cq = (pn == 12 || pn == 13);
        f32x4 v[2][4][2][2];
        float rsxv[2][4]; row_rs8n(ssq_x, ns_x, row0, 1.0f / 2048.0f, eps, rsxv);
#pragma unroll
        for (int ai = 0; ai < 2; ++ai)
#pragma unroll
            for (int m = 0; m < 4; ++m) { const float rsx = rsxv[ai][m];
#pragma unroll
                for (int bj = 0; bj < 2; ++bj)
#pragma unroll
                    for (int n = 0; n < 2; ++n) v[ai][m][bj][n] = acc[ai][bj][m][n] * rsx; }
        if (headn || ckvn) {
#pragma unroll
            for (int ai = 0; ai < 2; ++ai)
#pragma unroll
                for (int m = 0; m < 4; ++m)
#pragma unroll
                    for (int bj = 0; bj < 2; ++bj) { const float s = sum_fq(ssq4(v[ai][m][bj][0]) + ssq4(v[ai][m][bj][1]), lane);
                        if (fq == 0) xl[((ai * HALF + wr * 64 + m * 16 + fr) * 2 + bj) * 4 + wc] = s; }
            asm volatile("s_waitcnt lgkmcnt(0)" ::: "memory"); __builtin_amdgcn_s_barrier(); asm volatile("" ::: "memory");
            f32x4 gg[2][2];
            { const int go = wc * 32 + 8 * fq;
              if (ckvn) { gg[0][0] = *(const f32x4*)(gckv + go); gg[0][1] = *(const f32x4*)(gckv + go + 4); gg[1][0] = *(const f32x4*)(gckv + HALF + go); gg[1][1] = *(const f32x4*)(gckv + HALF + go + 4); }
              else if (pn < 4) { gg[0][0] = *(const f32x4*)(gq + go); gg[0][1] = *(const f32x4*)(gq + go + 4); gg[1][0] = gg[0][0]; gg[1][1] = gg[0][1]; }
              else { gg[0][0] = *(const f32x4*)(gk + go); gg[0][1] = *(const f32x4*)(gk + go + 4); gg[1][0] = gg[0][0]; gg[1][1] = gg[0][1]; } }
#pragma unroll
            for (int ai = 0; ai < 2; ++ai)
#pragma unroll
                for (int m = 0; m < 4; ++m) { const int r = ai * HALF + wr * 64 + m * 16 + fr;
                    const f32x4 p0 = *(const PG8_LAS f32x4*)(xl + (r * 2 + 0) * 4), p1 = *(const PG8_LAS f32x4*)(xl + (r * 2 + 1) * 4);
                    const float t0 = (p0[0] + p0[1]) + (p0[2] + p0[3]), t1 = (p1[0] + p1[1]) + (p1[2] + p1[3]);
                    const float r0 = ckvn ? __builtin_amdgcn_rsqf((t0 + t1) * (1.0f / 256.0f) + eps) : __builtin_amdgcn_rsqf(t0 * (1.0f / 128.0f) + eps);
                    const float r1 = ckvn ? r0 : __builtin_amdgcn_rsqf(t1 * (1.0f / 128.0f) + eps);
#pragma unroll
                    for (int n = 0; n < 2; ++n) { v[ai][m][0][n] = v[ai][m][0][n] * r0 * gg[0][n]; v[ai][m][1][n] = v[ai][m][1][n] * r1 * gg[1][n]; } }
        } else if (cq) {
#pragma unroll
            for (int ai = 0; ai < 2; ++ai)
#pragma unroll
                for (int m = 0; m < 4; ++m) { const float s = sum_fq((ssq4(v[ai][m][0][0]) + ssq4(v[ai][m][0][1])) + (ssq4(v[ai][m][1][0]) + ssq4(v[ai][m][1][1])), lane);
                    if (fq == 0) xl[(ai * HALF + wr * 64 + m * 16 + fr) * 4 + wc] = s; }
            asm volatile("s_waitcnt lgkmcnt(0)" ::: "memory"); __builtin_amdgcn_s_barrier(); asm volatile("" ::: "memory");
            if (wc == 0 && fq == 0) {
#pragma unroll
                for (int ai = 0; ai < 2; ++ai)
#pragma unroll
                    for (int m = 0; m < 4; ++m) { const int r = ai * HALF + wr * 64 + m * 16 + fr; const f32x4 p = *(const PG8_LAS f32x4*)(xl + r * 4);
                        ssq_cq[(size_t)(u.pm * BM + r) * 2 + (pn - 12)] = (p[0] + p[1]) + (p[2] + p[3]); } }
        }
#pragma unroll
        for (int ai = 0; ai < 2; ++ai)
#pragma unroll
            for (int m = 0; m < 4; ++m) { bf16_t* rowp = O + (size_t)(row0 + ai * HALF + m * 16) * ldc + col0;
#pragma unroll
                for (int bj = 0; bj < 2; ++bj) { const f32x4 v0 = v[ai][m][bj][0], v1 = v[ai][m][bj][1];
                    u32x4 w; w.x = cvt_pk_bf16(v0[0], v0[1]); w.y = cvt_pk_bf16(v0[2], v0[3]); w.z = cvt_pk_bf16(v1[0], v1[1]); w.w = cvt_pk_bf16(v1[2], v1[3]);
                    *(u32x4*)(rowp + bj * HALF) = w; } }
    }
};
struct EpiRes {
    static constexpr bool PERM = true;
    const float* base32; const bf16_t* base16; float* out32; bf16_t* xb; float* ssq; int ldc;
    __device__ __forceinline__ void operator()(const f32x4 (&acc)[2][2][4][2], const Unit& u, int wr, int wc, int fr, int fq, int lane, PG8_LAS float* xl) const {
        const int row0 = u.pm * BM + wr * 64 + fr, col0 = u.pn * BM + wc * 32 + 8 * fq;
        float sr[2][4];
#define PG8_RES_ROW(ai, m, B00, B01, B10, B11) do { const size_t off = (size_t)(row0 + (ai) * HALF + (m) * 16) * ldc + col0; float s = 0.f;                      \
            { const f32x4 o0 = (B00) + acc[ai][0][m][0], o1 = (B01) + acc[ai][0][m][1];                                                                     \
              if (out32) { *(f32x4*)(out32 + off) = o0; *(f32x4*)(out32 + off + 4) = o1; }                                                                  \
              if (xb) { s += ssq4(o0) + ssq4(o1); u32x4 w; w.x = cvt_pk_bf16(o0[0], o0[1]); w.y = cvt_pk_bf16(o0[2], o0[3]); w.z = cvt_pk_bf16(o1[0], o1[1]); w.w = cvt_pk_bf16(o1[2], o1[3]); *(u32x4*)(xb + off) = w; } } \
            { const f32x4 o0 = (B10) + acc[ai][1][m][0], o1 = (B11) + acc[ai][1][m][1];                                                                     \
              if (out32) { *(f32x4*)(out32 + off + HALF) = o0; *(f32x4*)(out32 + off + HALF + 4) = o1; }                                                    \
              if (xb) { s += ssq4(o0) + ssq4(o1); u32x4 w; w.x = cvt_pk_bf16(o0[0], o0[1]); w.y = cvt_pk_bf16(o0[2], o0[3]); w.z = cvt_pk_bf16(o1[0], o1[1]); w.w = cvt_pk_bf16(o1[2], o1[3]); *(u32x4*)(xb + off + HALF) = w; } } \
            sr[ai][m] = s; } while (0)
#define PG8_BF_LO(q_) ((f32x4){__builtin_bit_cast(float, (q_).x << 16), __builtin_bit_cast(float, (q_).x & 0xffff0000u), __builtin_bit_cast(float, (q_).y << 16), __builtin_bit_cast(float, (q_).y & 0xffff0000u)})
#define PG8_BF_HI(q_) ((f32x4){__builtin_bit_cast(float, (q_).z << 16), __builtin_bit_cast(float, (q_).z & 0xffff0000u), __builtin_bit_cast(float, (q_).w << 16), __builtin_bit_cast(float, (q_).w & 0xffff0000u)})
        if (base32) {
#pragma unroll
            for (int ai = 0; ai < 2; ++ai) { f32x4 b[4][2][2];
#pragma unroll
                for (int m = 0; m < 4; ++m) { const size_t off = (size_t)(row0 + ai * HALF + m * 16) * ldc + col0;
#pragma unroll
                    for (int bj = 0; bj < 2; ++bj) { b[m][bj][0] = *(const f32x4*)(base32 + off + bj * HALF); b[m][bj][1] = *(const f32x4*)(base32 + off + bj * HALF + 4); } }
#pragma unroll
                for (int m = 0; m < 4; ++m) PG8_RES_ROW(ai, m, b[m][0][0], b[m][0][1], b[m][1][0], b[m][1][1]); }
        } else {
            u32x4 w[2][4][2];
#pragma unroll
            for (int ai = 0; ai < 2; ++ai)
#pragma unroll
                for (int m = 0; m < 4; ++m) { const size_t off = (size_t)(row0 + ai * HALF + m * 16) * ldc + col0; w[ai][m][0] = *(const u32x4*)(base16 + off); w[ai][m][1] = *(const u32x4*)(base16 + off + HALF); }
#pragma unroll
            for (int ai = 0; ai < 2; ++ai)
#pragma unroll
                for (int m = 0; m < 4; ++m) PG8_RES_ROW(ai, m, PG8_BF_LO(w[ai][m][0]), PG8_BF_HI(w[ai][m][0]), PG8_BF_LO(w[ai][m][1]), PG8_BF_HI(w[ai][m][1]));
        }
#undef PG8_RES_ROW
#undef PG8_BF_LO
#undef PG8_BF_HI
        if (xb) {
#pragma unroll
            for (int ai = 0; ai < 2; ++ai)
#pragma unroll
                for (int m = 0; m < 4; ++m) { const float s = sum_fq(sr[ai][m], lane); if (fq == 0) xl[(ai * HALF + wr * 64 + m * 16 + fr) * 4 + wc] = s; }
            asm volatile("s_waitcnt lgkmcnt(0)" ::: "memory"); __builtin_amdgcn_s_barrier(); asm volatile("" ::: "memory");
            if (wc == 0 && fq == 0) {
#pragma unroll
                for (int ai = 0; ai < 2; ++ai)
#pragma unroll
                    for (int m = 0; m < 4; ++m) { const int r = ai * HALF + wr * 64 + m * 16 + fr; const f32x4 p = *(const PG8_LAS f32x4*)(xl + r * 4);
                        ssq[(size_t)(u.pm * BM + r) * 8 + u.pn] = (p[0] + p[1]) + (p[2] + p[3]); } }
        }
    }
};
__device__ __forceinline__ float silu_mul(float g, float u) { return g * u * __builtin_amdgcn_rcpf(1.0f + __builtin_amdgcn_exp2f(-1.4426950408889634f * g)); }
struct EpiSwiGLU {
    static constexpr bool PERM = true;
    bf16_t* O; int ldc; int nNl; const float* ssq; float eps; int probe;
    __device__ __forceinline__ void operator()(const f32x4 (&acc)[2][2][4][2], const Unit& u, int wr, int wc, int fr, int fq, int lane, PG8_LAS float* xl) const {
        const int pnl = u.pn - u.e * nNl;
        if (probe == 2) return;
        const int row0 = u.pm * BM + wr * 64 + fr, col0 = pnl * HALF + wc * 32 + 8 * fq;
        float rsv[2][4];
        if (ssq) row_rs8<8>(ssq, row0, 1.0f / 2048.0f, eps, rsv); else ones8(rsv);
#pragma unroll
        for (int ai = 0; ai < 2; ++ai)
#pragma unroll
            for (int m = 0; m < 4; ++m) { const int grow = row0 + ai * HALF + m * 16; bf16_t* rowp = O + (size_t)grow * ldc + col0;
                const float rs = rsv[ai][m];
                const f32x4 g0 = acc[ai][0][m][0] * rs, g1 = acc[ai][0][m][1] * rs, u0 = acc[ai][1][m][0] * rs, u1 = acc[ai][1][m][1] * rs;
                u32x4 w; w.x = cvt_pk_bf16(silu_mul(g0[0], u0[0]), silu_mul(g0[1], u0[1])); w.y = cvt_pk_bf16(silu_mul(g0[2], u0[2]), silu_mul(g0[3], u0[3]));
                w.z = cvt_pk_bf16(silu_mul(g1[0], u1[0]), silu_mul(g1[1], u1[1])); w.w = cvt_pk_bf16(silu_mul(g1[2], u1[2]), silu_mul(g1[3], u1[3]));
                if (probe != 1 || w.x == 0x12345678u) *(u32x4*)rowp = w; }
    }
};
struct EpiMoeDown {
    static constexpr bool PERM = true;
    bf16_t* Y; int ldc; int nNl; const float* glist; const int* cnt; int S_cap; bf16_t* P;
    __device__ __forceinline__ void operator()(const f32x4 (&acc)[2][2][4][2], const Unit& u, int wr, int wc, int fr, int fq, int lane, PG8_LAS float* xl) const {
        const int pnl = u.pn - u.e * nNl; const int n = cnt[u.e * CNT_STRIDE];
        const int r0 = wr * 64 + fr;
        char* const tbase = u.tail ? (char*)(P + (size_t)(u.tail - 1) * BM * BM) : (char*)(Y + (size_t)u.pm * BM * ldc + pnl * BM);
        const unsigned pitch = u.tail ? (unsigned)BM : (unsigned)ldc;
        float gtv[2][4];
#pragma unroll
        for (int ai = 0; ai < 2; ++ai)
#pragma unroll
            for (int m = 0; m < 4; ++m) { const int slot = u.lt * 256 + r0 + ai * HALF + m * 16; gtv[ai][m] = slot < n ? glist[(size_t)u.e * S_cap + slot] : 0.f; }
#pragma unroll
        for (int ai = 0; ai < 2; ++ai)
#pragma unroll
            for (int m = 0; m < 4; ++m) { const int r = r0 + ai * HALF + m * 16;
                const float gt = gtv[ai][m];
                bf16_t* rowp = (bf16_t*)(tbase + ((unsigned)r * pitch + (unsigned)(wc * 32 + 8 * fq)) * 2u);
#pragma unroll
                for (int bj = 0; bj < 2; ++bj) { const f32x4 v0 = acc[ai][bj][m][0] * gt, v1 = acc[ai][bj][m][1] * gt;
                    u32x4 w; w.x = cvt_pk_bf16(v0[0], v0[1]); w.y = cvt_pk_bf16(v0[2], v0[3]); w.z = cvt_pk_bf16(v1[0], v1[1]); w.w = cvt_pk_bf16(v1[2], v1[3]);
                    *(u32x4*)(rowp + bj * HALF) = w; } }
    }
};

template <class Epi, class Sched, bool GATHER, bool KS = false>
__device__ __forceinline__ void gemm_phase(PG8_LAS unsigned char* lds, const Gemm g, const Sched& S, const Epi& E, const int wid_in, PG8_LAS float* xlds) {
    int wid_ = wid_in; asm volatile("" : "+s"(wid_)); const int wid = wid_;
    int lane_; asm volatile("v_mbcnt_lo_u32_b32 %0, -1, 0\n\tv_mbcnt_hi_u32_b32 %0, -1, %0" : "=v"(lane_));
    const int lane = lane_, tid = wid * 64 + lane, wr = wid >> 2, wc = wid & 3, fr = lane & 15, fq = lane >> 4;
    const int K = g.K; int nt = K / BK;
    unsigned voffA[2], voffB[2]; int Rg[2];
#pragma unroll
    for (int i = 0; i < 2; ++i) { int R, C; stage_rc(tid * 16 + i * 8192, R, C); const int Rb = Epi::PERM ? ((R & ~31) + perm32(R & 31)) : R;
        voffA[i] = GATHER ? (unsigned)(C * 2) : (unsigned)(R * g.lda + C) * 2u; voffB[i] = (unsigned)(Rb * K + C) * 2u; Rg[i] = R; }
    const size_t kstep = (size_t)(BK * 2);
    const size_t hstep = (size_t)HALF * K * 2;
    const size_t tstep = 2 * hstep;
    const size_t hstepA = (size_t)HALF * g.lda * 2, tstepA = 2 * hstepA;
    const unsigned ldsw = (unsigned)wid * 1024u;
    const int aoff = lds_byte(wr * 64 + fr, fq * 8), boff = lds_byte(wc * 32 + fr, fq * 8);
#define PG8_SA(b, h) (((b) * 2 + (h)) * HTB)
#define PG8_SB(b, h) ((4 + (b) * 2 + (h)) * HTB)
#define PG8_STAGE(bufoff, gbase, voff) do { _Pragma("unroll") for (int _i = 0; _i < 2; ++_i) \
        __builtin_amdgcn_global_load_lds((const unsigned*)((const char*)(gbase) + (voff)[_i]), (PG8_LAS unsigned*)(lds + (bufoff) + ldsw + _i * 8192), 16, 0, 0); } while (0)
#define PG8_STA(bufoff, pbase, gbase, half, goff) do { if constexpr (GATHER) PG8_STAGE(bufoff, gbase, (goff)[half]); else PG8_STAGE(bufoff, (pbase) + (half) * hstepA, voffA); } while (0)
#define PG8_LDA(dst, b, h) do { _Pragma("unroll") for (int m = 0; m < 4; ++m) _Pragma("unroll") for (int k = 0; k < 2; ++k) dst[m][k] = *(const PG8_LAS bf16x8*)(lds + PG8_SA(b, h) + aoff + m * 2048 + k * 1024); } while (0)
#define PG8_LDB(dst, b, h) do { _Pragma("unroll") for (int n = 0; n < 2; ++n) _Pragma("unroll") for (int k = 0; k < 2; ++k) dst[n][k] = *(const PG8_LAS bf16x8*)(lds + PG8_SB(b, h) + boff + n * 2048 + k * 1024); } while (0)
#define PG8_MMA(ai, bj, At, Bt) do { __builtin_amdgcn_s_setprio(1); _Pragma("unroll") for (int m = 0; m < 4; ++m) _Pragma("unroll") for (int n = 0; n < 2; ++n) _Pragma("unroll") for (int k = 0; k < 2; ++k) \
        acc[ai][bj][m][n] = __builtin_amdgcn_mfma_f32_16x16x32_bf16(Bt[n][k], At[m][k], acc[ai][bj][m][n], 0, 0, 0); __builtin_amdgcn_s_setprio(0); } while (0)
#define PG8_WAIT_V(n) asm volatile("s_waitcnt vmcnt(" #n ")" ::: "memory")
#define PG8_WAIT_L(n) asm volatile("s_waitcnt lgkmcnt(" #n ")" ::: "memory")
#define PG8_BAR __builtin_amdgcn_s_barrier()
#define PG8_SCHED __builtin_amdgcn_sched_barrier(0)
#define PG8_GFILL(u, o) do { _Pragma("unroll") for (int _h = 0; _h < 2; ++_h) _Pragma("unroll") for (int _i = 0; _i < 2; ++_i) (o)[_h][_i] = S.a_off(u, _h * HALF + Rg[_i]) + voffA[_i]; } while (0)
    Unit cur, nxt; int ui = 0;
    if (!S.next(0, cur)) return;
    f32x4 acc[2][2][4][2];
#pragma unroll
    for (int a = 0; a < 2; ++a)
#pragma unroll
        for (int b = 0; b < 2; ++b)
#pragma unroll
            for (int m = 0; m < 4; ++m)
#pragma unroll
                for (int n = 0; n < 2; ++n) acc[a][b][m][n] = (f32x4){0.f, 0.f, 0.f, 0.f};
    bf16x8 At[4][2], B0[2][2], B1[2][2];
    unsigned gc[2][2] = {{0u, 0u}, {0u, 0u}}, gn[2][2] = {{0u, 0u}, {0u, 0u}};
    if constexpr (GATHER) PG8_GFILL(cur, gc);
    if constexpr (KS) nt = cur.nkt;
    const char* const gA = (const char*)g.A;
    const char* cA = GATHER ? gA : gA + (size_t)cur.pm * tstepA + (KS ? (size_t)cur.kt0 * kstep : 0); const char* cB = (const char*)g.Bt + (size_t)cur.pn * tstep + (KS ? (size_t)cur.kt0 * kstep : 0);
    PG8_STAGE(PG8_SB(0, 0), cB, voffB); PG8_STAGE(PG8_SB(0, 1), cB + hstep, voffB); PG8_STA(PG8_SA(0, 0), cA, gA, 0, gc); PG8_STA(PG8_SA(0, 1), cA, gA, 1, gc);
    if (wr == 1) PG8_BAR;
    PG8_WAIT_V(2); PG8_BAR;
    PG8_STAGE(PG8_SB(1, 0), cB + kstep, voffB); PG8_STA(PG8_SA(1, 0), cA + kstep, gA + kstep, 0, gc); PG8_STAGE(PG8_SB(1, 1), cB + hstep + kstep, voffB);
    PG8_WAIT_V(6); PG8_BAR;
    for (;;) {
        const bool has_next = S.next(ui + 1, nxt);
        if constexpr (GATHER) { if (has_next) PG8_GFILL(nxt, gn); else {
#pragma unroll
            for (int h = 0; h < 2; ++h)
#pragma unroll
                for (int i = 0; i < 2; ++i) gn[h][i] = gc[h][i]; } }
        const char* nA = (has_next && !GATHER) ? gA + (size_t)nxt.pm * tstepA + (KS ? (size_t)nxt.kt0 * kstep : 0) : cA; const char* nB = has_next ? (const char*)g.Bt + (size_t)nxt.pn * tstep + (KS ? (size_t)nxt.kt0 * kstep : 0) : cB;
        for (int t = 0; t < nt; t += 2) {
#ifdef KLOOP_ALIGN
            asm volatile(".p2align 6\n\t.rept " KLOOP_ALIGN "\n\ts_nop 0\n\t.endr");
#endif
            const bool last = (t == nt - 2);
            const char* a1 = cA + (size_t)(t + 1) * kstep;
            const char* a2 = last ? nA : cA + (size_t)(t + 2) * kstep; const char* b2 = last ? nB : cB + (size_t)(t + 2) * kstep;
            const char* a3 = a2 + kstep; const char* b3 = b2 + kstep;
            unsigned gs[2][2];
#pragma unroll
            for (int h = 0; h < 2; ++h)
#pragma unroll
                for (int i = 0; i < 2; ++i) gs[h][i] = last ? gn[h][i] : gc[h][i];
            PG8_LDB(B0, 0, 0); PG8_LDB(B1, 0, 1); PG8_SCHED; PG8_LDA(At, 0, 0); PG8_STA(PG8_SA(1, 1), a1, a1, 1, gc);
            PG8_WAIT_V(8); PG8_WAIT_L(0); PG8_BAR; PG8_MMA(0, 0, At, B0); PG8_MMA(0, 1, At, B1); PG8_BAR; PG8_SCHED;
            PG8_LDA(At, 0, 1); PG8_STAGE(PG8_SB(0, 0), b2, voffB); PG8_STAGE(PG8_SB(0, 1), b2 + hstep, voffB); PG8_STA(PG8_SA(0, 0), a2, a2, 0, gs);
            PG8_WAIT_V(8); PG8_WAIT_L(0); PG8_BAR; PG8_MMA(1, 0, At, B0); PG8_MMA(1, 1, At, B1); PG8_BAR; PG8_SCHED;
            PG8_LDB(B0, 1, 0); PG8_LDB(B1, 1, 1); PG8_SCHED; PG8_LDA(At, 1, 0); PG8_STA(PG8_SA(0, 1), a2, a2, 1, gs);
            PG8_WAIT_V(8); PG8_WAIT_L(0); PG8_BAR; PG8_MMA(0, 0, At, B0); PG8_MMA(0, 1, At, B1); PG8_BAR; PG8_SCHED;
            PG8_LDA(At, 1, 1); PG8_STAGE(PG8_SB(1, 0), b3, voffB); PG8_STAGE(PG8_SB(1, 1), b3 + hstep, voffB); PG8_STA(PG8_SA(1, 0), a3, a3, 0, gs);
            PG8_WAIT_V(8); PG8_WAIT_L(0); PG8_BAR; PG8_MMA(1, 0, At, B0); PG8_MMA(1, 1, At, B1); PG8_BAR; PG8_SCHED;
        }
        if (wr == 0) PG8_BAR;
        E(acc, cur, wr, wc, fr, fq, lane, xlds);
        if (!has_next) break;
#pragma unroll
        for (int a = 0; a < 2; ++a)
#pragma unroll
            for (int b = 0; b < 2; ++b)
#pragma unroll
                for (int m = 0; m < 4; ++m)
#pragma unroll
                    for (int n = 0; n < 2; ++n) acc[a][b][m][n] = (f32x4){0.f, 0.f, 0.f, 0.f};
        cur = nxt; cA = nA; cB = nB; ++ui; if constexpr (KS) nt = cur.nkt;
#pragma unroll
        for (int h = 0; h < 2; ++h)
#pragma unroll
            for (int i = 0; i < 2; ++i) gc[h][i] = gn[h][i];
        if (wr == 1) PG8_BAR;
    }
    PG8_WAIT_V(0);
    PG8_BAR;
#undef PG8_SA
#undef PG8_SB
#undef PG8_STAGE
#undef PG8_STA
#undef PG8_LDA
#undef PG8_LDB
#undef PG8_MMA
#undef PG8_WAIT_V
#undef PG8_WAIT_L
#undef PG8_BAR
#undef PG8_SCHED
#undef PG8_GFILL
}
}
namespace att {
#define ALAS __attribute__((address_space(3)))
typedef unsigned short bf16_t;
typedef short bf16x8 __attribute__((ext_vector_type(8)));
typedef short s16x4 __attribute__((ext_vector_type(4)));
typedef float f32x16 __attribute__((ext_vector_type(16)));
typedef float f32x4 __attribute__((ext_vector_type(4)));
typedef unsigned u32x4 __attribute__((ext_vector_type(4)));
typedef ALAS char* lptr;
constexpr int NW = 8, QBLK = 32, KVBLK = 64, QB = NW * QBLK;
constexpr int SHM_V = KVBLK * 128 * 2;
constexpr int TBL_U0 = 2400, TBL_N = 2688;
constexpr float THR = 8.f;

template <int DQK_, int QP_, int KP_, int VP_, int OP_, bool TBL_, int LP_ = 0, int JMIN_ = 0> struct Cfg {
    static constexpr int DQK = DQK_, QP = QP_, KP = KP_, VP = VP_, OP = OP_, LP = LP_, JMIN = JMIN_; static constexpr bool TBL = TBL_;
    static constexpr int ND = DQK / 16, NKC = DQK / 64, KROW = DQK * 2, SHM_K = KVBLK * DQK * 2;
    static constexpr float SCALE = (DQK == 128) ? 0.08838834764831845f : 0.07216878364870323f;
    static constexpr int OFF_K = 0, OFF_V = 2 * SHM_K, OFF_WS = 2 * SHM_V + 2 * SHM_K;
    static constexpr int OFF_TBL = OFF_WS + NW * 64 * 4, OFF_QR = OFF_TBL + (TBL ? TBL_N * 4 : 0), LDS_BYTES = OFF_QR + (DQK > 128 ? NW * 4096 : 0);
    static_assert(LDS_BYTES <= 131072, "attention LDS");
};

#define SBAR() __builtin_amdgcn_sched_barrier(0)
__device__ __forceinline__ int v_st(int k, int c) { const int kk = (k & ~0xC) | ((k & 4) << 1) | ((k & 8) >> 1); return ((kk >> 3) * 4 + (c >> 5)) * 512 + ((kk & 7) * 32 + (c & 31)) * 2; }
__device__ __forceinline__ int v_rd_base(int lane) { return ((lane & 3) << 3) | (((lane >> 2) & 3) << 6) | (((lane >> 4) & 1) << 5) | (((lane >> 5) & 1) << 8); }
constexpr int v_rd_off(int d0, int ks, int half) { return d0 * 512 + ks * 4096 + half * 2048; }
__device__ __forceinline__ int crow(int r, int hi) { return (r & 3) + 8 * (r >> 2) + 4 * hi; }
__device__ __forceinline__ unsigned cvtpk(float lo, float hi) { unsigned r; asm volatile("v_cvt_pk_bf16_f32 %0, %1, %2" : "=v"(r) : "v"(lo), "v"(hi)); return r; }
__device__ __forceinline__ bf16x8 ld8(const bf16_t* p) { return *reinterpret_cast<const bf16x8*>(p); }
__device__ __forceinline__ bf16x8 ld8u(const bf16_t* ubase, unsigned boff) { return *reinterpret_cast<const bf16x8*>((const char*)ubase + boff); }

__device__ __forceinline__ void mask_tile(f32x16& p0, f32x16& p1, int dq) {
    const float NEG = -__builtin_inff();
#pragma unroll
    for (int r = 0; r < 16; ++r) {
        const int c = (r & 3) + 8 * (r >> 2);
        if (dq - c < 0) p0[r] = NEG;
        if (dq - c - 32 < 0) p1[r] = NEG;
    }
}
__device__ __forceinline__ void table_tile(f32x16& p0, f32x16& p1, const ALAS float* tb) {
#pragma unroll
    for (int r = 0; r < 16; ++r) {
        const int c = (r & 3) + 8 * (r >> 2);
        p0[r] += tb[c]; p1[r] += tb[c + 32];
    }
}
template <class C>
__device__ __forceinline__ void partialSM(f32x16& p0, f32x16& p1, float& m_reg, float& mn, float& alpha) {
    float pmax = p0[0];
#pragma unroll
    for (int r = 1; r < 16; ++r) pmax = fmaxf(pmax, p0[r]);
#pragma unroll
    for (int r = 0; r < 16; ++r) pmax = fmaxf(pmax, p1[r]);
    { auto rr = __builtin_amdgcn_permlane32_swap(__float_as_uint(pmax), __float_as_uint(pmax), false, false);
      pmax = fmaxf(__uint_as_float(rr[0]), __uint_as_float(rr[1])); }
    constexpr float C2 = 1.4426950408889634f * C::SCALE;
    if (__builtin_expect(__all((pmax - m_reg) * C::SCALE <= THR), 1)) { mn = m_reg; alpha = 1.f; }
    else { mn = fmaxf(m_reg, pmax); alpha = __builtin_amdgcn_exp2f((m_reg - mn) * C2); m_reg = mn; }
    const float mnL = -mn * C2;
#pragma unroll
    for (int r = 0; r < 16; ++r) p0[r] = fmaf(p0[r], C2, mnL);
#pragma unroll
    for (int r = 0; r < 16; ++r) p1[r] = fmaf(p1[r], C2, mnL);
#pragma unroll
    for (int r = 0; r < 16; ++r) p0[r] = __builtin_amdgcn_exp2f(p0[r]);
}
__device__ __forceinline__ void finishSM(f32x16& p0, f32x16& p1, float alpha, float& l_reg, bf16x8& pa0, bf16x8& pa1, bf16x8& pa2, bf16x8& pa3) {
#pragma unroll
    for (int r = 0; r < 16; ++r) p1[r] = __builtin_amdgcn_exp2f(p1[r]);
    float ps = 0;
#pragma unroll
    for (int r = 0; r < 16; ++r) ps += p0[r];
#pragma unroll
    for (int r = 0; r < 16; ++r) ps += p1[r];
    { auto rr = __builtin_amdgcn_permlane32_swap(__float_as_uint(ps), __float_as_uint(ps), false, false);
      ps = __uint_as_float(rr[0]) + __uint_as_float(rr[1]); }
    l_reg = l_reg * alpha + ps;
#define PK4(P, B_, OUT) do { unsigned a0 = cvtpk(P[B_+0], P[B_+1]), a1 = cvtpk(P[B_+2], P[B_+3]);                          \
        unsigned b0 = cvtpk(P[B_+4], P[B_+5]), b1 = cvtpk(P[B_+6], P[B_+7]);                                             \
        auto r0 = __builtin_amdgcn_permlane32_swap(a0, b0, false, false); auto r1 = __builtin_amdgcn_permlane32_swap(a1, b1, false, false); \
        u32x4 w = {r0[0], r1[0], r0[1], r1[1]}; OUT = *reinterpret_cast<bf16x8*>(&w); } while (0)
    PK4(p0, 0, pa0); PK4(p0, 8, pa1); PK4(p1, 0, pa2); PK4(p1, 8, pa3);
#undef PK4
}
template <class C, int KB>
__device__ __forceinline__ void qkt(f32x16& p0, f32x16& p1, lptr K_lds, int r32, int hi, const bf16x8* qr, lptr qlds) {
    p0 = f32x16{}; p1 = f32x16{};
    lptr kb[4];
#pragma unroll
    for (int dd = 0; dd < 4; ++dd) {
        const int sw = (C::DQK == 128) ? (r32 & 7) : ((r32 >> 1) & 7);
        kb[dd] = K_lds + KB * C::SHM_K + r32 * C::KROW + 16 * ((2 * dd + hi) ^ sw);
    }
#pragma unroll
    for (int d0 = 0; d0 < C::ND; ++d0) { lptr a = kb[d0 & 3] + (d0 >> 2) * 128;
        bf16x8 b0 = *reinterpret_cast<const ALAS bf16x8*>(a);
        bf16x8 b1 = *reinterpret_cast<const ALAS bf16x8*>(a + 32 * C::KROW);
        bf16x8 q; if (d0 < 8) q = qr[d0]; else q = *reinterpret_cast<const ALAS bf16x8*>(qlds + (d0 - 8) * 1024);
        p0 = __builtin_amdgcn_mfma_f32_32x32x16_bf16(b0, q, p0, 0, 0, 0);
        p1 = __builtin_amdgcn_mfma_f32_32x32x16_bf16(b1, q, p1, 0, 0, 0); }
}
template <int VB>
__device__ __forceinline__ void pv_tile(f32x16* o, int vb0, bf16x8 pa0, bf16x8 pa1, bf16x8 pa2, bf16x8 pa3) {
#define TRRD(dst, off) asm volatile("ds_read_b64_tr_b16 %0, %1 offset:%2" : "=&v"(dst) : "v"(vb0), "i"(off) : "memory")
#define PV_D0(d0) do { s16x4 l0, l1, l2, l3, h0, h1, h2, h3; constexpr int b_ = VB * SHM_V + v_rd_off(d0, 0, 0); \
        TRRD(l0, b_); TRRD(h0, b_ + 2048); TRRD(l1, b_ + 4096); TRRD(h1, b_ + 6144); TRRD(l2, b_ + 8192); TRRD(h2, b_ + 10240); TRRD(l3, b_ + 12288); TRRD(h3, b_ + 14336); \
        asm volatile("s_waitcnt lgkmcnt(0)" ::: "memory"); SBAR();   \
        o[d0] = __builtin_amdgcn_mfma_f32_32x32x16_bf16(pa0, (bf16x8){l0[0], l0[1], l0[2], l0[3], h0[0], h0[1], h0[2], h0[3]}, o[d0], 0, 0, 0);   \
        o[d0] = __builtin_amdgcn_mfma_f32_32x32x16_bf16(pa1, (bf16x8){l1[0], l1[1], l1[2], l1[3], h1[0], h1[1], h1[2], h1[3]}, o[d0], 0, 0, 0);   \
        o[d0] = __builtin_amdgcn_mfma_f32_32x32x16_bf16(pa2, (bf16x8){l2[0], l2[1], l2[2], l2[3], h2[0], h2[1], h2[2], h2[3]}, o[d0], 0, 0, 0);   \
        o[d0] = __builtin_amdgcn_mfma_f32_32x32x16_bf16(pa3, (bf16x8){l3[0], l3[1], l3[2], l3[3], h3[0], h3[1], h3[2], h3[3]}, o[d0], 0, 0, 0); } while (0)
    PV_D0(0); PV_D0(1); PV_D0(2); PV_D0(3);
#undef PV_D0
#undef TRRD
}

struct BlockRef { const bf16_t* Q; const bf16_t* K; const bf16_t* V; bf16_t* O; float* lse; int P0; };
template <class C> struct Seam { bf16x8 qr[C::ND]; bf16x8 st_v0, st_v1; bf16x8 st_k[C::NKC]; };
__device__ __forceinline__ int swa_jlo(int P0, int W) { const int lowk = P0 - W + 1; return lowk > 0 ? lowk / KVBLK : 0; }

#define VMW() asm volatile("s_waitcnt vmcnt(0)" ::: "memory")
#define VMWN(n) asm volatile("s_waitcnt vmcnt(%0)" :: "i"(n) : "memory")
#define SLOAD_H(Kp, Vp, k0) do { const bf16_t* vu_ = (Vp) + (size_t)(k0) * C::VP; const bf16_t* ku_ = (Kp) + (size_t)(k0) * C::KP;                        \
        S.st_v0 = ld8u(vu_, voffV); S.st_v1 = ld8u(vu_ + 32 * C::VP, voffV);     \
        if constexpr (C::DQK == 128) { S.st_k[0] = ld8u(ku_, voffK); S.st_k[1] = ld8u(ku_ + 32 * C::KP, voffK); } \
        else { _Pragma("unroll") for (int i_ = 0; i_ < 3; ++i_) S.st_k[i_] = ld8u(ku_ + 64 * i_, voffK); } } while (0)
#define SWRITE_HK(bf) do { if constexpr (C::DQK == 128) { *(ALAS bf16x8*)(K_lds + (bf) * C::SHM_K + kws) = S.st_k[0]; *(ALAS bf16x8*)(K_lds + (bf) * C::SHM_K + kws + 32 * 256) = S.st_k[1]; } \
        else { _Pragma("unroll") for (int i_ = 0; i_ < 3; ++i_) *(ALAS bf16x8*)(K_lds + (bf) * C::SHM_K + kws + 128 * i_) = S.st_k[i_]; } } while (0)
#define SWRITE_HV(bf) do { *(ALAS bf16x8*)(V_lds + (bf) * SHM_V + vst0) = S.st_v0; *(ALAS bf16x8*)(V_lds + (bf) * SHM_V + vst1) = S.st_v1; } while (0)
#define SWRITE_H(bf) do { SWRITE_HV(bf); SWRITE_HK(bf); } while (0)
#define ATT_IDX() int lane_; asm volatile("v_mbcnt_lo_u32_b32 %0, -1, 0\n\tv_mbcnt_hi_u32_b32 %0, -1, %0" : "=v"(lane_)); const int lane = lane_, tid = wid * 64 + lane, r32 = lane & 31, hi = lane >> 5; \
    const int sr = tid >> 4, sc = (tid & 15) * 8, kr = tid >> 3, kc = (tid & 7) * 8; \
    const int kws = (C::DQK == 128) ? (sr * 256 + ((sc * 2) ^ ((sr & 7) << 4))) : (kr * 384 + 16 * ((tid & 7) ^ ((kr >> 1) & 7))); \
    const unsigned voffV = (unsigned)(sr * C::VP + sc) * 2u, voffK = (C::DQK == 128) ? (unsigned)(sr * C::KP + sc) * 2u : (unsigned)(kr * C::KP + kc) * 2u, voffQ = (unsigned)((wid * QBLK + r32) * C::QP + hi * 8) * 2u; \
    (void)wid; (void)lane; (void)r32; (void)hi; (void)kr; (void)kc; (void)sr; (void)sc; (void)kws; (void)voffV; (void)voffK; (void)voffQ

template <class C>
__device__ __forceinline__ void prime(const BlockRef& cur, int W, lptr lds, Seam<C>& S, const int wid) {
    ATT_IDX(); lptr K_lds = lds + C::OFF_K;
    const int kb0 = swa_jlo(cur.P0, W) * KVBLK;
#pragma unroll
    for (int d0 = 0; d0 < C::ND; ++d0) S.qr[d0] = ld8u(cur.Q + d0 * 16, voffQ);
    SLOAD_H(cur.K, cur.V, kb0); VMW(); SWRITE_HK(0);
    __syncthreads();
}
template <class C>
__device__ __forceinline__ void block(const BlockRef& cur, const BlockRef& nxt, int skv, int W, lptr lds, Seam<C>& S, const int wid) {
    ATT_IDX();
    const int j_lo = swa_jlo(cur.P0, W);
    int j_hi = (cur.P0 + QB - 1 - C::JMIN) / KVBLK + 1; if (j_hi > skv / KVBLK) j_hi = skv / KVBLK;
    const int NT = j_hi - j_lo;
    const int kbn = swa_jlo(nxt.P0, W) * KVBLK;
    const int qlo = cur.P0 + wid * QBLK, qm = qlo + r32 - 4 * hi;
    lptr V_lds = lds + C::OFF_V; lptr K_lds = lds + C::OFF_K;
    ALAS float* ws = (ALAS float*)(lds + C::OFF_WS) + wid * 64; ALAS float* li_l = ws; ALAS float* al_l = ws + 32;
    const ALAS float* tbl = (const ALAS float*)(lds + C::OFF_TBL);
    float m_reg = -1e30f, l_reg = 0; f32x16 o[4] = {};
    const int vst0 = v_st(sr, sc), vst1 = v_st(32 + sr, sc);
    const int vb0 = (int)(unsigned)(uintptr_t)V_lds + v_rd_base(lane);
    const bf16_t* Kh = cur.K; const bf16_t* Vh = cur.V;
#define RESC(a) do { if (__any((a) < 1.f)) { if (hi == 0) al_l[r32] = (a); asm volatile("s_waitcnt lgkmcnt(0)" ::: "memory");              \
                     _Pragma("unroll") for (int d_ = 0; d_ < 4; ++d_) _Pragma("unroll") for (int r = 0; r < 16; ++r) o[d_][r] *= al_l[crow(r, hi)]; } } while (0)
#define KBASE(t) ((j_lo + (t)) * KVBLK)
#define MASKT(P0_, P1_, t) do { const int kb_ = KBASE(t); if constexpr (C::TBL) { table_tile(P0_, P1_, tbl + (TBL_U0 - (qm - kb_))); } \
                                else { if (kb_ + KVBLK - 1 > qlo) mask_tile(P0_, P1_, qm - kb_); } } while (0)
#define SEAM_K0() do { VMWN(C::ND); SWRITE_HK(0); SBAR(); } while (0)
    f32x16 pA0, pA1, pB0, pB1; float mnA, mnB, alA, alB; bf16x8 pa0, pa1, pa2, pa3;
    lptr qlds = lds + C::OFF_QR + wid * 4096 + lane * 16;
    if constexpr (C::DQK > 128) {
#pragma unroll
        for (int d0 = 8; d0 < C::ND; ++d0) *reinterpret_cast<ALAS bf16x8*>(qlds + (d0 - 8) * 1024) = S.qr[d0]; }
    SWRITE_HV(0); SBAR();
    if (NT > 1) { SLOAD_H(Kh, Vh, KBASE(1)); }
    SBAR(); qkt<C, 0>(pA0, pA1, K_lds, r32, hi, S.qr, qlds);
    MASKT(pA0, pA1, 0); partialSM<C>(pA0, pA1, m_reg, mnA, alA);
    if (NT > 1) { VMW(); SWRITE_H(1); }
    __syncthreads();
#define HALF_STEP(PX0, PX1, mnX, alX, PY0, PY1, alY, t, KB, VB, SB) do {                                                      \
        SBAR(); qkt<C, KB>(PX0, PX1, K_lds, r32, hi, S.qr, qlds);                                                                   \
        finishSM(PY0, PY1, alY, l_reg, pa0, pa1, pa2, pa3); SBAR();                                                           \
        if ((t) + 1 < NT) { SLOAD_H(Kh, Vh, KBASE((t) + 1)); SBAR(); }                                                        \
        pv_tile<VB>(o, vb0, pa0, pa1, pa2, pa3); MASKT(PX0, PX1, (t)); partialSM<C>(PX0, PX1, m_reg, mnX, alX);               \
        __syncthreads();                                                                                                      \
        if ((t) + 1 < NT) { VMW(); SWRITE_H(SB); }                                                                            \
        RESC(alX); __syncthreads(); } while (0)
    for (int t = 1; t + 1 < NT; t += 2) {
#ifdef ALOOP_ALIGN
        asm volatile(".p2align 6\n\t.rept " ALOOP_ALIGN "\n\ts_nop 0\n\t.endr");
#endif
#ifdef ALOOP_ALIGN3
        if constexpr (C::DQK == 192) asm volatile(".p2align 6\n\t.rept " ALOOP_M "\n\ts_nop 0\n\t.endr"); else if constexpr (C::JMIN == 0) asm volatile(".p2align 6\n\t.rept " ALOOP_A "\n\ts_nop 0\n\t.endr"); else asm volatile(".p2align 6\n\t.rept " ALOOP_B "\n\ts_nop 0\n\t.endr");
#endif
        HALF_STEP(pB0, pB1, mnB, alB, pA0, pA1, alA, t, 1, 0, 0);
        HALF_STEP(pA0, pA1, mnA, alA, pB0, pB1, alB, t + 1, 0, 1, 1);
    }
    {
    int lane2_; asm volatile("v_mbcnt_lo_u32_b32 %0, -1, 0\n\tv_mbcnt_hi_u32_b32 %0, -1, %0" : "=v"(lane2_));
    const int lane = lane2_, r32 = lane & 31, hi = lane >> 5, qm = qlo + r32 - 4 * hi;
    const unsigned voffQ = (unsigned)((wid * QBLK + r32) * C::QP + hi * 8) * 2u;
    lptr qlds = lds + C::OFF_QR + wid * 4096 + lane * 16; (void)qlds; (void)qm;
    const bool even = (NT & 1) == 0;
    if (even) { SBAR(); qkt<C, 1>(pB0, pB1, K_lds, r32, hi, S.qr, qlds); SBAR(); }
    SLOAD_H(nxt.K, nxt.V, kbn); SBAR();
#pragma unroll
    for (int d0 = 0; d0 < C::ND; ++d0) S.qr[d0] = ld8u(nxt.Q + d0 * 16, voffQ);
    SBAR();
    finishSM(pA0, pA1, alA, l_reg, pa0, pa1, pa2, pa3); SBAR();
    pv_tile<0>(o, vb0, pa0, pa1, pa2, pa3);
    if (even) { MASKT(pB0, pB1, NT - 1); partialSM<C>(pB0, pB1, m_reg, mnB, alB); __syncthreads(); RESC(alB);
        finishSM(pB0, pB1, alB, l_reg, pa0, pa1, pa2, pa3); SBAR(); pv_tile<1>(o, vb0, pa0, pa1, pa2, pa3); }
    SBAR(); SEAM_K0();
    if (hi == 0) li_l[r32] = l_reg; asm volatile("s_waitcnt lgkmcnt(0)" ::: "memory");
    float rli[16];
#pragma unroll
    for (int r = 0; r < 16; ++r) { const float lv = li_l[crow(r, hi)]; rli[r] = lv > 0.f ? __builtin_amdgcn_rcpf(lv) : 0.f; }
    if constexpr (C::LP > 0) { if (hi == 0) cur.lse[(size_t)(wid * QBLK + r32) * C::LP] = l_reg > 0.f ? m_reg * C::SCALE + __logf(l_reg) : -__builtin_inff(); }
    char* const Ou = (char*)cur.O;
    const unsigned ooff = (unsigned)((wid * QBLK + 4 * hi) * C::OP + r32) * 2u;
#pragma unroll
    for (int r = 0; r < 16; ++r) { const int orow = (r & 3) + 8 * (r >> 2);
#pragma unroll
        for (int d0 = 0; d0 < 4; ++d0) { const float v = o[d0][r] * rli[r];
            const float vn = __builtin_bit_cast(float, __builtin_amdgcn_mov_dpp(__builtin_bit_cast(int, v), 0xB1, 0xF, 0xF, true));
            if ((r32 & 1) == 0) *(unsigned*)(Ou + ooff + (unsigned)(orow * C::OP + d0 * 32) * 2u) = cvtpk(v, vn); } }
    }
    __syncthreads();
#undef RESC
#undef KBASE
#undef MASKT
#undef SEAM_K0
#undef HALF_STEP
}
#undef VMW
#undef VMWN
#undef SLOAD_H
#undef SWRITE_HK
#undef SWRITE_HV
#undef SWRITE_H
#undef ATT_IDX
#undef SBAR
}
constexpr int NWAVES = 8;
constexpr int S_ = 16384, DM = 2048, NLAYER = 2;
constexpr int WA = 1024, QLORA = 512, KVLORA = 256, ROPE = 64, INC = 3904, INP = 4096;
constexpr int C_QA = 0, C_KA = 1024, C_VA = 2048, C_CQ = 3072, C_CKV = 3584, C_KR = 3840;
constexpr int NH = 8, HD = 128, QKB = 192, NQB_ = 1536  , NKVB = 2048  ;
constexpr int FF = 5632, NEXP = 8, NGU = 2 * FF  , NT_GU = NGU / 256  , NT_D = DM / 256  ;
constexpr int MT_MAX = 136;
constexpr float EPS = 1e-6f;
constexpr int W_DIL = 2049;
constexpr int W_CAUSAL = 0x40000000;

constexpr size_t MiB = 1u << 20;
constexpr size_t WS_CTL = 0, CTL_ZERO_BYTES = 32 * 1024;
constexpr size_t WS_TBL = 1 * MiB;
constexpr size_t WS_POS = 1 * MiB + 512 * 1024;
constexpr size_t WS_LTOK = 2 * MiB;
constexpr size_t WS_LGATE = 2 * MiB + 512 * 1024;
constexpr size_t WS_SSQ0 = 3 * MiB;
constexpr size_t WS_SSQX = WS_SSQ0 + 64 * 1024;
constexpr size_t WS_SSQC = WS_SSQX + 1 * MiB;
static_assert(WS_SSQC + 256 * 1024 <= 6 * MiB, "ws map");
constexpr size_t WS_WIN = 6 * MiB;
constexpr size_t WS_WQB = WS_WIN + 32 * MiB;
constexpr size_t WS_WKVB = WS_WQB + 3 * MiB;
constexpr size_t WS_WOUT = WS_WKVB + 2 * MiB;
constexpr size_t WS_WGU = WS_WOUT + 16 * MiB;
constexpr size_t WS_WD = WS_WGU + 44 * MiB;
constexpr size_t WS_WGUE = WS_WD + 22 * MiB;
constexpr size_t WS_WDE = WS_WGUE + 352 * MiB;
constexpr size_t WS_H = WS_WDE + 176 * MiB;
constexpr size_t WS_ACTS = WS_H + 64 * MiB;
constexpr size_t WS_PROJ = WS_ACTS;
constexpr size_t WS_QM = WS_PROJ + 128 * MiB;
constexpr size_t WS_KVM = WS_QM + 48 * MiB;
constexpr size_t WS_KM = WS_KVM + 64 * MiB;
constexpr size_t WS_CQN = WS_KM + 48 * MiB;
constexpr size_t WS_CKVN = WS_CQN + 16 * MiB;
constexpr size_t WS_ATT = WS_CKVN + 8 * MiB;
constexpr size_t WS_OA = WS_ATT + 64 * MiB, WS_OB = WS_OA + 32 * MiB;
constexpr size_t WS_LSEA = WS_OB + 32 * MiB, WS_LSEB = WS_LSEA + 1 * MiB;
constexpr size_t WS_ACT = WS_ACTS;
constexpr size_t WS_Y = WS_ACT + 374 * MiB;
constexpr size_t WS_PT = WS_Y + 136 * MiB;
constexpr size_t WS_HN = WS_PT + 32 * MiB;
constexpr size_t WS_END = WS_HN + 64 * MiB;
static_assert(WS_LSEB + 1 * MiB <= WS_END, "ws map");
static_assert((size_t)MT_MAX * 256 * FF * 2 <= 374 * MiB && (size_t)MT_MAX * 256 * DM * 2 <= 136 * MiB, "ws map");
constexpr int CW_TMO = 0, CW_CODE = 1;
constexpr int CW_CNT = 64;
constexpr int CW_BAR = 4096;

constexpr int RING_OFF = 0, RING_BYTES = 131072;
constexpr int LDSCTL_OFF = RING_BYTES, MISC_OFF = LDSCTL_OFF + 320, XLDS_OFF = RING_BYTES + 1024;
constexpr int LDS_BYTES = 147456;
static_assert(MISC_OFF + 128 <= XLDS_OFF && XLDS_OFF + 8192 <= LDS_BYTES, "LDS map");

#define GAS __attribute__((address_space(1)))
#define LAS __attribute__((address_space(3)))
typedef unsigned short bf16;
typedef unsigned v4u __attribute__((ext_vector_type(4)));
typedef unsigned v2u __attribute__((ext_vector_type(2)));
typedef float f32x4 __attribute__((ext_vector_type(4)));
typedef GAS unsigned gu32;
#define RLX_AGENT __ATOMIC_RELAXED, __HIP_MEMORY_SCOPE_AGENT
#define LDS_WAIT() asm volatile("s_waitcnt lgkmcnt(0)" ::: "memory")
#define VM_WAIT() asm volatile("s_waitcnt vmcnt(0)" ::: "memory")
__device__ __forceinline__ unsigned f2bf(float f) { unsigned u = __builtin_bit_cast(unsigned, f); return (u + 0x7fffu + ((u >> 16) & 1u)) >> 16; }
__device__ __forceinline__ unsigned pk2(float lo, float hi) { return f2bf(lo) | (f2bf(hi) << 16); }
__device__ __forceinline__ float bflo(unsigned w) { return __builtin_bit_cast(float, w << 16); }
__device__ __forceinline__ float bfhi(unsigned w) { return __builtin_bit_cast(float, w & 0xffff0000u); }

#define XB_TMO      128
#define XB_XCNT(j)  (256  + 64 * (j))
#define XB_XSUB(j)  (1280 + 64 * (j))
#define XB_XGEN(j)  (2304 + 64 * (j))
#define XB_TOP      3328
#define XB_TOPGEN   3392
#define XCD_BAR_WORDS 3456
#define XB_SPIN_CAP (1u << 20)
static_assert((size_t)(CW_BAR + XCD_BAR_WORDS) * 4 <= CTL_ZERO_BYTES && (size_t)(CW_CNT + 8 * 32) * 4 <= (size_t)CW_BAR * 4, "control words inside the zeroed region");

__device__ __forceinline__ unsigned xb_ld(gu32* p)              { return __hip_atomic_load(p, __ATOMIC_RELAXED, __HIP_MEMORY_SCOPE_AGENT); }
__device__ __forceinline__ unsigned xb_add(gu32* p, unsigned v) { return __hip_atomic_fetch_add(p, v, __ATOMIC_RELAXED, __HIP_MEMORY_SCOPE_AGENT); }
__device__ __forceinline__ unsigned xb_xcc_id() { return (unsigned)__builtin_amdgcn_s_getreg((3 << 11) | 20) & 0xFu; }
#define XB_SPIN(cond, bar) do { unsigned _sp = 0; while (cond) { __builtin_amdgcn_s_sleep(1); \
    if ((++_sp & 255u) == 0u) { if (xb_ld(&(bar)[XB_TMO])) break; if (_sp > XB_SPIN_CAP) { xb_add(&(bar)[XB_TMO], 1u); break; } } } } while (0)

struct XcdBarrier {
    gu32* bar; unsigned x;
    volatile LAS unsigned* st;
};
__device__ __forceinline__ XcdBarrier xcd_barrier_post(gu32* bar, volatile LAS unsigned* st) {
    XcdBarrier b; b.bar = bar; b.x = xb_xcc_id(); b.st = st;
    if (threadIdx.x == 0) (void)xb_add(&bar[XB_XCNT(b.x)], 1u);
    return b;
}
__device__ __forceinline__ void xcd_barrier_complete(gu32* bar, unsigned x, unsigned& nloc, unsigned& nx) {
    const unsigned G = gridDim.x * gridDim.y * gridDim.z;
    unsigned sum, cnt, mine, sp = 0u;
    for (;;) {
        sum = 0u; cnt = 0u; mine = 0u;
#pragma unroll
        for (unsigned j = 0; j < 16; ++j) { const unsigned c = xb_ld(&bar[XB_XCNT(j)]); sum += c; cnt += (c > 0u) ? 1u : 0u; mine = (j == x) ? c : mine; }
        if (sum == G) break;
        __builtin_amdgcn_s_sleep(1);
        if ((++sp & 255u) == 0u) { if (xb_ld(&bar[XB_TMO])) break; if (sp > XB_SPIN_CAP) { xb_add(&bar[XB_TMO], 1u); break; } }
    }
    nloc = mine > 0u ? mine : 1u; nx = cnt > 0u ? cnt : 1u;
}
__device__ __forceinline__ void xcd_barrier(const XcdBarrier& b) {
    asm volatile("s_waitcnt vmcnt(0)" ::: "memory");
    __syncthreads();
    if (threadIdx.x == 0) {
        gu32* bar = b.bar;
        __builtin_amdgcn_s_waitcnt(0);
        unsigned nloc = b.st[0], nx = b.st[1];
        if (nloc == 0u) { xcd_barrier_complete(bar, b.x, nloc, nx); b.st[0] = nloc; b.st[1] = nx; }
        const unsigned old = xb_add(&bar[XB_XSUB(b.x)], 1u);
        const unsigned gen = old / nloc;
        if (old + 1u == (gen + 1u) * nloc) {
            __builtin_amdgcn_fence(__ATOMIC_RELEASE, "agent");
            asm volatile("s_waitcnt vmcnt(0)" ::: "memory");
            const unsigned og = xb_add(&bar[XB_TOP], 1u);
            const unsigned tg = og / nx;
            if (og + 1u == (tg + 1u) * nx) xb_add(&bar[XB_TOPGEN], 1u);
            else XB_SPIN(xb_ld(&bar[XB_TOPGEN]) == tg, bar);
            __builtin_amdgcn_fence(__ATOMIC_ACQUIRE, "agent");
            xb_add(&bar[XB_XGEN(b.x)], 1u);
            asm volatile("s_waitcnt vmcnt(0)" ::: "memory");
        } else {
            XB_SPIN(xb_ld(&bar[XB_XGEN(b.x)]) == gen, bar);
            __builtin_amdgcn_fence(__ATOMIC_ACQUIRE, "agent");
            asm volatile("s_waitcnt vmcnt(0)" ::: "memory");
        }
    }
    __syncthreads();
}

struct Args { const void* in[22]; float* out; unsigned char* ws; int ph_lo, ph_hi, use_bar, pad; };
struct ArgsD { const GAS void* in[22]; GAS float* out; GAS unsigned char* ws; int ph_lo, ph_hi, use_bar, pad; };
static_assert(sizeof(ArgsD) == sizeof(Args), "ArgsD");
typedef const __attribute__((address_space(4))) ArgsD* KArgs;
__device__ __forceinline__ KArgs kargs() { KArgs p = (KArgs)__builtin_amdgcn_kernarg_segment_ptr(); asm volatile("" : "+s"(p)); return p; }
struct Frame {
    LAS unsigned char* lds;
    int vcu, G, wave;
};
#define PH_IDX() int lane_; asm volatile("v_mbcnt_lo_u32_b32 %0, -1, 0\n\tv_mbcnt_hi_u32_b32 %0, -1, %0" : "=v"(lane_)); const int lane = lane_, wave = F.wave, tid = wave * 64 + lane; (void)tid; (void)lane; (void)wave
__device__ __forceinline__ float shx(float v, int lane, int o) { return __builtin_bit_cast(float, __builtin_amdgcn_ds_bpermute((lane ^ o) << 2, __builtin_bit_cast(int, v))); }
__device__ __forceinline__ float wave_sum(float v, int lane) {
#pragma unroll
    for (int o = 1; o < 64; o <<= 1) v += shx(v, lane, o);
    return v;
}

template <bool GAIN>
__device__ __forceinline__ void xpose_item(const float* W, int K, int N, bf16* WT, int k0, int n0, int drow0, LAS float* scr, int lane, const float* gk) {
    float gl = 1.0f, gh = 1.0f; if constexpr (GAIN) { gl = gk[k0 + (lane & 31)]; gh = gk[k0 + 32 + (lane & 31)]; }
    float w[32];
    const GAS float* src = (const GAS float*)W + (size_t)(k0 + (lane >> 5)) * N + n0 + (lane & 31);
#pragma unroll
    for (int i = 0; i < 32; ++i) w[i] = __builtin_nontemporal_load(src + (size_t)(2 * i) * N);
#pragma unroll
    for (int i = 0; i < 32; ++i) { const int kk = 2 * i + (lane >> 5); float v = w[i];
        if constexpr (GAIN) { const float gsel = (i >= 16) ? gh : gl; v *= __builtin_bit_cast(float, __builtin_amdgcn_ds_bpermute((kk & 31) << 2, __builtin_bit_cast(int, gsel))); }
        scr[kk * 33 + (lane & 31)] = v; }
    LDS_WAIT(); asm volatile("" ::: "memory");
    const int c = lane & 7;
#pragma unroll
    for (int j = 0; j < 4; ++j) { const int n = (lane >> 3) + 8 * j; const LAS float* s = scr + (8 * c) * 33 + n;
        v4u o; o.x = pk2(s[0 * 33], s[1 * 33]); o.y = pk2(s[2 * 33], s[3 * 33]); o.z = pk2(s[4 * 33], s[5 * 33]); o.w = pk2(s[6 * 33], s[7 * 33]);
        __builtin_nontemporal_store(o, (GAS v4u*)(WT + (size_t)(drow0 + n) * K + k0 + 8 * c)); }
    LDS_WAIT(); asm volatile("" ::: "memory");
}
constexpr int IT_WIN1 = 32 * 122, IT_WQB1 = 8 * 48, IT_WKVB1 = 4 * 64, IT_WOUT1 = 32 * 64, IT_GU1 = 32 * 176, IT_D1 = 88 * 64;
constexpr int IT_EARLY = IT_WIN1 + IT_WQB1 + IT_WKVB1;
constexpr int IT_LATE = IT_WIN1 + IT_WQB1 + IT_WKVB1 + 2 * IT_WOUT1 + 2 * IT_GU1 + IT_D1 + 16 * IT_GU1 + 8 * IT_D1, IT_TOTAL = IT_EARLY + IT_LATE;
static_assert(IT_LATE % 2 == 0, "late items split in two halves");
__device__ __forceinline__ void conv_item(KArgs a, int it, LAS float* scr, int lane) {
    unsigned char* ws = (unsigned char*)a->ws;
    const float* W; bf16* WT; int K, N, kb, nb, drow0; const float* gk = nullptr;
    int l = 0; if (it >= IT_EARLY) { it -= IT_EARLY; l = 1; }
    if (it < IT_WIN1) { const int r = it; kb = r / 122; nb = r % 122; K = DM; N = INC; W = (const float*)a->in[4] + (size_t)l * DM * INC; WT = (bf16*)(ws + WS_WIN) + (size_t)l * INP * DM; drow0 = 32 * nb; gk = (const float*)a->in[3] + l * DM; }
    else if ((it -= IT_WIN1) < IT_WQB1) { const int r = it; kb = r / 48; nb = r % 48; K = QLORA; N = NQB_; W = (const float*)a->in[7] + (size_t)l * QLORA * NQB_; WT = (bf16*)(ws + WS_WQB) + (size_t)l * NQB_ * QLORA; drow0 = 32 * nb; gk = (const float*)a->in[5] + l * QLORA; }
    else if ((it -= IT_WQB1) < IT_WKVB1) { const int r = it; kb = r / 64; nb = r % 64; K = KVLORA; N = NKVB; W = (const float*)a->in[8] + (size_t)l * KVLORA * NKVB; WT = (bf16*)(ws + WS_WKVB) + (size_t)l * NKVB * KVLORA; drow0 = 32 * nb; }
    else if ((it -= IT_WKVB1) < 2 * IT_WOUT1) { const int lo = it / IT_WOUT1, r = it % IT_WOUT1; kb = r / 64; nb = r % 64; K = DM; N = DM; W = (const float*)a->in[13] + (size_t)lo * DM * DM; WT = (bf16*)(ws + WS_WOUT) + (size_t)lo * DM * DM; drow0 = 32 * nb; }
    else if ((it -= 2 * IT_WOUT1) < 2 * IT_GU1) { const int isup = it / IT_GU1, r = it % IT_GU1; kb = r / 176; nb = r % 176; K = DM; N = FF;
        W = isup ? (const float*)a->in[16] : (const float*)a->in[15]; WT = (bf16*)(ws + WS_WGU);
        const int n0 = 32 * nb; drow0 = 256 * (n0 >> 7) + (n0 & 127) + (isup ? 128 : 0); gk = (const float*)a->in[14]; }
    else if ((it -= 2 * IT_GU1) < IT_D1) { const int r = it; kb = r / 64; nb = r % 64; K = FF; N = DM; W = (const float*)a->in[17]; WT = (bf16*)(ws + WS_WD); drow0 = 32 * nb; }
    else if ((it -= IT_D1) < 16 * IT_GU1) { const int m = it / IT_GU1, r = it % IT_GU1; kb = r / 176; nb = r % 176; const int isup = m >> 3, e = m & 7; K = DM; N = FF;
        W = (isup ? (const float*)a->in[20] : (const float*)a->in[19]) + (size_t)e * DM * FF; WT = (bf16*)(ws + WS_WGUE) + (size_t)e * NGU * DM;
        const int n0 = 32 * nb; drow0 = 256 * (n0 >> 7) + (n0 & 127) + (isup ? 128 : 0); }
    else { it -= 16 * IT_GU1; const int e = it / IT_D1, r = it % IT_D1; kb = r / 64; nb = r % 64; K = FF; N = DM;
        W = (const float*)a->in[21] + (size_t)e * FF * DM; WT = (bf16*)(ws + WS_WDE) + (size_t)e * DM * FF; drow0 = 32 * nb; }
    if (gk) xpose_item<true>(W, K, N, WT, 64 * kb, 32 * nb, drow0, scr, lane, gk); else xpose_item<false>(W, K, N, WT, 64 * kb, 32 * nb, drow0, scr, lane, gk);
}
__device__ __forceinline__ void late_convert(Frame& F, KArgs a, int part) {
    PH_IDX();
    LAS float* scr = (LAS float*)(F.lds + RING_OFF + wave * 16384);
    const int bx = (int)blockIdx.x, cgw = ((bx >> 3) * 4 + (bx & 3)) * NWAVES + wave, CNGW = (F.G / 2) * NWAVES;
    for (int it = IT_EARLY + part * (IT_LATE / 2) + cgw; it < IT_EARLY + (part + 1) * (IT_LATE / 2); it += CNGW) conv_item(a, it, scr, lane);
}
__device__ __forceinline__ void p0_prologue(Frame& F, KArgs a) {
    PH_IDX();
    unsigned char* ws = (unsigned char*)a->ws;
    LAS float* scr = (LAS float*)(F.lds + RING_OFF + wave * 16384);
    const int gw = F.vcu * NWAVES + wave, NGW = F.G * NWAVES;
    const int it_end = (F.G % 8 == 0) ? IT_EARLY : IT_TOTAL;
    for (int it0 = gw; it0 < it_end; it0 += NGW) conv_item(a, it0, scr, lane);
    for (int r = gw; r < 2 * (INP - INC); r += NGW) { const int l = r / (INP - INC), rr = INC + r % (INP - INC);
        GAS v4u* p = (GAS v4u*)((bf16*)(ws + WS_WIN) + ((size_t)l * INP + rr) * DM) + lane;
#pragma unroll
        for (int j = 0; j < 4; ++j) p[64 * j] = (v4u){0u, 0u, 0u, 0u}; }
    { const float* x = (const float*)a->in[0]; bf16* H = (bf16*)(ws + WS_H); float* ssq0 = (float*)(ws + WS_SSQ0);
      for (int m = gw; m < S_; m += NGW) { const GAS f32x4* xr = (const GAS f32x4*)(x + (size_t)m * DM) + lane; GAS v2u* o8 = (GAS v2u*)(H + (size_t)m * DM) + lane; float ss = 0.f;
          f32x4 v[8];
#pragma unroll
          for (int j = 0; j < 8; ++j) v[j] = __builtin_nontemporal_load(xr + 64 * j);
#pragma unroll
          for (int j = 0; j < 8; ++j) { ss += (v[j].x * v[j].x + v[j].y * v[j].y) + (v[j].z * v[j].z + v[j].w * v[j].w); o8[64 * j] = (v2u){pk2(v[j].x, v[j].y), pk2(v[j].z, v[j].w)}; }
          ss = wave_sum(ss, lane); if (lane == 0) ssq0[m] = ss; } }
    { const float* rb = (const float*)a->in[2]; float* tbl = (float*)(ws + WS_TBL);
      for (int i = gw * 64 + lane; i < 2 * NH * att::TBL_N; i += NGW * 64) {
          const int pass = i / (NH * att::TBL_N), ii = i % (NH * att::TBL_N), h = ii / att::TBL_N, u = ii % att::TBL_N, st = att::TBL_U0 - u; float v = -__builtin_inff();
          int dl = -1, mu = 0;
          if (pass == 0) { if (st >= 0 && st <= 512) { dl = st; mu = (dl <= 128 ? 1 : 0) + (((dl & 3) == 0) ? 1 : 0) + (((dl & 15) == 0) ? 1 : 0); } }
          else { if (st >= 33 && st <= 128) { dl = 16 * st; mu = 1; } }
          if (mu > 0) { int bk; if (dl < 16) bk = dl; else { bk = 16 + (int)(logf((float)dl * 0.0625f) / 4.852030263919617f * 16.0f); if (bk > 31) bk = 31; }
              v = (rb[bk * NH + h] + logf((float)mu)) * 11.313708498984761f; }
          tbl[i] = v; } }
}

template <bool ROUTE, bool XB = false>
__device__ __forceinline__ void norm_rows(Frame& F, const float* x, const float* g, bf16* H, KArgs a, bool dry = false) {
    PH_IDX();
    const int gw = F.vcu * NWAVES + wave, NGW = F.G * NWAVES;
    LAS float* wr_l = (LAS float*)(F.lds + RING_OFF);
    if constexpr (ROUTE) {
        const float* wrt = (const float*)a->in[18];
        for (int i0 = tid; i0 < DM * NEXP; i0 += 8 * NWAVES * 64) { float t[8];
#pragma unroll
            for (int q = 0; q < 8; ++q) t[q] = wrt[i0 + q * NWAVES * 64];
#pragma unroll
            for (int q = 0; q < 8; ++q) { const int i = i0 + q * NWAVES * 64, k = i >> 3, e = i & 7; wr_l[e * DM + k] = t[q]; } }
        LDS_WAIT(); __syncthreads();
    }
    f32x4 gv[8];
#pragma unroll
    for (int j = 0; j < 8; ++j) gv[j] = ((const GAS f32x4*)g)[lane + 64 * j];
    LAS unsigned* lcnt = (LAS unsigned*)(F.lds + RING_OFF + 65536); LAS unsigned* lbase = lcnt + 8; LAS int* rec = (LAS int*)(F.lds + RING_OFF + 65536 + 256);
    const int NIT = (S_ + NGW - 1) / NGW;
    for (int c0 = 0; c0 < NIT; c0 += 8) {
        const int c1 = c0 + 8 < NIT ? c0 + 8 : NIT;
        if constexpr (ROUTE) { if (tid < 8) lcnt[tid] = 0u; LDS_WAIT(); __syncthreads(); }
        v2u raw[8];
        for (int ci = c0; ci < c1; ++ci) {
            const int m = gw + ci * NGW;
            if (m >= S_) { if constexpr (ROUTE) { if (lane == 0) rec[(wave * 8 + (ci - c0)) * 8] = -1; } continue; }
            f32x4 v[8]; float ss = 0.f;
            if constexpr (XB) {
                if (ci == c0) { const GAS v2u* xr = (const GAS v2u*)((const bf16*)x + (size_t)m * DM) + lane;
#pragma unroll
                    for (int j = 0; j < 8; ++j) raw[j] = xr[64 * j]; }
#pragma unroll
                for (int j = 0; j < 8; ++j) { const v2u w = raw[j]; v[j] = (f32x4){bflo(w.x), bfhi(w.x), bflo(w.y), bfhi(w.y)}; }
            } else { const GAS f32x4* xr = (const GAS f32x4*)(x + (size_t)m * DM) + lane;
#pragma unroll
                for (int j = 0; j < 8; ++j) v[j] = xr[64 * j]; }
#pragma unroll
            for (int j = 0; j < 8; ++j) ss += (v[j].x * v[j].x + v[j].y * v[j].y) + (v[j].z * v[j].z + v[j].w * v[j].w);
            const float rstd = 1.0f / sqrtf(wave_sum(ss, lane) * (1.0f / DM) + EPS);
#pragma unroll
            for (int j = 0; j < 8; ++j) v[j] = v[j] * rstd * gv[j];
            GAS v2u* o8 = (GAS v2u*)(H + (size_t)m * DM) + lane;
#pragma unroll
            for (int j = 0; j < 8; ++j) o8[64 * j] = (v2u){pk2(v[j].x, v[j].y), pk2(v[j].z, v[j].w)};
            if constexpr (XB) { const int mn = m + NGW; if (ci + 1 < c1 && mn < S_) { const GAS v2u* xn = (const GAS v2u*)((const bf16*)x + (size_t)mn * DM) + lane;
#pragma unroll
                for (int j = 0; j < 8; ++j) raw[j] = xn[64 * j]; } }
            if constexpr (ROUTE) {
                float sd[8];
#pragma unroll
                for (int e = 0; e < 8; ++e) { float t = 0.f;
#pragma unroll
                    for (int j = 0; j < 8; ++j) { const f32x4 w = *(const LAS f32x4*)(wr_l + e * DM + 4 * (lane + 64 * j)); t += (v[j].x * w.x + v[j].y * w.y) + (v[j].z * w.z + v[j].w * w.w); }
                    sd[e] = t; }
                float ra[4], rb[2], rc;
#pragma unroll
                for (int i = 0; i < 4; ++i) { const bool up = (lane & 1) != 0; ra[i] = (up ? sd[4 + i] : sd[i]) + shx(up ? sd[i] : sd[4 + i], lane, 1); }
#pragma unroll
                for (int i = 0; i < 2; ++i) { const bool up = (lane & 2) != 0; rb[i] = (up ? ra[2 + i] : ra[i]) + shx(up ? ra[i] : ra[2 + i], lane, 2); }
                { const bool up = (lane & 4) != 0; rc = (up ? rb[1] : rb[0]) + shx(up ? rb[0] : rb[1], lane, 4); }
                rc += shx(rc, lane, 8); rc += shx(rc, lane, 16); rc += shx(rc, lane, 32);
                float v0 = -__builtin_inff(), v1 = -__builtin_inff(); int e0 = 0, e1 = 0;
#pragma unroll
                for (int e = 0; e < 8; ++e) { constexpr int BR[8] = {0, 4, 2, 6, 1, 5, 3, 7};
                    const float sv = __builtin_bit_cast(float, __builtin_amdgcn_readlane(__builtin_bit_cast(int, rc), BR[e]));
                    if (sv > v0) { v1 = v0; e1 = e0; v0 = sv; e0 = e; } else if (sv > v1) { v1 = sv; e1 = e; } }
                const float g0 = 1.0f / (1.0f + expf(v1 - v0)), g1 = 1.0f - g0;
                if (lane == 0) {
                    const unsigned o0 = __hip_atomic_fetch_add(lcnt + e0, 1u, __ATOMIC_RELAXED, __HIP_MEMORY_SCOPE_WORKGROUP), o1 = __hip_atomic_fetch_add(lcnt + e1, 1u, __ATOMIC_RELAXED, __HIP_MEMORY_SCOPE_WORKGROUP);
                    LAS int* r = rec + (wave * 8 + (ci - c0)) * 8;
                    r[0] = m; r[1] = e0; r[2] = e1; r[3] = __builtin_bit_cast(int, g0); r[4] = __builtin_bit_cast(int, g1); r[5] = (int)o0; r[6] = (int)o1; }
            }
        }
        if constexpr (ROUTE) {
            LDS_WAIT(); __syncthreads();
            if (tid < 8) { const unsigned c = lcnt[tid]; unsigned b = 0u; if (c && !dry) b = xb_add((gu32*)(a->ws + WS_CTL) + CW_CNT + tid * pg8::CNT_STRIDE, c); lbase[tid] = b; }
            LDS_WAIT(); __syncthreads();
            if (lane < c1 - c0 && !dry) { const LAS int* r = rec + (wave * 8 + lane) * 8; const int m = r[0];
                if (m >= 0) { const int e0 = r[1], e1 = r[2]; const int s0 = (int)lbase[e0] + r[5], s1 = (int)lbase[e1] + r[6];
                    int* ltok = (int*)(a->ws + WS_LTOK); float* lgate = (float*)(a->ws + WS_LGATE);
                    ltok[(size_t)e0 * S_ + s0] = m; lgate[(size_t)e0 * S_ + s0] = __builtin_bit_cast(float, r[3]);
                    ltok[(size_t)e1 * S_ + s1] = m; lgate[(size_t)e1 * S_ + s1] = __builtin_bit_cast(float, r[4]);
                    ((int4*)(a->ws + WS_POS))[m] = make_int4(e0, s0, e1, s1); } }
        }
    }
}

__device__ __forceinline__ void unpack8(const v4u w, float (&f)[8]) { f[0] = bflo(w.x); f[1] = bfhi(w.x); f[2] = bflo(w.y); f[3] = bfhi(w.y); f[4] = bflo(w.z); f[5] = bfhi(w.z); f[6] = bflo(w.w); f[7] = bfhi(w.w); }
__device__ __forceinline__ v4u pack8s(const float (&f)[8], float s, const float (&g)[8]) {
    v4u o; o.x = pk2(f[0] * s * g[0], f[1] * s * g[1]); o.y = pk2(f[2] * s * g[2], f[3] * s * g[3]); o.z = pk2(f[4] * s * g[4], f[5] * s * g[5]); o.w = pk2(f[6] * s * g[6], f[7] * s * g[7]); return o; }
__device__ __forceinline__ float ssq8(const float (&f)[8]) { return ((f[0] * f[0] + f[1] * f[1]) + (f[2] * f[2] + f[3] * f[3])) + ((f[4] * f[4] + f[5] * f[5]) + (f[6] * f[6] + f[7] * f[7])); }
__device__ __forceinline__ void prep2(Frame& F, KArgs a, int l, bool dry = false) {
    PH_IDX();
    const int gw = F.vcu * NWAVES + wave, NGW = F.G * NWAVES, h = lane >> 3, sub = lane & 7;
    bf16* PROJ = (bf16*)(a->ws + WS_PROJ); bf16* QM = (bf16*)(a->ws + WS_QM); bf16* KVM = (bf16*)(a->ws + WS_KVM); bf16* KM = (bf16*)(a->ws + WS_KM);
    const int* pos = (const int*)a->in[1];
    const float* gq = (const float*)a->in[11] + l * QKB; const float* gk = (const float*)a->in[12] + l * QKB;
    float g_q[3][8], g_k[3][8], inv[8];
#pragma unroll
    for (int i = 0; i < 3; ++i)
#pragma unroll
        for (int j = 0; j < 8; ++j) { g_q[i][j] = gq[64 * i + 8 * sub + j]; g_k[i][j] = gk[64 * i + 8 * sub + j]; }
#pragma unroll
    for (int j = 0; j < 8; ++j) inv[j] = powf(10000.0f, -(float)((sub & 3) * 8 + j) * (1.0f / 32.0f));
    for (int m = gw; m < S_; m += NGW) {
        const float p = (float)pos[m];
        float cs[8], sn[8];
#pragma unroll
        for (int j = 0; j < 8; ++j) { const float ang = p * inv[j]; sincosf(ang, &sn[j], &cs[j]); }
        const GAS v4u* qrow = (const GAS v4u*)(QM + (size_t)m * NQB_ + h * QKB);
        const GAS v4u* krow = (const GAS v4u*)(KVM + (size_t)m * NKVB + h * 256);
        const GAS v4u* rrow = (const GAS v4u*)(PROJ + (size_t)m * INP + C_KR);
        float fq[3][8], fk[3][8];
#pragma unroll
        for (int i = 0; i < 3; ++i) unpack8(qrow[sub + 8 * i], fq[i]);
        unpack8(krow[sub], fk[0]); unpack8(krow[8 + sub], fk[1]); unpack8(rrow[sub], fk[2]);
        float sq = ssq8(fq[0]) + ssq8(fq[1]) + ssq8(fq[2]), sk = ssq8(fk[0]) + ssq8(fk[1]) + ssq8(fk[2]);
#pragma unroll
        for (int o = 1; o < 8; o <<= 1) { sq += shx(sq, lane, o); sk += shx(sk, lane, o); }
        const float rq = 1.0f / sqrtf(sq * (1.0f / QKB) + EPS), rk = 1.0f / sqrtf(sk * (1.0f / QKB) + EPS);
        float nq[8], nk[8];
#pragma unroll
        for (int j = 0; j < 8; ++j) { nq[j] = fq[2][j] * rq * g_q[2][j]; nk[j] = fk[2][j] * rk * g_k[2][j]; }
        float oq[8], ok[8];
#pragma unroll
        for (int j = 0; j < 8; ++j) { const float pq = shx(nq[j], lane, 4), pk = shx(nk[j], lane, 4);
            oq[j] = (sub < 4) ? (nq[j] * cs[j] - pq * sn[j]) : (pq * sn[j] + nq[j] * cs[j]);
            ok[j] = (sub < 4) ? (nk[j] * cs[j] - pk * sn[j]) : (pk * sn[j] + nk[j] * cs[j]); }
        const float one[8] = {1.f, 1.f, 1.f, 1.f, 1.f, 1.f, 1.f, 1.f};
        const size_t dofs = dry ? (size_t)(400 * MiB) / 2 : 0; GAS v4u* qo = (GAS v4u*)(QM + dofs + (size_t)m * NQB_ + h * QKB); GAS v4u* ko = (GAS v4u*)(KM + dofs + (size_t)m * NQB_ + h * QKB);
        qo[sub] = pack8s(fq[0], rq, g_q[0]); qo[8 + sub] = pack8s(fq[1], rq, g_q[1]); qo[16 + sub] = pack8s(oq, 1.0f, one);
        ko[sub] = pack8s(fk[0], rk, g_k[0]); ko[8 + sub] = pack8s(fk[1], rk, g_k[1]); ko[16 + sub] = pack8s(ok, 1.0f, one);
    }
}
__device__ __forceinline__ void att_merge(Frame& F, KArgs a) {
    PH_IDX();
    const int gw = F.vcu * NWAVES + wave, NGW = F.G * NWAVES;
    const bf16* OA = (const bf16*)(a->ws + WS_OA); const bf16* OB = (const bf16*)(a->ws + WS_OB); const float* LA = (const float*)(a->ws + WS_LSEA); const float* LB = (const float*)(a->ws + WS_LSEB);
    bf16* ATT = (bf16*)(a->ws + WS_ATT);
    for (int m = gw; m < S_; m += NGW) {
        const GAS v4u* pa = (const GAS v4u*)(OA + (size_t)m * WA) + 2 * lane; const GAS v4u* pb = (const GAS v4u*)(OB + (size_t)m * WA) + 2 * lane;
        const float la = LA[(size_t)m * NH + (lane >> 3)], lb = LB[(size_t)m * NH + (lane >> 3)];
        const v4u qa[2] = {pa[0], pa[1]}, qb[2] = {pb[0], pb[1]};
        const float wb = 1.0f / (1.0f + expf(la - lb)), wa = 1.0f - wb;
        GAS v4u* po = (GAS v4u*)(ATT + (size_t)m * DM) + 2 * lane;
#pragma unroll
        for (int j = 0; j < 2; ++j) { float fa[8], fb[8]; unpack8(qa[j], fa); unpack8(qb[j], fb);
            v4u o; o.x = pk2(wa * fa[0] + wb * fb[0], wa * fa[1] + wb * fb[1]); o.y = pk2(wa * fa[2] + wb * fb[2], wa * fa[3] + wb * fb[3]);
            o.z = pk2(wa * fa[4] + wb * fb[4], wa * fa[5] + wb * fb[5]); o.w = pk2(wa * fa[6] + wb * fb[6], wa * fa[7] + wb * fb[7]); po[j] = o; }
    }
}
__device__ __forceinline__ void moe_tail_reduce(Frame& F, KArgs a, int T, int pm, int pnl) {
    PH_IDX();
    const int bx = (int)blockIdx.x; if (bx >= 4 * T) return;
    const int tu = bx >> 2, q = bx & 3;
    const bf16* P = (const bf16*)(a->ws + WS_PT) + (size_t)tu * 4 * 65536; bf16* Y = (bf16*)(a->ws + WS_Y);
    for (int rr = wave; rr < 64; rr += NWAVES) { const int r = 64 * q + rr;
        float s0 = 0.f, s1 = 0.f, s2 = 0.f, s3 = 0.f;
#pragma unroll
        for (int k = 0; k < 4; ++k) { const v2u w = *((const GAS v2u*)(P + (size_t)k * 65536 + (size_t)r * 256) + lane); s0 += bflo(w.x); s1 += bfhi(w.x); s2 += bflo(w.y); s3 += bfhi(w.y); }
        *((GAS v2u*)(Y + (size_t)(pm * 256 + r) * DM + pnl * 256) + lane) = (v2u){pk2(s0, s1), pk2(s2, s3)}; }
}
__device__ __forceinline__ void moe_tiles(KArgs a, int (&tb)[9]) {
    gu32* cnt = (gu32*)(a->ws + WS_CTL) + CW_CNT; int acc = 0;
    int lane_; asm volatile("v_mbcnt_lo_u32_b32 %0, -1, 0\n\tv_mbcnt_hi_u32_b32 %0, -1, %0" : "=v"(lane_));
    const int cv = (int)__hip_atomic_load(cnt + (lane_ & 7) * pg8::CNT_STRIDE, RLX_AGENT);
#pragma unroll
    for (int e = 0; e < 8; ++e) { tb[e] = acc; acc += (__builtin_amdgcn_readlane(cv, e) + 255) >> 8; }
    tb[8] = acc;
}
__device__ __forceinline__ void moe_combine(Frame& F, KArgs a, bool dry = false) {
    PH_IDX();
    const int gw = F.vcu * NWAVES + wave, NGW = F.G * NWAVES;
    int tb[9]; moe_tiles(a, tb);
    const bf16* Y = (const bf16*)(a->ws + WS_Y); const bf16* X3 = (const bf16*)(a->ws + WS_H); float* out = (float*)a->out; float* outw = dry ? (float*)(a->ws + WS_PROJ) : out;
    typedef int v4i __attribute__((ext_vector_type(4)));
    const GAS v4i* posr = (const GAS v4i*)(a->ws + WS_POS);
    v4i ps = posr[gw < S_ ? gw : 0];
    for (int m = gw; m < S_; m += NGW) {
        int b0 = 0, b1 = 0;
#pragma unroll
        for (int e = 0; e < 8; ++e) { b0 = (ps.x == e) ? tb[e] : b0; b1 = (ps.z == e) ? tb[e] : b1; }
        const GAS v2u* y0 = (const GAS v2u*)(Y + (size_t)(b0 * 256 + ps.y) * DM) + lane; const GAS v2u* y1 = (const GAS v2u*)(Y + (size_t)(b1 * 256 + ps.w) * DM) + lane;
        const GAS v2u* xr = (const GAS v2u*)(X3 + (size_t)m * DM) + lane; GAS f32x4* xw = (GAS f32x4*)(outw + (size_t)m * DM) + lane;
        v2u w0[8], w1[8], wx[8];
#pragma unroll
        for (int j = 0; j < 8; ++j) { w0[j] = y0[64 * j]; w1[j] = y1[64 * j]; wx[j] = xr[64 * j]; }
        { const int mn = m + NGW; ps = posr[mn < S_ ? mn : m]; }
#pragma unroll
        for (int j = 0; j < 8; ++j) { f32x4 v;
            v.x = bflo(wx[j].x) + (bflo(w0[j].x) + bflo(w1[j].x)); v.y = bfhi(wx[j].x) + (bfhi(w0[j].x) + bfhi(w1[j].x)); v.z = bflo(wx[j].y) + (bflo(w0[j].y) + bflo(w1[j].y)); v.w = bfhi(wx[j].y) + (bfhi(w0[j].y) + bfhi(w1[j].y));
            __builtin_nontemporal_store(v, xw + 64 * j); }
    }
}
#ifndef MK_PER_PHASE
#define MK_PER_PHASE 0
#endif
#ifndef DBG_STOP
#define DBG_STOP 23
#endif
#ifndef DUP_MASK
#define DUP_MASK 0u
#endif
constexpr int NPH = 20;
#undef DBG_STOP
#define DBG_STOP NPH

using CfgM = att::Cfg<192, NQB_, NQB_, NKVB, DM, false>;
using CfgA = att::Cfg<128, INP, INP, INP, WA, true, NH, 0>;
using CfgB = att::Cfg<128, 16 * INP, 16 * INP, 16 * INP, 16 * WA, true, 16 * NH, 33>;
constexpr int W_DILA = 513, W_DILB = 129;

__global__ void __launch_bounds__(NWAVES * 64, 2) mega_fwd(Args a_byval) {
    extern __shared__ __attribute__((aligned(16))) unsigned char lds[];
#ifdef PAD_NOPS
    asm volatile(".rept " PAD_NOPS "\n\ts_nop 0\n\t.endr");
#endif
    Frame F;
    F.lds = (LAS unsigned char*)lds;
    F.wave = __builtin_amdgcn_readfirstlane((int)threadIdx.x >> 6); asm volatile("" : "+s"(F.wave));
    F.G = gridDim.x; { const int bx = blockIdx.x; F.vcu = (F.G % 8 == 0) ? (bx % 8) * (F.G / 8) + bx / 8 : bx; }
    const int lo = a_byval.ph_lo, hi = a_byval.ph_hi, use_bar = a_byval.use_bar;
    GAS unsigned char* const ws0 = kargs()->ws;
    volatile LAS unsigned* MISC = (volatile LAS unsigned*)(F.lds + MISC_OFF);
    for (int u = threadIdx.x; u < (LDS_BYTES - LDSCTL_OFF) / 4; u += NWAVES * 64) ((LAS unsigned*)(F.lds + LDSCTL_OFF))[u] = 0u;
    __syncthreads();
    XcdBarrier bar; bar.bar = (gu32*)(ws0 + WS_CTL) + CW_BAR; bar.x = 0; bar.st = nullptr;
    if (use_bar) bar = xcd_barrier_post((gu32*)(ws0 + WS_CTL) + CW_BAR, MISC + 8);
#define IN(k) (lo <= (k) && (k) < hi)
#define REPS(k) (((DUP_MASK >> (k)) & 1u) ? 2 : 1)
#ifndef DUP_BAR
#define DUP_BAR 0
#endif
#define DUP(k) for (int rp_ = 0; rp_ < REPS(k); (DUP_BAR && use_bar && rp_ == 0 && REPS(k) > 1) ? (xcd_barrier(bar), 0) : 0, ++rp_)
#ifndef INPROJ_WGM
#define INPROJ_WGM 8
#endif
#ifndef GU_WGM
#define GU_WGM 8
#endif
#ifndef OUT_WGM
#define OUT_WGM 8
#endif
#ifndef MOE_GU_WGM
#define MOE_GU_WGM 8
#endif
#ifndef DOWN_REV
#define DOWN_REV 1
#endif
#ifndef DOWN_WGM
#define DOWN_WGM 4
#endif
#ifndef PROBE_EPI
#define PROBE_EPI 0
#endif
#ifndef SEAM_REPS
#define SEAM_REPS 1
#endif
#define SEAM(k) do { if (use_bar && IN(k) && IN((k) + 1)) { for (int sr_ = 0; sr_ < SEAM_REPS; ++sr_) { XcdBarrier b_ = bar; asm volatile("" : "+s"(b_.bar)); xcd_barrier(b_); } } } while (0)
    LAS unsigned char* const ring = F.lds + RING_OFF;
    LAS float* const xlds = (LAS float*)(F.lds + XLDS_OFF);

    if (IN(0)) { DUP(0) p0_prologue(F, kargs()); SEAM(0); }

    for (int l = 0; l < NLAYER; ++l) {
        const int pb = l ? 9 : 1;
        int bx = (int)blockIdx.x, G_ = F.G; asm volatile("" : "+s"(bx), "+s"(G_));
        const KArgs a = kargs(); GAS unsigned char* ws = a->ws; asm volatile("" : "+s"(ws));
        bf16* const H = (bf16*)(ws + WS_H); bf16* const PROJ = (bf16*)(ws + WS_PROJ); bf16* const QM = (bf16*)(ws + WS_QM); bf16* const KVM = (bf16*)(ws + WS_KVM);
        bf16* const KM = (bf16*)(ws + WS_KM); bf16* const ATT = (bf16*)(ws + WS_ATT);
        bf16* const ACT = (bf16*)(ws + WS_ACT); bf16* const Y = (bf16*)(ws + WS_Y);
        float* const ssq0 = (float*)(ws + WS_SSQ0); float* const ssqx = (float*)(ws + WS_SSQX); float* const ssqc = (float*)(ws + WS_SSQC) + (size_t)l * S_ * 2;
        if (IN(pb + 0)) { DUP(pb + 0) {
            pg8::Gemm g{H, (const bf16*)(ws + WS_WIN) + (size_t)l * INP * DM, DM, DM}; pg8::TileOrder O; O.init(S_ / 256, INP / 256, G_, bx, INPROJ_WGM);
            pg8::EpiInProj E{PROJ, INP, l ? ssqx + (size_t)S_ * 8 : ssq0, l ? 8 : 1, (const float*)a->in[9] + l * HD, (const float*)a->in[10] + l * HD, (const float*)a->in[6] + l * KVLORA, ssqc, EPS};
            pg8::gemm_phase<pg8::EpiInProj, pg8::TileOrder, false>(ring, g, O, E, F.wave, xlds); }
            SEAM(pb + 0);
        }
        if (IN(pb + 1)) { DUP(pb + 1) {
            { pg8::Gemm g{PROJ + C_CQ, (const bf16*)(ws + WS_WQB) + (size_t)l * NQB_ * QLORA, QLORA, INP}; pg8::TileOrder O; O.init(S_ / 256, NQB_ / 256, G_, bx);
              pg8::EpiBf16 E{QM, NQB_, ssqc, 2, 1.0f / QLORA, EPS}; pg8::gemm_phase<pg8::EpiBf16, pg8::TileOrder, false>(ring, g, O, E, F.wave, xlds); }
            { pg8::Gemm g{PROJ + C_CKV, (const bf16*)(ws + WS_WKVB) + (size_t)l * NKVB * KVLORA, KVLORA, INP}; pg8::TileOrder O; O.init(S_ / 256, NKVB / 256, G_, bx);
              pg8::EpiBf16 E{KVM, NKVB, nullptr, 0, 0.f, 0.f}; pg8::gemm_phase<pg8::EpiBf16, pg8::TileOrder, false>(ring, g, O, E, F.wave, xlds); } }
            SEAM(pb + 1);
        }
        if (IN(pb + 2)) { if (REPS(pb + 2) > 1) prep2(F, a, l, true); prep2(F, a, l); SEAM(pb + 2); }
        if (IN(pb + 3)) { DUP(pb + 3) {
            att::lptr albs = (att::lptr)ring;
            const bool host = (l == 0) && (G_ % 8 == 0) && rp_ == 0;
            if (host && (bx & 4) == 0) { late_convert(F, a, 0); __syncthreads(); }
            if (F.wave >= 4) __builtin_amdgcn_s_setprio(1);
            {   att::Seam<CfgM> Sm;
                for (int it = bx; it < 256; it += G_) {
                    const int h = it & 7, x = it >> 3;
                    att::BlockRef b0, b1;
                    b0.P0 = (63 - x) * 256; b1.P0 = x * 256;
                    b0.K = b1.K = KM + h * QKB; b0.V = b1.V = KVM + h * 256 + 128;
                    b0.Q = QM + (size_t)b0.P0 * NQB_ + h * QKB; b1.Q = QM + (size_t)b1.P0 * NQB_ + h * QKB;
                    b0.O = ATT + (size_t)b0.P0 * DM + WA + h * HD; b1.O = ATT + (size_t)b1.P0 * DM + WA + h * HD; b0.lse = b1.lse = nullptr;
                    att::prime<CfgM>(b0, W_CAUSAL, albs, Sm, F.wave);
                    for (int pass = 0; pass < 2; ++pass) { const att::BlockRef cur = pass ? b1 : b0; att::block<CfgM>(cur, b1, S_, W_CAUSAL, albs, Sm, F.wave); }
                } }
            {   att::Seam<CfgA> Sa;
                bf16* const OA = (bf16*)(ws + WS_OA); float* const LA = (float*)(ws + WS_LSEA);
                for (int it = bx; it < 256; it += G_) {
                    const int h = it & 7, x = it >> 3;
                    { const float* tg = (const float*)(ws + WS_TBL) + h * att::TBL_N; LAS float* tl = (LAS float*)(ring + CfgA::OFF_TBL);
                      PH_IDX(); static_assert(att::TBL_N % 4 == 0 && att::TBL_N / 4 <= 2 * NWAVES * 64, "table copy"); const int i1 = tid + NWAVES * 64; const bool h1 = i1 < att::TBL_N / 4; const f32x4 t0 = ((const GAS f32x4*)tg)[tid], t1 = ((const GAS f32x4*)tg)[h1 ? i1 : tid]; ((LAS f32x4*)tl)[tid] = t0; if (h1) ((LAS f32x4*)tl)[i1] = t1; }
                    att::BlockRef b0, b1;
                    b0.P0 = x * 256; b1.P0 = (63 - x) * 256;
                    b0.K = b1.K = PROJ + C_KA + h * HD; b0.V = b1.V = PROJ + C_VA + h * HD;
                    b0.Q = PROJ + (size_t)b0.P0 * INP + C_QA + h * HD; b1.Q = PROJ + (size_t)b1.P0 * INP + C_QA + h * HD;
                    b0.O = OA + (size_t)b0.P0 * WA + h * HD; b1.O = OA + (size_t)b1.P0 * WA + h * HD;
                    b0.lse = LA + (size_t)b0.P0 * NH + h; b1.lse = LA + (size_t)b1.P0 * NH + h;
                    att::prime<CfgA>(b0, W_DILA, albs, Sa, F.wave);
                    for (int pass = 0; pass < 2; ++pass) { const att::BlockRef cur = pass ? b1 : b0; att::block<CfgA>(cur, b1, S_, W_DILA, albs, Sa, F.wave); }
                } }
            {   att::Seam<CfgB> Sb;
                bf16* const OB = (bf16*)(ws + WS_OB); float* const LB = (float*)(ws + WS_LSEB);
                for (int it = bx; it < 256; it += G_) {
                    const int h = it & 7, y = it >> 3;
                    { const float* tg = (const float*)(ws + WS_TBL) + (NH + h) * att::TBL_N; LAS float* tl = (LAS float*)(ring + CfgB::OFF_TBL);
                      PH_IDX(); static_assert(att::TBL_N % 4 == 0 && att::TBL_N / 4 <= 2 * NWAVES * 64, "table copy"); const int i1 = tid + NWAVES * 64; const bool h1 = i1 < att::TBL_N / 4; const f32x4 t0 = ((const GAS f32x4*)tg)[tid], t1 = ((const GAS f32x4*)tg)[h1 ? i1 : tid]; ((LAS f32x4*)tl)[tid] = t0; if (h1) ((LAS f32x4*)tl)[i1] = t1; }
                    att::BlockRef b0, b1;
                    const int i0 = 2 * y, i1 = 2 * y + 1, r0 = i0 >> 2, r1 = i1 >> 2;
                    b0.P0 = (i0 & 3) * 256; b1.P0 = (i1 & 3) * 256;
                    b0.K = PROJ + (size_t)r0 * INP + C_KA + h * HD; b1.K = PROJ + (size_t)r1 * INP + C_KA + h * HD;
                    b0.V = PROJ + (size_t)r0 * INP + C_VA + h * HD; b1.V = PROJ + (size_t)r1 * INP + C_VA + h * HD;
                    b0.Q = PROJ + ((size_t)b0.P0 * 16 + r0) * INP + C_QA + h * HD; b1.Q = PROJ + ((size_t)b1.P0 * 16 + r1) * INP + C_QA + h * HD;
                    b0.O = OB + ((size_t)b0.P0 * 16 + r0) * WA + h * HD; b1.O = OB + ((size_t)b1.P0 * 16 + r1) * WA + h * HD;
                    b0.lse = LB + ((size_t)b0.P0 * 16 + r0) * NH + h; b1.lse = LB + ((size_t)b1.P0 * 16 + r1) * NH + h;
                    att::prime<CfgB>(b0, W_DILB, albs, Sb, F.wave);
                    for (int pass = 0; pass < 2; ++pass) { const att::BlockRef cur = pass ? b1 : b0; att::block<CfgB>(cur, b1, S_ / 16, W_DILB, albs, Sb, F.wave); }
                } }
            __builtin_amdgcn_s_setprio(0);
            if (host && (bx & 4) != 0) { __syncthreads(); late_convert(F, a, 1); } }
            SEAM(pb + 3);
        }
        if (IN(pb + 4)) { att_merge(F, a); SEAM(pb + 4); }
        if (IN(pb + 5)) { for (int rp_ = 0; rp_ < (l == 0 ? REPS(6) : 1); ++rp_) {
            pg8::Gemm g{ATT, (const bf16*)(ws + WS_WOUT) + (size_t)l * DM * DM, DM, DM}; pg8::TileOrder O; O.init(S_ / 256, DM / 256, G_, bx, OUT_WGM);
            pg8::EpiRes E{l == 0 ? (const float*)a->in[0] : nullptr, H, nullptr, H, ssqx, DM};
            pg8::gemm_phase<pg8::EpiRes, pg8::TileOrder, false>(ring, g, O, E, F.wave, xlds); }
            SEAM(pb + 5);
        }
        if (l == 0) {
            if (IN(7)) { DUP(7) {
                pg8::Gemm g{H, (const bf16*)(ws + WS_WGU), DM, DM}; pg8::TileOrder O; O.init(S_ / 256, NT_GU, G_, bx, GU_WGM);
                pg8::EpiSwiGLU E{ACT, FF, NT_GU, ssqx, EPS, (REPS(7) > 1 && rp_ == 0) ? PROBE_EPI : 0};
                pg8::gemm_phase<pg8::EpiSwiGLU, pg8::TileOrder, false>(ring, g, O, E, F.wave, xlds); }
                SEAM(7);
            }
            if (IN(8)) { DUP(8) {
                const bool dry = REPS(8) > 1 && rp_ == 0;
                pg8::Gemm g{ACT, (const bf16*)(ws + WS_WD), FF, FF}; pg8::TileOrder O; O.init(S_ / 256, NT_D, G_, bx, DOWN_WGM);
                pg8::EpiRes E{nullptr, H, dry ? (float*)(ws + WS_END) : nullptr, dry ? nullptr : H, ssqx + (size_t)S_ * 8, DM};
                pg8::gemm_phase<pg8::EpiRes, pg8::TileOrder, false>(ring, g, O, E, F.wave, xlds); }
                SEAM(8);
            }
        } else {
            bf16* const HN = (bf16*)(ws + WS_HN);
            if (IN(15)) { if (REPS(15) > 1) norm_rows<true, true>(F, (const float*)H, (const float*)a->in[14] + l * DM, HN, a, true); norm_rows<true, true>(F, (const float*)H, (const float*)a->in[14] + l * DM, HN, a); SEAM(15); }
            if (IN(16)) { DUP(16) {
                int tb[9]; moe_tiles(a, tb);
                pg8::MoeOrder O; O.t.init(tb[8], NT_GU, G_, bx, MOE_GU_WGM); O.t1 = tb[1]; O.t2 = tb[2]; O.t3 = tb[3]; O.t4 = tb[4]; O.t5 = tb[5]; O.t6 = tb[6]; O.t7 = tb[7];
                O.nNl = NT_GU; O.list = (const int*)(ws + WS_LTOK); O.cnt = (const int*)(ws + WS_CTL) + CW_CNT; O.S_cap = S_; O.R = -1; O.T = 0; O.nkt_full = DM / 64;
                pg8::Gemm g{HN, (const bf16*)(ws + WS_WGUE), DM, DM};
                pg8::EpiSwiGLU E{ACT, FF, NT_GU, nullptr, 0.f, (REPS(16) > 1 && rp_ == 0) ? PROBE_EPI : 0};
                pg8::gemm_phase<pg8::EpiSwiGLU, pg8::MoeOrder, true>(ring, g, O, E, F.wave, xlds); }
                SEAM(16);
            }
            if (IN(17)) { DUP(17) {
                int tb[9]; moe_tiles(a, tb);
                pg8::MoeOrder O; O.t.init(tb[8], NT_D, G_, bx, DOWN_WGM); O.t.rev = DOWN_REV; O.t1 = tb[1]; O.t2 = tb[2]; O.t3 = tb[3]; O.t4 = tb[4]; O.t5 = tb[5]; O.t6 = tb[6]; O.t7 = tb[7];
                O.nNl = NT_D; O.list = (const int*)(ws + WS_LTOK); O.cnt = (const int*)(ws + WS_CTL) + CW_CNT; O.S_cap = S_; O.nkt_full = FF / 64;
                { const int U = tb[8] * NT_D, Rr = U / G_, Tt = U - Rr * G_; const bool split = Tt > 0 && 4 * Tt <= G_; O.R = split ? Rr : -1; O.T = split ? Tt : 0; }
                pg8::Gemm g{ACT, (const bf16*)(ws + WS_WDE), FF, FF};
                pg8::EpiMoeDown E{Y, DM, NT_D, (const float*)(ws + WS_LGATE), (const int*)(ws + WS_CTL) + CW_CNT, S_, (bf16*)(ws + WS_PT)};
                pg8::gemm_phase<pg8::EpiMoeDown, pg8::MoeOrder, false, true>(ring, g, O, E, F.wave, xlds); }
                SEAM(17);
            }
            if (IN(18)) {
                int tb[9]; moe_tiles(a, tb);
                const int U = tb[8] * NT_D, Rr = U / G_, Tt = U - Rr * G_;
                if (Tt > 0 && 4 * Tt <= G_ && bx < 4 * Tt) {
                    pg8::TileOrder O; O.init(tb[8], NT_D, G_, bx, DOWN_WGM); O.rev = DOWN_REV; pg8::Unit u; O.at((long)Rr * G_ + (bx >> 2), u);
                    moe_tail_reduce(F, a, Tt, u.pm, u.pn); }
                SEAM(18);
            }
            if (IN(19)) { if (REPS(19) > 1) moe_combine(F, a, true); moe_combine(F, a); }
        }
    }
#undef IN
#undef SEAM
#undef REPS
#undef DUP
}

extern "C" void kernel_launch(void* const* d_in, const int* in_sizes, int n_in, void* d_out, int out_size, void* d_ws, size_t ws_size, hipStream_t stream) {
    static int grid = 0;
    if (grid == 0) {
        if (n_in != 22 || in_sizes[0] != S_ * DM || out_size != S_ * DM || ws_size < WS_END) { fprintf(stderr, "kernel_launch: shape/workspace mismatch (n_in %d, in0 %d, out %d, ws %zu, need %zu)\n", n_in, n_in > 0 ? in_sizes[0] : -1, out_size, ws_size, (size_t)WS_END); grid = -1; return; }
        int dev = 0, cus = 0, per_cu = 0;
        if (hipGetDevice(&dev) != hipSuccess || hipDeviceGetAttribute(&cus, hipDeviceAttributeMultiprocessorCount, dev) != hipSuccess) { grid = -1; return; }
        if (hipFuncSetAttribute((const void*)mega_fwd, hipFuncAttributeMaxDynamicSharedMemorySize, LDS_BYTES) != hipSuccess) { fprintf(stderr, "kernel_launch: hipFuncSetAttribute failed\n"); grid = -1; return; }
        if (hipOccupancyMaxActiveBlocksPerMultiprocessor(&per_cu, (const void*)mega_fwd, NWAVES * 64, LDS_BYTES) != hipSuccess || per_cu < 1) { fprintf(stderr, "kernel_launch: occupancy query reports %d\n", per_cu); }
        (void)hipGetLastError();
        grid = cus;
    }
    if (grid < 0) return;
    if (hipMemsetAsync((char*)d_ws + WS_CTL, 0, CTL_ZERO_BYTES, stream) != hipSuccess) return;
    Args a{};
    for (int i = 0; i < 22; ++i) a.in[i] = d_in[i];
    a.out = (float*)d_out; a.ws = (unsigned char*)d_ws; a.pad = 0;
#if MK_PER_PHASE
    for (int ph = 0; ph < DBG_STOP; ++ph) { a.ph_lo = ph; a.ph_hi = ph + 1; a.use_bar = 0;
        hipLaunchKernelGGL(mega_fwd, dim3(grid), dim3(NWAVES * 64), LDS_BYTES, stream, a); }
#else
    a.ph_lo = 0; a.ph_hi = DBG_STOP; a.use_bar = 1;
    hipLaunchKernelGGL(mega_fwd, dim3(grid), dim3(NWAVES * 64), LDS_BYTES, stream, a);
#endif
}
```

```cpp
#define KLOOP_ALIGN "4"
#define PAD_NOPS "16"
#include <hip/hip_runtime.h>
#include <cstdio>
#include <cstdint>
namespace pg8 {
constexpr int CNT_STRIDE = 32;
#define PG8_LAS __attribute__((address_space(3)))
typedef unsigned short bf16_t;
typedef short bf16x8 __attribute__((ext_vector_type(8)));
typedef float f32x4 __attribute__((ext_vector_type(4)));
typedef unsigned u32x4 __attribute__((ext_vector_type(4)));
constexpr int BM = 256, BK = 64, HALF = 128, HTB = HALF * BK * 2  , STAGE_BYTES = 8 * HTB, NXCD = 8, WGM = 8;

__device__ __forceinline__ int lds_byte(int r, int c) { const int st = (r >> 4) * 2 + (c >> 5), rr = r & 15, cc = c & 31, ob = rr * 64 + cc * 2; return st * 1024 + (ob ^ (((ob >> 9) & 1) << 5)); }
__device__ __forceinline__ void stage_rc(int b, int& R, int& C) { const int st = b / 1024, sb = b % 1024, swz = sb ^ (((sb >> 9) & 1) << 5); R = (st >> 1) * 16 + swz / 64; C = (st & 1) * 32 + (swz % 64) / 2; }
__device__ __forceinline__ int perm32(int rho) { const int n = rho >> 4, i = rho & 15; return 8 * (i >> 2) + 4 * n + (i & 3); }

struct Unit { int pm, pn, e, lt, kt0, nkt, tail; };
struct Gemm { const bf16_t* A; const bf16_t* Bt; int K; int lda; };

struct TileOrder {
    int nM, nN, nwg, G, c, wgm, rev;
    __device__ __forceinline__ void init(int nM_, int nN_, int G_, int c_, int wgm_ = WGM) { nM = nM_; nN = nN_; nwg = nM * nN; G = G_; c = c_; wgm = wgm_; rev = 0; }
    __device__ __forceinline__ bool next(int i, Unit& u) const { return at((long)i * G + c, u); }
    __device__ __forceinline__ bool at(long L, Unit& u) const {
        if (L >= nwg) return false;
        int wgid = (int)L; { const int q = nwg / NXCD, r = nwg % NXCD, xcd = wgid % NXCD, off = wgid / NXCD; wgid = (xcd < r ? xcd * (q + 1) : r * (q + 1) + (xcd - r) * q) + off; }
        if (rev) wgid = nwg - 1 - wgid;
        const int nig = wgm * nN, gid = wgid / nig, fm = gid * wgm, gsz = (nM - fm) < wgm ? (nM - fm) : wgm;
        u.pm = fm + ((wgid % nig) % gsz); u.pn = (wgid % nig) / gsz; u.e = 0; u.lt = 0; u.kt0 = 0; u.nkt = 0; u.tail = 0; return true;
    }
    __device__ __forceinline__ unsigned a_off(const Unit&, int) const { return 0u; }
};
struct MoeOrder {
    TileOrder t; int t1, t2, t3, t4, t5, t6, t7; int nNl; const int* list; const int* cnt; int S_cap; int R, T, nkt_full;
    __device__ __forceinline__ void find(int pm, int& e, int& tb) const {
        e = (pm >= t1) + (pm >= t2) + (pm >= t3) + (pm >= t4) + (pm >= t5) + (pm >= t6) + (pm >= t7);
        tb = pm >= t7 ? t7 : pm >= t6 ? t6 : pm >= t5 ? t5 : pm >= t4 ? t4 : pm >= t3 ? t3 : pm >= t2 ? t2 : pm >= t1 ? t1 : 0;
    }
    __device__ __forceinline__ bool next(int i, Unit& u) const {
        if (R >= 0 && i >= R) {
            if (i > R || t.c >= 4 * T) return false;
            if (!t.at((long)R * t.G + (t.c >> 2), u)) return false;
            u.nkt = nkt_full / 4; u.kt0 = (t.c & 3) * u.nkt; u.tail = 1 + t.c;
        } else { if (!t.next(i, u)) return false; u.nkt = nkt_full; }
        int e, tb; find(u.pm, e, tb); u.e = e; u.lt = u.pm - tb; u.pn += e * nNl; return true;
    }
    __device__ __forceinline__ unsigned a_off(const Unit& u, int R) const {
        const int slot = u.lt * 256 + R; const int n = cnt[u.e * CNT_STRIDE];
        const int tok = list[(size_t)u.e * S_cap + (slot < n ? slot : 0)];
        return (unsigned)tok * 4096u;
    }
};

__device__ __forceinline__ unsigned cvt_pk_bf16(float lo, float hi) { unsigned r; asm volatile("v_cvt_pk_bf16_f32 %0, %1, %2" : "=v"(r) : "v"(lo), "v"(hi)); return r; }

__device__ __forceinline__ float shx(float v, int lane, int o) { return __builtin_bit_cast(float, __builtin_amdgcn_ds_bpermute((lane ^ o) << 2, __builtin_bit_cast(int, v))); }
__device__ __forceinline__ float sum_fq(float v, int lane) { v += shx(v, lane, 16); v += shx(v, lane, 32); return v; }
__device__ __forceinline__ float ssq4(const f32x4 a) { return (a[0] * a[0] + a[1] * a[1]) + (a[2] * a[2] + a[3] * a[3]); }
typedef float f32x2 __attribute__((ext_vector_type(2)));
template <int NS>
__device__ __forceinline__ void row_rs8(const float* ssq, int row0, float inv_n, float eps, float (&rs)[2][4]) {
    if constexpr (NS == 8) { f32x4 a[2][4], b[2][4];
#pragma unroll
        for (int ai = 0; ai < 2; ++ai)
#pragma unroll
            for (int m = 0; m < 4; ++m) { const float* p = ssq + (size_t)(row0 + ai * HALF + m * 16) * 8; a[ai][m] = *(const f32x4*)p; b[ai][m] = *(const f32x4*)(p + 4); }
#pragma unroll
        for (int ai = 0; ai < 2; ++ai)
#pragma unroll
            for (int m = 0; m < 4; ++m) { const f32x4 x = a[ai][m], y = b[ai][m]; rs[ai][m] = __builtin_amdgcn_rsqf((((x[0] + x[1]) + (x[2] + x[3])) + ((y[0] + y[1]) + (y[2] + y[3]))) * inv_n + eps); }
    } else if constexpr (NS == 2) { f32x2 a[2][4];
#pragma unroll
        for (int ai = 0; ai < 2; ++ai)
#pragma unroll
            for (int m = 0; m < 4; ++m) a[ai][m] = *(const f32x2*)(ssq + (size_t)(row0 + ai * HALF + m * 16) * 2);
#pragma unroll
        for (int ai = 0; ai < 2; ++ai)
#pragma unroll
            for (int m = 0; m < 4; ++m) rs[ai][m] = __builtin_amdgcn_rsqf((a[ai][m][0] + a[ai][m][1]) * inv_n + eps);
    } else { float a[2][4];
#pragma unroll
        for (int ai = 0; ai < 2; ++ai)
#pragma unroll
            for (int m = 0; m < 4; ++m) a[ai][m] = ssq[row0 + ai * HALF + m * 16];
#pragma unroll
        for (int ai = 0; ai < 2; ++ai)
#pragma unroll
            for (int m = 0; m < 4; ++m) rs[ai][m] = __builtin_amdgcn_rsqf(a[ai][m] * inv_n + eps);
    }
}
__device__ __forceinline__ void row_rs8n(const float* ssq, int ns, int row0, float inv_n, float eps, float (&rs)[2][4]) {
    if (ns == 8) row_rs8<8>(ssq, row0, inv_n, eps, rs); else if (ns == 2) row_rs8<2>(ssq, row0, inv_n, eps, rs); else row_rs8<1>(ssq, row0, inv_n, eps, rs);
}
__device__ __forceinline__ void ones8(float (&rs)[2][4]) {
#pragma unroll
    for (int ai = 0; ai < 2; ++ai)
#pragma unroll
        for (int m = 0; m < 4; ++m) rs[ai][m] = 1.0f;
}
struct EpiBf16 {
    static constexpr bool PERM = true;
    bf16_t* O; int ldc; const float* ssq; int ns; float inv_n, eps;
    __device__ __forceinline__ void operator()(const f32x4 (&acc)[2][2][4][2], const Unit& u, int wr, int wc, int fr, int fq, int lane, PG8_LAS float* xl) const {
        const int row0 = u.pm * BM + wr * 64 + fr, col0 = u.pn * BM + wc * 32 + 8 * fq;
        float rsv[2][4];
        if (ssq) row_rs8n(ssq, ns, row0, inv_n, eps, rsv); else ones8(rsv);
#pragma unroll
        for (int ai = 0; ai < 2; ++ai)
#pragma unroll
            for (int m = 0; m < 4; ++m) { const int grow = row0 + ai * HALF + m * 16; bf16_t* rowp = O + (size_t)grow * ldc + col0;
                const float rs = rsv[ai][m];
#pragma unroll
                for (int bj = 0; bj < 2; ++bj) { const f32x4 v0 = acc[ai][bj][m][0] * rs, v1 = acc[ai][bj][m][1] * rs;
                    u32x4 w; w.x = cvt_pk_bf16(v0[0], v0[1]); w.y = cvt_pk_bf16(v0[2], v0[3]); w.z = cvt_pk_bf16(v1[0], v1[1]); w.w = cvt_pk_bf16(v1[2], v1[3]);
                    *(u32x4*)(rowp + bj * HALF) = w; } }
    }
};
struct EpiInProj {
    static constexpr bool PERM = true;
    bf16_t* O; int ldc; const float* ssq_x; int ns_x; const float* gq; const float* gk; const float* gckv; float* ssq_cq; float eps;
    __device__ __forceinline__ void operator()(const f32x4 (&acc)[2][2][4][2], const Unit& u, int wr, int wc, int fr, int fq, int lane, PG8_LAS float* xl) const {
        const int row0 = u.pm * BM + wr * 64 + fr, col0 = u.pn * BM + wc * 32 + 8 * fq, pn = u.pn;
        const bool headn = pn < 8, ckvn = pn == 14, cq = (pn == 12 || pn == 13);
        f32x4 v[2][4][2][2];
        float rsxv[2][4]; row_rs8n(ssq_x, ns_x, row0, 1.0f / 2048.0f, eps, rsxv);
#pragma unroll
        for (int ai = 0; ai < 2; ++ai)
#pragma unroll
            for (int m = 0; m < 4; ++m) { const float rsx = rsxv[ai][m];
#pragma unroll
                for (int bj = 0; bj < 2; ++bj)
#pragma unroll
                    for (int n = 0; n < 2; ++n) v[ai][m][bj][n] = acc[ai][bj][m][n] * rsx; }
        if (headn || ckvn) {
#pragma unroll
            for (int ai = 0; ai < 2; ++ai)
#pragma unroll
                for (int m = 0; m < 4; ++m)
#pragma unroll
                    for (int bj = 0; bj < 2; ++bj) { const float s = sum_fq(ssq4(v[ai][m][bj][0]) + ssq4(v[ai][m][bj][1]), lane);
                        if (fq == 0) xl[((ai * HALF + wr * 64 + m * 16 + fr) * 2 + bj) * 4 + wc] = s; }
            asm volatile("s_waitcnt lgkmcnt(0)" ::: "memory"); __builtin_amdgcn_s_barrier(); asm volatile("" ::: "memory");
            f32x4 gg[2][2];
            { const int go = wc * 32 + 8 * fq;
              if (ckvn) { gg[0][0] = *(const f32x4*)(gckv + go); gg[0][1] = *(const f32x4*)(gckv + go + 4); gg[1][0] = *(const f32x4*)(gckv + HALF + go); gg[1][1] = *(const f32x4*)(gckv + HALF + go + 4); }
              else if (pn < 4) { gg[0][0] = *(const f32x4*)(gq + go); gg[0][1] = *(const f32x4*)(gq + go + 4); gg[1][0] = gg[0][0]; gg[1][1] = gg[0][1]; }
              else { gg[0][0] = *(const f32x4*)(gk + go); gg[0][1] = *(const f32x4*)(gk + go + 4); gg[1][0] = gg[0][0]; gg[1][1] = gg[0][1]; } }
#pragma unroll
            for (int ai = 0; ai < 2; ++ai)
#pragma unroll
                for (int m = 0; m < 4; ++m) { const int r = ai * HALF + wr * 64 + m * 16 + fr;
                    const f32x4 p0 = *(const PG8_LAS f32x4*)(xl + (r * 2 + 0) * 4), p1 = *(const PG8_LAS f32x4*)(xl + (r * 2 + 1) * 4);
                    const float t0 = (p0[0] + p0[1]) + (p0[2] + p0[3]), t1 = (p1[0] + p1[1]) + (p1[2] + p1[3]);
                    const float r0 = ckvn ? __builtin_amdgcn_rsqf((t0 + t1) * (1.0f / 256.0f) + eps) : __builtin_amdgcn_rsqf(t0 * (1.0f / 128.0f) + eps);
                    const float r1 = ckvn ? r0 : __builtin_amdgcn_rsqf(t1 * (1.0f / 128.0f) + eps);
#pragma unroll
                    for (int n = 0; n < 2; ++n) { v[ai][m][0][n] = v[ai][m][0][n] * r0 * gg[0][n]; v[ai][m][1][n] = v[ai][m][1][n] * r1 * gg[1][n]; } }
        } else if (cq) {
#pragma unroll
            for (int ai = 0; ai < 2; ++ai)
#pragma unroll
                for (int m = 0; m < 4; ++m) { const float s = sum_fq((ssq4(v[ai][m][0][0]) + ssq4(v[ai][m][0][1])) + (ssq4(v[ai][m][1][0]) + ssq4(v[ai][m][1][1])), lane);
                    if (fq == 0) xl[(ai * HALF + wr * 64 + m * 16 + fr) * 4 + wc] = s; }
            asm volatile("s_waitcnt lgkmcnt(0)" ::: "memory"); __builtin_amdgcn_s_barrier(); asm volatile("" ::: "memory");
            if (wc == 0 && fq == 0) {
#pragma unroll
                for (int ai = 0; ai < 2; ++ai)
#pragma unroll
                    for (int m = 0; m < 4; ++m) { const int r = ai * HALF + wr * 64 + m * 16 + fr; const f32x4 p = *(const PG8_LAS f32x4*)(xl + r * 4);
                        ssq_cq[(size_t)(u.pm * BM + r) * 2 + (pn - 12)] = (p[0] + p[1]) + (p[2] + p[3]); } }
        }
#pragma unroll
        for (int ai = 0; ai < 2; ++ai)
#pragma unroll
            for (int m = 0; m < 4; ++m) { bf16_t* rowp = O + (size_t)(row0 + ai * HALF + m * 16) * ldc + col0;
#pragma unroll
                for (int bj = 0; bj < 2; ++bj) { const f32x4 v0 = v[ai][m][bj][0], v1 = v[ai][m][bj][1];
                    u32x4 w; w.x = cvt_pk_bf16(v0[0], v0[1]); w.y = cvt_pk_bf16(v0[2], v0[3]); w.z = cvt_pk_bf16(v1[0], v1[1]); w.w = cvt_pk_bf16(v1[2], v1[3]);
                    *(u32x4*)(rowp + bj * HALF) = w; } }
    }
};
struct EpiRes {
    static constexpr bool PERM = true;
    const float* base32; const bf16_t* base16; float* out32; bf16_t* xb; float* ssq; int ldc;
    __device__ __forceinline__ void operator()(const f32x4 (&acc)[2][2][4][2], const Unit& u, int wr, int wc, int fr, int fq, int lane, PG8_LAS float* xl) const {
        const int row0 = u.pm * BM + wr * 64 + fr, col0 = u.pn * BM + wc * 32 + 8 * fq;
        float sr[2][4];
#define PG8_RES_ROW(ai, m, B00, B01, B10, B11) do { const size_t off = (size_t)(row0 + (ai) * HALF + (m) * 16) * ldc + col0; float s = 0.f;                      \
            { const f32x4 o0 = (B00) + acc[ai][0][m][0], o1 = (B01) + acc[ai][0][m][1];                                                                     \
              if (out32) { *(f32x4*)(out32 + off) = o0; *(f32x4*)(out32 + off + 4) = o1; }                                                                  \
              if (xb) { s += ssq4(o0) + ssq4(o1); u32x4 w; w.x = cvt_pk_bf16(o0[0], o0[1]); w.y = cvt_pk_bf16(o0[2], o0[3]); w.z = cvt_pk_bf16(o1[0], o1[1]); w.w = cvt_pk_bf16(o1[2], o1[3]); *(u32x4*)(xb + off) = w; } } \
            { const f32x4 o0 = (B10) + acc[ai][1][m][0], o1 = (B11) + acc[ai][1][m][1];                                                                     \
              if (out32) { *(f32x4*)(out32 + off + HALF) = o0; *(f32x4*)(out32 + off + HALF + 4) = o1; }                                                    \
              if (xb) { s += ssq4(o0) + ssq4(o1); u32x4 w; w.x = cvt_pk_bf16(o0[0], o0[1]); w.y = cvt_pk_bf16(o0[2], o0[3]); w.z = cvt_pk_bf16(o1[0], o1[1]); w.w = cvt_pk_bf16(o1[2], o1[3]); *(u32x4*)(xb + off + HALF) = w; } } \
            sr[ai][m] = s; } while (0)
#define PG8_BF_LO(q_) ((f32x4){__builtin_bit_cast(float, (q_).x << 16), __builtin_bit_cast(float, (q_).x & 0xffff0000u), __builtin_bit_cast(float, (q_).y << 16), __builtin_bit_cast(float, (q_).y & 0xffff0000u)})
#define PG8_BF_HI(q_) ((f32x4){__builtin_bit_cast(float, (q_).z << 16), __builtin_bit_cast(float, (q_).z & 0xffff0000u), __builtin_bit_cast(float, (q_).w << 16), __builtin_bit_cast(float, (q_).w & 0xffff0000u)})
        if (base32) {
#pragma unroll
            for (int ai = 0; ai < 2; ++ai) { f32x4 b[4][2][2];
#pragma unroll
                for (int m = 0; m < 4; ++m) { const size_t off = (size_t)(row0 + ai * HALF + m * 16) * ldc + col0;
#pragma unroll
                    for (int bj = 0; bj < 2; ++bj) { b[m][bj][0] = *(const f32x4*)(base32 + off + bj * HALF); b[m][bj][1] = *(const f32x4*)(base32 + off + bj * HALF + 4); } }
#pragma unroll
                for (int m = 0; m < 4; ++m) PG8_RES_ROW(ai, m, b[m][0][0], b[m][0][1], b[m][1][0], b[m][1][1]); }
        } else {
            u32x4 w[2][4][2];
#pragma unroll
            for (int ai = 0; ai < 2; ++ai)
#pragma unroll
                for (int m = 0; m < 4; ++m) { const size_t off = (size_t)(row0 + ai * HALF + m * 16) * ldc + col0; w[ai][m][0] = *(const u32x4*)(base16 + off); w[ai][m][1] = *(const u32x4*)(base16 + off + HALF); }
#pragma unroll
            for (int ai = 0; ai < 2; ++ai)
#pragma unroll
                for (int m = 0; m < 4; ++m) PG8_RES_ROW(ai, m, PG8_BF_LO(w[ai][m][0]), PG8_BF_HI(w[ai][m][0]), PG8_BF_LO(w[ai][m][1]), PG8_BF_HI(w[ai][m][1]));
        }
#undef PG8_RES_ROW
#undef PG8_BF_LO
#undef PG8_BF_HI
        if (xb) {
#pragma unroll
            for (int ai = 0; ai < 2; ++ai)
#pragma unroll
                for (int m = 0; m < 4; ++m) { const float s = sum_fq(sr[ai][m], lane); if (fq == 0) xl[(ai * HALF + wr * 64 + m * 16 + fr) * 4 + wc] = s; }
            asm volatile("s_waitcnt lgkmcnt(0)" ::: "memory"); __builtin_amdgcn_s_barrier(); asm volatile("" ::: "memory");
            if (wc == 0 && fq == 0) {
#pragma unroll
                for (int ai = 0; ai < 2; ++ai)
#pragma unroll
                    for (int m = 0; m < 4; ++m) { const int r = ai * HALF + wr * 64 + m * 16 + fr; const f32x4 p = *(const PG8_LAS f32x4*)(xl + r * 4);
                        ssq[(size_t)(u.pm * BM + r) * 8 + u.pn] = (p[0] + p[1]) + (p[2] + p[3]); } }
        }
    }
};
__device__ __forceinline__ float silu_mul(float g, float u) { return g * u * __builtin_amdgcn_rcpf(1.0f + __builtin_amdgcn_exp2f(-1.4426950408889634f * g)); }
struct EpiSwiGLU {
    static constexpr bool PERM = true;
    bf16_t* O; int ldc; int nNl; const float* ssq; float eps; int probe;
    __device__ __forceinline__ void operator()(const f32x4 (&acc)[2][2][4][2], const Unit& u, int wr, int wc, int fr, int fq, int lane, PG8_LAS float* xl) const {
        const int pnl = u.pn - u.e * nNl;
        if (probe == 2) return;
        const int row0 = u.pm * BM + wr * 64 + fr, col0 = pnl * HALF + wc * 32 + 8 * fq;
        float rsv[2][4];
        if (ssq) row_rs8<8>(ssq, row0, 1.0f / 2048.0f, eps, rsv); else ones8(rsv);
#pragma unroll
        for (int ai = 0; ai < 2; ++ai)
#pragma unroll
            for (int m = 0; m < 4; ++m) { const int grow = row0 + ai * HALF + m * 16; bf16_t* rowp = O + (size_t)grow * ldc + col0;
                const float rs = rsv[ai][m];
                const f32x4 g0 = acc[ai][0][m][0] * rs, g1 = acc[ai][0][m][1] * rs, u0 = acc[ai][1][m][0] * rs, u1 = acc[ai][1][m][1] * rs;
                u32x4 w; w.x = cvt_pk_bf16(silu_mul(g0[0], u0[0]), silu_mul(g0[1], u0[1])); w.y = cvt_pk_bf16(silu_mul(g0[2], u0[2]), silu_mul(g0[3], u0[3]));
                w.z = cvt_pk_bf16(silu_mul(g1[0], u1[0]), silu_mul(g1[1], u1[1])); w.w = cvt_pk_bf16(silu_mul(g1[2], u1[2]), silu_mul(g1[3], u1[3]));
                if (probe != 1 || w.x == 0x12345678u) *(u32x4*)rowp = w; }
    }
};
struct EpiMoeDown {
    static constexpr bool PERM = true;
    bf16_t* Y; int ldc; int nNl; const float* glist; const int* cnt; int S_cap; bf16_t* P;
    __device__ __forceinline__ void operator()(const f32x4 (&acc)[2][2][4][2], const Unit& u, int wr, int wc, int fr, int fq, int lane, PG8_LAS float* xl) const {
        const int pnl = u.pn - u.e * nNl; const int n = cnt[u.e * CNT_STRIDE];
        const int r0 = wr * 64 + fr;
        char* const tbase = u.tail ? (char*)(P + (size_t)(u.tail - 1) * BM * BM) : (char*)(Y + (size_t)u.pm * BM * ldc + pnl * BM);
        const unsigned pitch = u.tail ? (unsigned)BM : (unsigned)ldc;
        float gtv[2][4];
#pragma unroll
        for (int ai = 0; ai < 2; ++ai)
#pragma unroll
            for (int m = 0; m < 4; ++m) { const int slot = u.lt * 256 + r0 + ai * HALF + m * 16; gtv[ai][m] = slot < n ? glist[(size_t)u.e * S_cap + slot] : 0.f; }
#pragma unroll
        for (int ai = 0; ai < 2; ++ai)
#pragma unroll
            for (int m = 0; m < 4; ++m) { const int r = r0 + ai * HALF + m * 16;
                const float gt = gtv[ai][m];
                bf16_t* rowp = (bf16_t*)(tbase + ((unsigned)r * pitch + (unsigned)(wc * 32 + 8 * fq)) * 2u);
#pragma unroll
                for (int bj = 0; bj < 2; ++bj) { const f32x4 v0 = acc[ai][bj][m][0] * gt, v1 = acc[ai][bj][m][1] * gt;
                    u32x4 w; w.x = cvt_pk_bf16(v0[0], v0[1]); w.y = cvt_pk_bf16(v0[2], v0[3]); w.z = cvt_pk_bf16(v1[0], v1[1]); w.w = cvt_pk_bf16(v1[2], v1[3]);
                    *(u32x4*)(rowp + bj * HALF) = w; } }
    }
};

template <class Epi, class Sched, bool GATHER, bool KS = false>
__device__ __forceinline__ void gemm_phase(PG8_LAS unsigned char* lds, const Gemm g, const Sched& S, const Epi& E, const int wid_in, PG8_LAS float* xlds) {
    int wid_ = wid_in; asm volatile("" : "+s"(wid_)); const int wid = wid_;
    int lane_; asm volatile("v_mbcnt_lo_u32_b32 %0, -1, 0\n\tv_mbcnt_hi_u32_b32 %0, -1, %0" : "=v"(lane_));
    const int lane = lane_, tid = wid * 64 + lane, wr = wid >> 2, wc = wid & 3, fr = lane & 15, fq = lane >> 4;
    const int K = g.K; int nt = K / BK;
    unsigned voffA[2], voffB[2]; int Rg[2];
#pragma unroll
    for (int i = 0; i < 2; ++i) { int R, C; stage_rc(tid * 16 + i * 8192, R, C); const int Rb = Epi::PERM ? ((R & ~31) + perm32(R & 31)) : R;
        voffA[i] = GATHER ? (unsigned)(C * 2) : (unsigned)(R * g.lda + C) * 2u; voffB[i] = (unsigned)(Rb * K + C) * 2u; Rg[i] = R; }
    const size_t kstep = (size_t)(BK * 2);
    const size_t hstep = (size_t)HALF * K * 2;
    const size_t tstep = 2 * hstep;
    const size_t hstepA = (size_t)HALF * g.lda * 2, tstepA = 2 * hstepA;
    const unsigned ldsw = (unsigned)wid * 1024u;
    const int aoff = lds_byte(wr * 64 + fr, fq * 8), boff = lds_byte(wc * 32 + fr, fq * 8);
#define PG8_SA(b, h) (((b) * 2 + (h)) * HTB)
#define PG8_SB(b, h) ((4 + (b) * 2 + (h)) * HTB)
#define PG8_STAGE(bufoff, gbase, voff) do { _Pragma("unroll") for (int _i = 0; _i < 2; ++_i) \
        __builtin_amdgcn_global_load_lds((const unsigned*)((const char*)(gbase) + (voff)[_i]), (PG8_LAS unsigned*)(lds + (bufoff) + ldsw + _i * 8192), 16, 0, 0); } while (0)
#define PG8_STA(bufoff, pbase, gbase, half, goff) do { if constexpr (GATHER) PG8_STAGE(bufoff, gbase, (goff)[half]); else PG8_STAGE(bufoff, (pbase) + (half) * hstepA, voffA); } while (0)
#define PG8_LDA(dst, b, h) do { _Pragma("unroll") for (int m = 0; m < 4; ++m) _Pragma("unroll") for (int k = 0; k < 2; ++k) dst[m][k] = *(const PG8_LAS bf16x8*)(lds + PG8_SA(b, h) + aoff + m * 2048 + k * 1024); } while (0)
#define PG8_LDB(dst, b, h) do { _Pragma("unroll") for (int n = 0; n < 2; ++n) _Pragma("unroll") for (int k = 0; k < 2; ++k) dst[n][k] = *(const PG8_LAS bf16x8*)(lds + PG8_SB(b, h) + boff + n * 2048 + k * 1024); } while (0)
#define PG8_MMA(ai, bj, At, Bt) do { __builtin_amdgcn_s_setprio(1); _Pragma("unroll") for (int m = 0; m < 4; ++m) _Pragma("unroll") for (int n = 0; n < 2; ++n) _Pragma("unroll") for (int k = 0; k < 2; ++k) \
        acc[ai][bj][m][n] = __builtin_amdgcn_mfma_f32_16x16x32_bf16(Bt[n][k], At[m][k], acc[ai][bj][m][n], 0, 0, 0); __builtin_amdgcn_s_setprio(0); } while (0)
#define PG8_WAIT_V(n) asm volatile("s_waitcnt vmcnt(" #n ")" ::: "memory")
#define PG8_WAIT_L(n) asm volatile("s_waitcnt lgkmcnt(" #n ")" ::: "memory")
#define PG8_BAR __builtin_amdgcn_s_barrier()
#define PG8_SCHED __builtin_amdgcn_sched_barrier(0)
#define PG8_GFILL(u, o) do { _Pragma("unroll") for (int _h = 0; _h < 2; ++_h) _Pragma("unroll") for (int _i = 0; _i < 2; ++_i) (o)[_h][_i] = S.a_off(u, _h * HALF + Rg[_i]) + voffA[_i]; } while (0)
    Unit cur, nxt; int ui = 0;
    if (!S.next(0, cur)) return;
    f32x4 acc[2][2][4][2];
#pragma unroll
    for (int a = 0; a < 2; ++a)
#pragma unroll
        for (int b = 0; b < 2; ++b)
#pragma unroll
            for (int m = 0; m < 4; ++m)
#pragma unroll
                for (int n = 0; n < 2; ++n) acc[a][b][m][n] = (f32x4){0.f, 0.f, 0.f, 0.f};
    bf16x8 At[4][2], B0[2][2], B1[2][2];
    unsigned gc[2][2] = {{0u, 0u}, {0u, 0u}}, gn[2][2] = {{0u, 0u}, {0u, 0u}};
    if constexpr (GATHER) PG8_GFILL(cur, gc);
    if constexpr (KS) nt = cur.nkt;
    const char* const gA = (const char*)g.A;
    const char* cA = GATHER ? gA : gA + (size_t)cur.pm * tstepA + (KS ? (size_t)cur.kt0 * kstep : 0); const char* cB = (const char*)g.Bt + (size_t)cur.pn * tstep + (KS ? (size_t)cur.kt0 * kstep : 0);
    PG8_STAGE(PG8_SB(0, 0), cB, voffB); PG8_STAGE(PG8_SB(0, 1), cB + hstep, voffB); PG8_STA(PG8_SA(0, 0), cA, gA, 0, gc); PG8_STA(PG8_SA(0, 1), cA, gA, 1, gc);
    if (wr == 1) PG8_BAR;
    PG8_WAIT_V(2); PG8_BAR;
    PG8_STAGE(PG8_SB(1, 0), cB + kstep, voffB); PG8_STA(PG8_SA(1, 0), cA + kstep, gA + kstep, 0, gc); PG8_STAGE(PG8_SB(1, 1), cB + hstep + kstep, voffB);
    PG8_WAIT_V(6); PG8_BAR;
    for (;;) {
        const bool has_next = S.next(ui + 1, nxt);
        if constexpr (GATHER) { if (has_next) PG8_GFILL(nxt, gn); else {
#pragma unroll
            for (int h = 0; h < 2; ++h)
#pragma unroll
                for (int i = 0; i < 2; ++i) gn[h][i] = gc[h][i]; } }
        const char* nA = (has_next && !GATHER) ? gA + (size_t)nxt.pm * tstepA + (KS ? (size_t)nxt.kt0 * kstep : 0) : cA; const char* nB = has_next ? (const char*)g.Bt + (size_t)nxt.pn * tstep + (KS ? (size_t)nxt.kt0 * kstep : 0) : cB;
        for (int t = 0; t < nt; t += 2) {
#ifdef KLOOP_ALIGN
            asm volatile(".p2align 6\n\t.rept " KLOOP_ALIGN "\n\ts_nop 0\n\t.endr");
#endif
            const bool last = (t == nt - 2);
            const char* a1 = cA + (size_t)(t + 1) * kstep;
            const char* a2 = last ? nA : cA + (size_t)(t + 2) * kstep; const char* b2 = last ? nB : cB + (size_t)(t + 2) * kstep;
            const char* a3 = a2 + kstep; const char* b3 = b2 + kstep;
            unsigned gs[2][2];
#pragma unroll
            for (int h = 0; h < 2; ++h)
#pragma unroll
                for (int i = 0; i < 2; ++i) gs[h][i] = last ? gn[h][i] : gc[h][i];
            PG8_LDB(B0, 0, 0); PG8_LDB(B1, 0, 1); PG8_SCHED; PG8_LDA(At, 0, 0); PG8_STA(PG8_SA(1, 1), a1, a1, 1, gc);
            PG8_WAIT_V(8); PG8_WAIT_L(0); PG8_BAR; PG8_MMA(0, 0, At, B0); PG8_MMA(0, 1, At, B1); PG8_BAR; PG8_SCHED;
            PG8_LDA(At, 0, 1); PG8_STAGE(PG8_SB(0, 0), b2, voffB); PG8_STAGE(PG8_SB(0, 1), b2 + hstep, voffB); PG8_STA(PG8_SA(0, 0), a2, a2, 0, gs);
            PG8_WAIT_V(8); PG8_WAIT_L(0); PG8_BAR; PG8_MMA(1, 0, At, B0); PG8_MMA(1, 1, At, B1); PG8_BAR; PG8_SCHED;
            PG8_LDB(B0, 1, 0); PG8_LDB(B1, 1, 1); PG8_SCHED; PG8_LDA(At, 1, 0); PG8_STA(PG8_SA(0, 1), a2, a2, 1, gs);
            PG8_WAIT_V(8); PG8_WAIT_L(0); PG8_BAR; PG8_MMA(0, 0, At, B0); PG8_MMA(0, 1, At, B1); PG8_BAR; PG8_SCHED;
            PG8_LDA(At, 1, 1); PG8_STAGE(PG8_SB(1, 0), b3, voffB); PG8_STAGE(PG8_SB(1, 1), b3 + hstep, voffB); PG8_STA(PG8_SA(1, 0), a3, a3, 0, gs);
            PG8_WAIT_V(8); PG8_WAIT_L(0); PG8_BAR; PG8_MMA(1, 0, At, B0); PG8_MMA(1, 1, At, B1); PG8_BAR; PG8_SCHED;
        }
        if (wr == 0) PG8_BAR;
        E(acc, cur, wr, wc, fr, fq, lane, xlds);
        if (!has_next) break;
#pragma unroll
        for (int a = 0; a < 2; ++a)
#pragma unroll
            for (int b = 0; b < 2; ++b)
#pragma unroll
                for (int m = 0; m < 4; ++m)
#pragma unroll
                    for (int n = 0; n < 2; ++n) acc[a][b][m][n] = (f32x4){0.f, 0.f, 0.f, 0.f};
        cur = nxt; cA = nA; cB = nB; ++ui; if constexpr (KS) nt = cur.nkt;
#pragma unroll
        for (int h = 0; h < 2; ++h)
#pragma unroll
            for (int i = 0; i < 2; ++i) gc[h][i] = gn[h][i];
        if (wr == 1) PG8_BAR;
    }
    PG8_WAIT_V(0);
    PG8_BAR;
#undef PG8_SA
#undef PG8_SB
#undef PG8_STAGE
#undef PG8_STA
#undef PG8_LDA
#undef PG8_LDB
#undef PG8_MMA
#undef PG8_WAIT_V
#undef PG8_WAIT_L
#undef PG8_BAR
#undef PG8_SCHED
#undef PG8_GFILL
}
}
namespace att {
#define ALAS __attribute__((address_space(3)))
typedef unsigned short bf16_t;
typedef short bf16x8 __attribute__((ext_vector_type(8)));
typedef short s16x4 __attribute__((ext_vector_type(4)));
typedef float f32x16 __attribute__((ext_vector_type(16)));
typedef float f32x4 __attribute__((ext_vector_type(4)));
typedef unsigned u32x4 __attribute__((ext_vector_type(4)));
typedef ALAS char* lptr;
constexpr int NW = 8, QBLK = 32, KVBLK = 64, QB = NW * QBLK;
constexpr int SHM_V = KVBLK * 128 * 2;
constexpr int TBL_U0 = 2400, TBL_N = 2688;
constexpr float THR = 8.f;

template <int DQK_, int QP_, int KP_, int VP_, int OP_, bool TBL_, int LP_ = 0, int JMIN_ = 0> struct Cfg {
    static constexpr int DQK = DQK_, QP = QP_, KP = KP_, VP = VP_, OP = OP_, LP = LP_, JMIN = JMIN_; static constexpr bool TBL = TBL_;
    static constexpr int ND = DQK / 16, NKC = DQK / 64, KROW = DQK * 2, SHM_K = KVBLK * DQK * 2;
    static constexpr float SCALE = (DQK == 128) ? 0.08838834764831845f : 0.07216878364870323f;
    static constexpr int OFF_K = 0, OFF_V = 2 * SHM_K, OFF_WS = 2 * SHM_V + 2 * SHM_K;
    static constexpr int OFF_TBL = OFF_WS + NW * 64 * 4, OFF_QR = OFF_TBL + (TBL ? TBL_N * 4 : 0), LDS_BYTES = OFF_QR + (DQK > 128 ? NW * 4096 : 0);
    static_assert(LDS_BYTES <= 131072, "attention LDS");
};

#define SBAR() __builtin_amdgcn_sched_barrier(0)
__device__ __forceinline__ int v_st(int k, int c) { const int kk = (k & ~0xC) | ((k & 4) << 1) | ((k & 8) >> 1); return ((kk >> 3) * 4 + (c >> 5)) * 512 + ((kk & 7) * 32 + (c & 31)) * 2; }
__device__ __forceinline__ int v_rd_base(int lane) { return ((lane & 3) << 3) | (((lane >> 2) & 3) << 6) | (((lane >> 4) & 1) << 5) | (((lane >> 5) & 1) << 8); }
constexpr int v_rd_off(int d0, int ks, int half) { return d0 * 512 + ks * 4096 + half * 2048; }
__device__ __forceinline__ int crow(int r, int hi) { return (r & 3) + 8 * (r >> 2) + 4 * hi; }
__device__ __forceinline__ unsigned cvtpk(float lo, float hi) { unsigned r; asm volatile("v_cvt_pk_bf16_f32 %0, %1, %2" : "=v"(r) : "v"(lo), "v"(hi)); return r; }
__device__ __forceinline__ bf16x8 ld8(const bf16_t* p) { return *reinterpret_cast<const bf16x8*>(p); }
__device__ __forceinline__ bf16x8 ld8u(const bf16_t* ubase, unsigned boff) { return *reinterpret_cast<const bf16x8*>((const char*)ubase + boff); }

__device__ __forceinline__ void mask_tile(f32x16& p0, f32x16& p1, int dq) {
    const float NEG = -__builtin_inff();
#pragma unroll
    for (int r = 0; r < 16; ++r) {
        const int c = (r & 3) + 8 * (r >> 2);
        if (dq - c < 0) p0[r] = NEG;
        if (dq - c - 32 < 0) p1[r] = NEG;
    }
}
__device__ __forceinline__ void table_tile(f32x16& p0, f32x16& p1, const ALAS float* tb) {
#pragma unroll
    for (int r = 0; r < 16; ++r) {
        const int c = (r & 3) + 8 * (r >> 2);
        p0[r] += tb[c]; p1[r] += tb[c + 32];
    }
}
template <class C>
__device__ __forceinline__ void partialSM(f32x16& p0, f32x16& p1, float& m_reg, float& mn, float& alpha) {
    float pmax = p0[0];
#pragma unroll
    for (int r = 1; r < 16; ++r) pmax = fmaxf(pmax, p0[r]);
#pragma unroll
    for (int r = 0; r < 16; ++r) pmax = fmaxf(pmax, p1[r]);
    { auto rr = __builtin_amdgcn_permlane32_swap(__float_as_uint(pmax), __float_as_uint(pmax), false, false);
      pmax = fmaxf(__uint_as_float(rr[0]), __uint_as_float(rr[1])); }
    constexpr float C2 = 1.4426950408889634f * C::SCALE;
    if (__builtin_expect(__all((pmax - m_reg) * C::SCALE <= THR), 1)) { mn = m_reg; alpha = 1.f; }
    else { mn = fmaxf(m_reg, pmax); alpha = __builtin_amdgcn_exp2f((m_reg - mn) * C2); m_reg = mn; }
    const float mnL = -mn * C2;
#pragma unroll
    for (int r = 0; r < 16; ++r) p0[r] = fmaf(p0[r], C2, mnL);
#pragma unroll
    for (int r = 0; r < 16; ++r) p1[r] = fmaf(p1[r], C2, mnL);
#pragma unroll
    for (int r = 0; r < 16; ++r) p0[r] = __builtin_amdgcn_exp2f(p0[r]);
}
__device__ __forceinline__ void finishSM(f32x16& p0, f32x16& p1, float alpha, float& l_reg, bf16x8& pa0, bf16x8& pa1, bf16x8& pa2, bf16x8& pa3) {
#pragma unroll
    for (int r = 0; r < 16; ++r) p1[r] = __builtin_amdgcn_exp2f(p1[r]);
    float ps = 0;
#pragma unroll
    for (int r = 0; r < 16; ++r) ps += p0[r];
#pragma unroll
    for (int r = 0; r < 16; ++r) ps += p1[r];
    { auto rr = __builtin_amdgcn_permlane32_swap(__float_as_uint(ps), __float_as_uint(ps), false, false);
      ps = __uint_as_float(rr[0]) + __uint_as_float(rr[1]); }
    l_reg = l_reg * alpha + ps;
#define PK4(P, B_, OUT) do { unsigned a0 = cvtpk(P[B_+0], P[B_+1]), a1 = cvtpk(P[B_+2], P[B_+3]);                          \
        unsigned b0 = cvtpk(P[B_+4], P[B_+5]), b1 = cvtpk(P[B_+6], P[B_+7]);                                             \
        auto r0 = __builtin_amdgcn_permlane32_swap(a0, b0, false, false); auto r1 = __builtin_amdgcn_permlane32_swap(a1, b1, false, false); \
        u32x4 w = {r0[0], r1[0], r0[1], r1[1]}; OUT = *reinterpret_cast<bf16x8*>(&w); } while (0)
    PK4(p0, 0, pa0); PK4(p0, 8, pa1); PK4(p1, 0, pa2); PK4(p1, 8, pa3);
#undef PK4
}
template <class C, int KB>
__device__ __forceinline__ void qkt(f32x16& p0, f32x16& p1, lptr K_lds, int r32, int hi, const bf16x8* qr, lptr qlds) {
    p0 = f32x16{}; p1 = f32x16{};
    lptr kb[4];
#pragma unroll
    for (int dd = 0; dd < 4; ++dd) {
        const int sw = (C::DQK == 128) ? (r32 & 7) : ((r32 >> 1) & 7);
        kb[dd] = K_lds + KB * C::SHM_K + r32 * C::KROW + 16 * ((2 * dd + hi) ^ sw);
    }
#pragma unroll
    for (int d0 = 0; d0 < C::ND; ++d0) { lptr a = kb[d0 & 3] + (d0 >> 2) * 128;
        bf16x8 b0 = *reinterpret_cast<const ALAS bf16x8*>(a);
        bf16x8 b1 = *reinterpret_cast<const ALAS bf16x8*>(a + 32 * C::KROW);
        bf16x8 q; if (d0 < 8) q = qr[d0]; else q = *reinterpret_cast<const ALAS bf16x8*>(qlds + (d0 - 8) * 1024);
        p0 = __builtin_amdgcn_mfma_f32_32x32x16_bf16(b0, q, p0, 0, 0, 0);
        p1 = __builtin_amdgcn_mfma_f32_32x32x16_bf16(b1, q, p1, 0, 0, 0); }
}
template <int VB>
__device__ __forceinline__ void pv_tile(f32x16* o, int vb0, bf16x8 pa0, bf16x8 pa1, bf16x8 pa2, bf16x8 pa3) {
#define TRRD(dst, off) asm volatile("ds_read_b64_tr_b16 %0, %1 offset:%2" : "=&v"(dst) : "v"(vb0), "i"(off) : "memory")
#define PV_D0(d0) do { s16x4 l0, l1, l2, l3, h0, h1, h2, h3; constexpr int b_ = VB * SHM_V + v_rd_off(d0, 0, 0); \
        TRRD(l0, b_); TRRD(h0, b_ + 2048); TRRD(l1, b_ + 4096); TRRD(h1, b_ + 6144); TRRD(l2, b_ + 8192); TRRD(h2, b_ + 10240); TRRD(l3, b_ + 12288); TRRD(h3, b_ + 14336); \
        asm volatile("s_waitcnt lgkmcnt(0)" ::: "memory"); SBAR();   \
        o[d0] = __builtin_amdgcn_mfma_f32_32x32x16_bf16(pa0, (bf16x8){l0[0], l0[1], l0[2], l0[3], h0[0], h0[1], h0[2], h0[3]}, o[d0], 0, 0, 0);   \
        o[d0] = __builtin_amdgcn_mfma_f32_32x32x16_bf16(pa1, (bf16x8){l1[0], l1[1], l1[2], l1[3], h1[0], h1[1], h1[2], h1[3]}, o[d0], 0, 0, 0);   \
        o[d0] = __builtin_amdgcn_mfma_f32_32x32x16_bf16(pa2, (bf16x8){l2[0], l2[1], l2[2], l2[3], h2[0], h2[1], h2[2], h2[3]}, o[d0], 0, 0, 0);   \
        o[d0] = __builtin_amdgcn_mfma_f32_32x32x16_bf16(pa3, (bf16x8){l3[0], l3[1], l3[2], l3[3], h3[0], h3[1], h3[2], h3[3]}, o[d0], 0, 0, 0); } while (0)
    PV_D0(0); PV_D0(1); PV_D0(2); PV_D0(3);
#undef PV_D0
#undef TRRD
}

struct BlockRef { const bf16_t* Q; const bf16_t* K; const bf16_t* V; bf16_t* O; float* lse; int P0; };
template <class C> struct Seam { bf16x8 qr[C::ND]; bf16x8 st_v0, st_v1; bf16x8 st_k[C::NKC]; };
__device__ __forceinline__ int swa_jlo(int P0, int W) { const int lowk = P0 - W + 1; return lowk > 0 ? lowk / KVBLK : 0; }

#define VMW() asm volatile("s_waitcnt vmcnt(0)" ::: "memory")
#define VMWN(n) asm volatile("s_waitcnt vmcnt(%0)" :: "i"(n) : "memory")
#define SLOAD_H(Kp, Vp, k0) do { const bf16_t* vu_ = (Vp) + (size_t)(k0) * C::VP; const bf16_t* ku_ = (Kp) + (size_t)(k0) * C::KP;                        \
        S.st_v0 = ld8u(vu_, voffV); S.st_v1 = ld8u(vu_ + 32 * C::VP, voffV);     \
        if constexpr (C::DQK == 128) { S.st_k[0] = ld8u(ku_, voffK); S.st_k[1] = ld8u(ku_ + 32 * C::KP, voffK); } \
        else { _Pragma("unroll") for (int i_ = 0; i_ < 3; ++i_) S.st_k[i_] = ld8u(ku_ + 64 * i_, voffK); } } while (0)
#define SWRITE_HK(bf) do { if constexpr (C::DQK == 128) { *(ALAS bf16x8*)(K_lds + (bf) * C::SHM_K + kws) = S.st_k[0]; *(ALAS bf16x8*)(K_lds + (bf) * C::SHM_K + kws + 32 * 256) = S.st_k[1]; } \
        else { _Pragma("unroll") for (int i_ = 0; i_ < 3; ++i_) *(ALAS bf16x8*)(K_lds + (bf) * C::SHM_K + kws + 128 * i_) = S.st_k[i_]; } } while (0)
#define SWRITE_HV(bf) do { *(ALAS bf16x8*)(V_lds + (bf) * SHM_V + vst0) = S.st_v0; *(ALAS bf16x8*)(V_lds + (bf) * SHM_V + vst1) = S.st_v1; } while (0)
#define SWRITE_H(bf) do { SWRITE_HV(bf); SWRITE_HK(bf); } while (0)
#define ATT_IDX() int lane_; asm volatile("v_mbcnt_lo_u32_b32 %0, -1, 0\n\tv_mbcnt_hi_u32_b32 %0, -1, %0" : "=v"(lane_)); const int lane = lane_, tid = wid * 64 + lane, r32 = lane & 31, hi = lane >> 5; \
    const int sr = tid >> 4, sc = (tid & 15) * 8, kr = tid >> 3, kc = (tid & 7) * 8; \
    const int kws = (C::DQK == 128) ? (sr * 256 + ((sc * 2) ^ ((sr & 7) << 4))) : (kr * 384 + 16 * ((tid & 7) ^ ((kr >> 1) & 7))); \
    const unsigned voffV = (unsigned)(sr * C::VP + sc) * 2u, voffK = (C::DQK == 128) ? (unsigned)(sr * C::KP + sc) * 2u : (unsigned)(kr * C::KP + kc) * 2u, voffQ = (unsigned)((wid * QBLK + r32) * C::QP + hi * 8) * 2u; \
    (void)wid; (void)lane; (void)r32; (void)hi; (void)kr; (void)kc; (void)sr; (void)sc; (void)kws; (void)voffV; (void)voffK; (void)voffQ

template <class C>
__device__ __forceinline__ void prime(const BlockRef& cur, int W, lptr lds, Seam<C>& S, const int wid) {
    ATT_IDX(); lptr K_lds = lds + C::OFF_K;
    const int kb0 = swa_jlo(cur.P0, W) * KVBLK;
#pragma unroll
    for (int d0 = 0; d0 < C::ND; ++d0) S.qr[d0] = ld8u(cur.Q + d0 * 16, voffQ);
    SLOAD_H(cur.K, cur.V, kb0); VMW(); SWRITE_HK(0);
    __syncthreads();
}
template <class C>
__device__ __forceinline__ void block(const BlockRef& cur, const BlockRef& nxt, int skv, int W, lptr lds, Seam<C>& S, const int wid) {
    ATT_IDX();
    const int j_lo = swa_jlo(cur.P0, W);
    int j_hi = (cur.P0 + QB - 1 - C::JMIN) / KVBLK + 1; if (j_hi > skv / KVBLK) j_hi = skv / KVBLK;
    const int NT = j_hi - j_lo;
    const int kbn = swa_jlo(nxt.P0, W) * KVBLK;
    const int qlo = cur.P0 + wid * QBLK, qm = qlo + r32 - 4 * hi;
    lptr V_lds = lds + C::OFF_V; lptr K_lds = lds + C::OFF_K;
    ALAS float* ws = (ALAS float*)(lds + C::OFF_WS) + wid * 64; ALAS float* li_l = ws; ALAS float* al_l = ws + 32;
    const ALAS float* tbl = (const ALAS float*)(lds + C::OFF_TBL);
    float m_reg = -1e30f, l_reg = 0; f32x16 o[4] = {};
    const int vst0 = v_st(sr, sc), vst1 = v_st(32 + sr, sc);
    const int vb0 = (int)(unsigned)(uintptr_t)V_lds + v_rd_base(lane);
    const bf16_t* Kh = cur.K; const bf16_t* Vh = cur.V;
#define RESC(a) do { if (__any((a) < 1.f)) { if (hi == 0) al_l[r32] = (a); asm volatile("s_waitcnt lgkmcnt(0)" ::: "memory");              \
                     _Pragma("unroll") for (int d_ = 0; d_ < 4; ++d_) _Pragma("unroll") for (int r = 0; r < 16; ++r) o[d_][r] *= al_l[crow(r, hi)]; } } while (0)
#define KBASE(t) ((j_lo + (t)) * KVBLK)
#define MASKT(P0_, P1_, t) do { const int kb_ = KBASE(t); if constexpr (C::TBL) { table_tile(P0_, P1_, tbl + (TBL_U0 - (qm - kb_))); } \
                                else { if (kb_ + KVBLK - 1 > qlo) mask_tile(P0_, P1_, qm - kb_); } } while (0)
#define SEAM_K0() do { VMWN(C::ND); SWRITE_HK(0); SBAR(); } while (0)
    f32x16 pA0, pA1, pB0, pB1; float mnA, mnB, alA, alB; bf16x8 pa0, pa1, pa2, pa3;
    lptr qlds = lds + C::OFF_QR + wid * 4096 + lane * 16;
    if constexpr (C::DQK > 128) {
#pragma unroll
        for (int d0 = 8; d0 < C::ND; ++d0) *reinterpret_cast<ALAS bf16x8*>(qlds + (d0 - 8) * 1024) = S.qr[d0]; }
    SWRITE_HV(0); SBAR();
    if (NT > 1) { SLOAD_H(Kh, Vh, KBASE(1)); }
    SBAR(); qkt<C, 0>(pA0, pA1, K_lds, r32, hi, S.qr, qlds);
    MASKT(pA0, pA1, 0); partialSM<C>(pA0, pA1, m_reg, mnA, alA);
    if (NT > 1) { VMW(); SWRITE_H(1); }
    __syncthreads();
#define HALF_STEP(PX0, PX1, mnX, alX, PY0, PY1, alY, t, KB, VB, SB) do {                                                      \
        SBAR(); qkt<C, KB>(PX0, PX1, K_lds, r32, hi, S.qr, qlds);                                                                   \
        finishSM(PY0, PY1, alY, l_reg, pa0, pa1, pa2, pa3); SBAR();                                                           \
        if ((t) + 1 < NT) { SLOAD_H(Kh, Vh, KBASE((t) + 1)); SBAR(); }                                                        \
        pv_tile<VB>(o, vb0, pa0, pa1, pa2, pa3); MASKT(PX0, PX1, (t)); partialSM<C>(PX0, PX1, m_reg, mnX, alX);               \
        __syncthreads();                                                                                                      \
        if ((t) + 1 < NT) { VMW(); SWRITE_H(SB); }                                                                            \
        RESC(alX); __syncthreads(); } while (0)
    for (int t = 1; t + 1 < NT; t += 2) {
#ifdef ALOOP_ALIGN
        asm volatile(".p2align 6\n\t.rept " ALOOP_ALIGN "\n\ts_nop 0\n\t.endr");
#endif
#ifdef ALOOP_ALIGN3
        if constexpr (C::DQK == 192) asm volatile(".p2align 6\n\t.rept " ALOOP_M "\n\ts_nop 0\n\t.endr"); else if constexpr (C::JMIN == 0) asm volatile(".p2align 6\n\t.rept " ALOOP_A "\n\ts_nop 0\n\t.endr"); else asm volatile(".p2align 6\n\t.rept " ALOOP_B "\n\ts_nop 0\n\t.endr");
#endif
        HALF_STEP(pB0, pB1, mnB, alB, pA0, pA1, alA, t, 1, 0, 0);
        HALF_STEP(pA0, pA1, mnA, alA, pB0, pB1, alB, t + 1, 0, 1, 1);
    }
    {
    int lane2_; asm volatile("v_mbcnt_lo_u32_b32 %0, -1, 0\n\tv_mbcnt_hi_u32_b32 %0, -1, %0" : "=v"(lane2_));
    const int lane = lane2_, r32 = lane & 31, hi = lane >> 5, qm = qlo + r32 - 4 * hi;
    const unsigned voffQ = (unsigned)((wid * QBLK + r32) * C::QP + hi * 8) * 2u;
    lptr qlds = lds + C::OFF_QR + wid * 4096 + lane * 16; (void)qlds; (void)qm;
    const bool even = (NT & 1) == 0;
    if (even) { SBAR(); qkt<C, 1>(pB0, pB1, K_lds, r32, hi, S.qr, qlds); SBAR(); }
    SLOAD_H(nxt.K, nxt.V, kbn); SBAR();
#pragma unroll
    for (int d0 = 0; d0 < C::ND; ++d0) S.qr[d0] = ld8u(nxt.Q + d0 * 16, voffQ);
    SBAR();
    finishSM(pA0, pA1, alA, l_reg, pa0, pa1, pa2, pa3); SBAR();
    pv_tile<0>(o, vb0, pa0, pa1, pa2, pa3);
    if (even) { MASKT(pB0, pB1, NT - 1); partialSM<C>(pB0, pB1, m_reg, mnB, alB); __syncthreads(); RESC(alB);
        finishSM(pB0, pB1, alB, l_reg, pa0, pa1, pa2, pa3); SBAR(); pv_tile<1>(o, vb0, pa0, pa1, pa2, pa3); }
    SBAR(); SEAM_K0();
    if (hi == 0) li_l[r32] = l_reg; asm volatile("s_waitcnt lgkmcnt(0)" ::: "memory");
    float rli[16];
#pragma unroll
    for (int r = 0; r < 16; ++r) { const float lv = li_l[crow(r, hi)]; rli[r] = lv > 0.f ? __builtin_amdgcn_rcpf(lv) : 0.f; }
    if constexpr (C::LP > 0) { if (hi == 0) cur.lse[(size_t)(wid * QBLK + r32) * C::LP] = l_reg > 0.f ? m_reg * C::SCALE + __logf(l_reg) : -__builtin_inff(); }
    char* const Ou = (char*)cur.O;
    const unsigned ooff = (unsigned)((wid * QBLK + 4 * hi) * C::OP + r32) * 2u;
#pragma unroll
    for (int r = 0; r < 16; ++r) { const int orow = (r & 3) + 8 * (r >> 2);
#pragma unroll
        for (int d0 = 0; d0 < 4; ++d0) { const float v = o[d0][r] * rli[r];
            const float vn = __builtin_bit_cast(float, __builtin_amdgcn_mov_dpp(__builtin_bit_cast(int, v), 0xB1, 0xF, 0xF, true));
            if ((r32 & 1) == 0) *(unsigned*)(Ou + ooff + (unsigned)(orow * C::OP + d0 * 32) * 2u) = cvtpk(v, vn); } }
    }
    __syncthreads();
#undef RESC
#undef KBASE
#undef MASKT
#undef SEAM_K0
#undef HALF_STEP
}
#undef VMW
#undef VMWN
#undef SLOAD_H
#undef SWRITE_HK
#undef SWRITE_HV
#undef SWRITE_H
#undef ATT_IDX
#undef SBAR
}
constexpr int NWAVES = 8;
constexpr int S_ = 16384, DM = 2048, NLAYER = 2;
constexpr int WA = 1024, QLORA = 512, KVLORA = 256, ROPE = 64, INC = 3904, INP = 4096;
constexpr int C_QA = 0, C_KA = 1024, C_VA = 2048, C_CQ = 3072, C_CKV = 3584, C_KR = 3840;
constexpr int NH = 8, HD = 128, QKB = 192, NQB_ = 1536  , NKVB = 2048  ;
constexpr int FF = 5632, NEXP = 8, NGU = 2 * FF  , NT_GU = NGU / 256  , NT_D = DM / 256  ;
constexpr int MT_MAX = 136;
constexpr float EPS = 1e-6f;
constexpr int W_DIL = 2049;
constexpr int W_CAUSAL = 0x40000000;

constexpr size_t MiB = 1u << 20;
constexpr size_t WS_CTL = 0, CTL_ZERO_BYTES = 32 * 1024;
constexpr size_t WS_TBL = 1 * MiB;
constexpr size_t WS_POS = 1 * MiB + 512 * 1024;
constexpr size_t WS_LTOK = 2 * MiB;
constexpr size_t WS_LGATE = 2 * MiB + 512 * 1024;
constexpr size_t WS_SSQ0 = 3 * MiB;
constexpr size_t WS_SSQX = WS_SSQ0 + 64 * 1024;
constexpr size_t WS_SSQC = WS_SSQX + 1 * MiB;
static_assert(WS_SSQC + 256 * 1024 <= 6 * MiB, "ws map");
constexpr size_t WS_WIN = 6 * MiB;
constexpr size_t WS_WQB = WS_WIN + 32 * MiB;
constexpr size_t WS_WKVB = WS_WQB + 3 * MiB;
constexpr size_t WS_WOUT = WS_WKVB + 2 * MiB;
constexpr size_t WS_WGU = WS_WOUT + 16 * MiB;
constexpr size_t WS_WD = WS_WGU + 44 * MiB;
constexpr size_t WS_WGUE = WS_WD + 22 * MiB;
constexpr size_t WS_WDE = WS_WGUE + 352 * MiB;
constexpr size_t WS_H = WS_WDE + 176 * MiB;
constexpr size_t WS_ACTS = WS_H + 64 * MiB;
constexpr size_t WS_PROJ = WS_ACTS;
constexpr size_t WS_QM = WS_PROJ + 128 * MiB;
constexpr size_t WS_KVM = WS_QM + 48 * MiB;
constexpr size_t WS_KM = WS_KVM + 64 * MiB;
constexpr size_t WS_CQN = WS_KM + 48 * MiB;
constexpr size_t WS_CKVN = WS_CQN + 16 * MiB;
constexpr size_t WS_ATT = WS_CKVN + 8 * MiB;
constexpr size_t WS_OA = WS_ATT + 64 * MiB, WS_OB = WS_OA + 32 * MiB;
constexpr size_t WS_LSEA = WS_OB + 32 * MiB, WS_LSEB = WS_LSEA + 1 * MiB;
constexpr size_t WS_ACT = WS_ACTS;
constexpr size_t WS_Y = WS_ACT + 374 * MiB;
constexpr size_t WS_PT = WS_Y + 136 * MiB;
constexpr size_t WS_HN = WS_PT + 32 * MiB;
constexpr size_t WS_END = WS_HN + 64 * MiB;
static_assert(WS_LSEB + 1 * MiB <= WS_END, "ws map");
static_assert((size_t)MT_MAX * 256 * FF * 2 <= 374 * MiB && (size_t)MT_MAX * 256 * DM * 2 <= 136 * MiB, "ws map");
constexpr int CW_TMO = 0, CW_CODE = 1;
constexpr int CW_CNT = 64;
constexpr int CW_BAR = 4096;

constexpr int RING_OFF = 0, RING_BYTES = 131072;
constexpr int LDSCTL_OFF = RING_BYTES, MISC_OFF = LDSCTL_OFF + 320, XLDS_OFF = RING_BYTES + 1024;
constexpr int LDS_BYTES = 147456;
static_assert(MISC_OFF + 128 <= XLDS_OFF && XLDS_OFF + 8192 <= LDS_BYTES, "LDS map");

#define GAS __attribute__((address_space(1)))
#define LAS __attribute__((address_space(3)))
typedef unsigned short bf16;
typedef unsigned v4u __attribute__((ext_vector_type(4)));
typedef unsigned v2u __attribute__((ext_vector_type(2)));
typedef float f32x4 __attribute__((ext_vector_type(4)));
typedef GAS unsigned gu32;
#define RLX_AGENT __ATOMIC_RELAXED, __HIP_MEMORY_SCOPE_AGENT
#define LDS_WAIT() asm volatile("s_waitcnt lgkmcnt(0)" ::: "memory")
#define VM_WAIT() asm volatile("s_waitcnt vmcnt(0)" ::: "memory")
__device__ __forceinline__ unsigned f2bf(float f) { unsigned u = __builtin_bit_cast(unsigned, f); return (u + 0x7fffu + ((u >> 16) & 1u)) >> 16; }
__device__ __forceinline__ unsigned pk2(float lo, float hi) { return f2bf(lo) | (f2bf(hi) << 16); }
__device__ __forceinline__ float bflo(unsigned w) { return __builtin_bit_cast(float, w << 16); }
__device__ __forceinline__ float bfhi(unsigned w) { return __builtin_bit_cast(float, w & 0xffff0000u); }

#define XB_TMO      128
#define XB_XCNT(j)  (256  + 64 * (j))
#define XB_XSUB(j)  (1280 + 64 * (j))
#define XB_XGEN(j)  (2304 + 64 * (j))
#define XB_TOP      3328
#define XB_TOPGEN   3392
#define XCD_BAR_WORDS 3456
#define XB_SPIN_CAP (1u << 20)
static_assert((size_t)(CW_BAR + XCD_BAR_WORDS) * 4 <= CTL_ZERO_BYTES && (size_t)(CW_CNT + 8 * 32) * 4 <= (size_t)CW_BAR * 4, "control words inside the zeroed region");

__device__ __forceinline__ unsigned xb_ld(gu32* p)              { return __hip_atomic_load(p, __ATOMIC_RELAXED, __HIP_MEMORY_SCOPE_AGENT); }
__device__ __forceinline__ unsigned xb_add(gu32* p, unsigned v) { return __hip_atomic_fetch_add(p, v, __ATOMIC_RELAXED, __HIP_MEMORY_SCOPE_AGENT); }
__device__ __forceinline__ unsigned xb_xcc_id() { return (unsigned)__builtin_amdgcn_s_getreg((3 << 11) | 20) & 0xFu; }
#define XB_SPIN(cond, bar) do { unsigned _sp = 0; while (cond) { __builtin_amdgcn_s_sleep(1); \
    if ((++_sp & 255u) == 0u) { if (xb_ld(&(bar)[XB_TMO])) break; if (_sp > XB_SPIN_CAP) { xb_add(&(bar)[XB_TMO], 1u); break; } } } } while (0)

struct XcdBarrier {
    gu32* bar; unsigned x;
    volatile LAS unsigned* st;
};
__device__ __forceinline__ XcdBarrier xcd_barrier_post(gu32* bar, volatile LAS unsigned* st) {
    XcdBarrier b; b.bar = bar; b.x = xb_xcc_id(); b.st = st;
    if (threadIdx.x == 0) (void)xb_add(&bar[XB_XCNT(b.x)], 1u);
    return b;
}
__device__ __forceinline__ void xcd_barrier_complete(gu32* bar, unsigned x, unsigned& nloc, unsigned& nx) {
    const unsigned G = gridDim.x * gridDim.y * gridDim.z;
    unsigned sum, cnt, mine, sp = 0u;
    for (;;) {
        sum = 0u; cnt = 0u; mine = 0u;
#pragma unroll
        for (unsigned j = 0; j < 16; ++j) { const unsigned c = xb_ld(&bar[XB_XCNT(j)]); sum += c; cnt += (c > 0u) ? 1u : 0u; mine = (j == x) ? c : mine; }
        if (sum == G) break;
        __builtin_amdgcn_s_sleep(1);
        if ((++sp & 255u) == 0u) { if (xb_ld(&bar[XB_TMO])) break; if (sp > XB_SPIN_CAP) { xb_add(&bar[XB_TMO], 1u); break; } }
    }
    nloc = mine > 0u ? mine : 1u; nx = cnt > 0u ? cnt : 1u;
}
__device__ __forceinline__ void xcd_barrier(const XcdBarrier& b) {
    asm volatile("s_waitcnt vmcnt(0)" ::: "memory");
    __syncthreads();
    if (threadIdx.x == 0) {
        gu32* bar = b.bar;
        __builtin_amdgcn_s_waitcnt(0);
        unsigned nloc = b.st[0], nx = b.st[1];
        if (nloc == 0u) { xcd_barrier_complete(bar, b.x, nloc, nx); b.st[0] = nloc; b.st[1] = nx; }
        const unsigned old = xb_add(&bar[XB_XSUB(b.x)], 1u);
        const unsigned gen = old / nloc;
        if (old + 1u == (gen + 1u) * nloc) {
            __builtin_amdgcn_fence(__ATOMIC_RELEASE, "agent");
            asm volatile("s_waitcnt vmcnt(0)" ::: "memory");
            const unsigned og = xb_add(&bar[XB_TOP], 1u);
            const unsigned tg = og / nx;
            if (og + 1u == (tg + 1u) * nx) xb_add(&bar[XB_TOPGEN], 1u);
            else XB_SPIN(xb_ld(&bar[XB_TOPGEN]) == tg, bar);
            __builtin_amdgcn_fence(__ATOMIC_ACQUIRE, "agent");
            xb_add(&bar[XB_XGEN(b.x)], 1u);
            asm volatile("s_waitcnt vmcnt(0)" ::: "memory");
        } else {
            XB_SPIN(xb_ld(&bar[XB_XGEN(b.x)]) == gen, bar);
            __builtin_amdgcn_fence(__ATOMIC_ACQUIRE, "agent");
            asm volatile("s_waitcnt vmcnt(0)" ::: "memory");
        }
    }
    __syncthreads();
}

struct Args { const void* in[22]; float* out; unsigned char* ws; int ph_lo, ph_hi, use_bar, pad; };
struct ArgsD { const GAS void* in[22]; GAS float* out; GAS unsigned char* ws; int ph_lo, ph_hi, use_bar, pad; };
static_assert(sizeof(ArgsD) == sizeof(Args), "ArgsD");
typedef const __attribute__((address_space(4))) ArgsD* KArgs;
__device__ __forceinline__ KArgs kargs() { KArgs p = (KArgs)__builtin_amdgcn_kernarg_segment_ptr(); asm volatile("" : "+s"(p)); return p; }
struct Frame {
    LAS unsigned char* lds;
    int vcu, G, wave;
};
#define PH_IDX() int lane_; asm volatile("v_mbcnt_lo_u32_b32 %0, -1, 0\n\tv_mbcnt_hi_u32_b32 %0, -1, %0" : "=v"(lane_)); const int lane = lane_, wave = F.wave, tid = wave * 64 + lane; (void)tid; (void)lane; (void)wave
__device__ __forceinline__ float shx(float v, int lane, int o) { return __builtin_bit_cast(float, __builtin_amdgcn_ds_bpermute((lane ^ o) << 2, __builtin_bit_cast(int, v))); }
__device__ __forceinline__ float wave_sum(float v, int lane) {
#pragma unroll
    for (int o = 1; o < 64; o <<= 1) v += shx(v, lane, o);
    return v;
}

template <bool GAIN>
__device__ __forceinline__ void xpose_item(const float* W, int K, int N, bf16* WT, int k0, int n0, int drow0, LAS float* scr, int lane, const float* gk) {
    float gl = 1.0f, gh = 1.0f; if constexpr (GAIN) { gl = gk[k0 + (lane & 31)]; gh = gk[k0 + 32 + (lane & 31)]; }
    float w[32];
    const GAS float* src = (const GAS float*)W + (size_t)(k0 + (lane >> 5)) * N + n0 + (lane & 31);
#pragma unroll
    for (int i = 0; i < 32; ++i) w[i] = __builtin_nontemporal_load(src + (size_t)(2 * i) * N);
#pragma unroll
    for (int i = 0; i < 32; ++i) { const int kk = 2 * i + (lane >> 5); float v = w[i];
        if constexpr (GAIN) { const float gsel = (i >= 16) ? gh : gl; v *= __builtin_bit_cast(float, __builtin_amdgcn_ds_bpermute((kk & 31) << 2, __builtin_bit_cast(int, gsel))); }
        scr[kk * 33 + (lane & 31)] = v; }
    LDS_WAIT(); asm volatile("" ::: "memory");
    const int c = lane & 7;
#pragma unroll
    for (int j = 0; j < 4; ++j) { const int n = (lane >> 3) + 8 * j; const LAS float* s = scr + (8 * c) * 33 + n;
        v4u o; o.x = pk2(s[0 * 33], s[1 * 33]); o.y = pk2(s[2 * 33], s[3 * 33]); o.z = pk2(s[4 * 33], s[5 * 33]); o.w = pk2(s[6 * 33], s[7 * 33]);
        __builtin_nontemporal_store(o, (GAS v4u*)(WT + (size_t)(drow0 + n) * K + k0 + 8 * c)); }
    LDS_WAIT(); asm volatile("" ::: "memory");
}
constexpr int IT_WIN1 = 32 * 122, IT_WQB1 = 8 * 48, IT_WKVB1 = 4 * 64, IT_WOUT1 = 32 * 64, IT_GU1 = 32 * 176, IT_D1 = 88 * 64;
constexpr int IT_EARLY = IT_WIN1 + IT_WQB1 + IT_WKVB1;
constexpr int IT_LATE = IT_WIN1 + IT_WQB1 + IT_WKVB1 + 2 * IT_WOUT1 + 2 * IT_GU1 + IT_D1 + 16 * IT_GU1 + 8 * IT_D1, IT_TOTAL = IT_EARLY + IT_LATE;
static_assert(IT_LATE % 2 == 0, "late items split in two halves");
__device__ __forceinline__ void conv_item(KArgs a, int it, LAS float* scr, int lane) {
    unsigned char* ws = (unsigned char*)a->ws;
    const float* W; bf16* WT; int K, N, kb, nb, drow0; const float* gk = nullptr;
    int l = 0; if (it >= IT_EARLY) { it -= IT_EARLY; l = 1; }
    if (it < IT_WIN1) { const int r = it; kb = r / 122; nb = r % 122; K = DM; N = INC; W = (const float*)a->in[4] + (size_t)l * DM * INC; WT = (bf16*)(ws + WS_WIN) + (size_t)l * INP * DM; drow0 = 32 * nb; gk = (const float*)a->in[3] + l * DM; }
    else if ((it -= IT_WIN1) < IT_WQB1) { const int r = it; kb = r / 48; nb = r % 48; K = QLORA; N = NQB_; W = (const float*)a->in[7] + (size_t)l * QLORA * NQB_; WT = (bf16*)(ws + WS_WQB) + (size_t)l * NQB_ * QLORA; drow0 = 32 * nb; gk = (const float*)a->in[5] + l * QLORA; }
    else if ((it -= IT_WQB1) < IT_WKVB1) { const int r = it; kb = r / 64; nb = r % 64; K = KVLORA; N = NKVB; W = (const float*)a->in[8] + (size_t)l * KVLORA * NKVB; WT = (bf16*)(ws + WS_WKVB) + (size_t)l * NKVB * KVLORA; drow0 = 32 * nb; }
    else if ((it -= IT_WKVB1) < 2 * IT_WOUT1) { const int lo = it / IT_WOUT1, r = it % IT_WOUT1; kb = r / 64; nb = r % 64; K = DM; N = DM; W = (const float*)a->in[13] + (size_t)lo * DM * DM; WT = (bf16*)(ws + WS_WOUT) + (size_t)lo * DM * DM; drow0 = 32 * nb; }
    else if ((it -= 2 * IT_WOUT1) < 2 * IT_GU1) { const int isup = it / IT_GU1, r = it % IT_GU1; kb = r / 176; nb = r % 176; K = DM; N = FF;
        W = isup ? (const float*)a->in[16] : (const float*)a->in[15]; WT = (bf16*)(ws + WS_WGU);
        const int n0 = 32 * nb; drow0 = 256 * (n0 >> 7) + (n0 & 127) + (isup ? 128 : 0); gk = (const float*)a->in[14]; }
    else if ((it -= 2 * IT_GU1) < IT_D1) { const int r = it; kb = r / 64; nb = r % 64; K = FF; N = DM; W = (const float*)a->in[17]; WT = (bf16*)(ws + WS_WD); drow0 = 32 * nb; }
    else if ((it -= IT_D1) < 16 * IT_GU1) { const int m = it / IT_GU1, r = it % IT_GU1; kb = r / 176; nb = r % 176; const int isup = m >> 3, e = m & 7; K = DM; N = FF;
        W = (isup ? (const float*)a->in[20] : (const float*)a->in[19]) + (size_t)e * DM * FF; WT = (bf16*)(ws + WS_WGUE) + (size_t)e * NGU * DM;
        const int n0 = 32 * nb; drow0 = 256 * (n0 >> 7) + (n0 & 127) + (isup ? 128 : 0); }
    else { it -= 16 * IT_GU1; const int e = it / IT_D1, r = it % IT_D1; kb = r / 64; nb = r % 64; K = FF; N = DM;
        W = (const float*)a->in[21] + (size_t)e * FF * DM; WT = (bf16*)(ws + WS_WDE) + (size_t)e * DM * FF; drow0 = 32 * nb; }
    if (gk) xpose_item<true>(W, K, N, WT, 64 * kb, 32 * nb, drow0, scr, lane, gk); else xpose_item<false>(W, K, N, WT, 64 * kb, 32 * nb, drow0, scr, lane, gk);
}
__device__ __forceinline__ void late_convert(Frame& F, KArgs a, int part) {
    PH_IDX();
    LAS float* scr = (LAS float*)(F.lds + RING_OFF + wave * 16384);
    const int bx = (int)blockIdx.x, cgw = ((bx >> 3) * 4 + (bx & 3)) * NWAVES + wave, CNGW = (F.G / 2) * NWAVES;
    for (int it = IT_EARLY + part * (IT_LATE / 2) + cgw; it < IT_EARLY + (part + 1) * (IT_LATE / 2); it += CNGW) conv_item(a, it, scr, lane);
}
__device__ __forceinline__ void p0_prologue(Frame& F, KArgs a) {
    PH_IDX();
    unsigned char* ws = (unsigned char*)a->ws;
    LAS float* scr = (LAS float*)(F.lds + RING_OFF + wave * 16384);
    const int gw = F.vcu * NWAVES + wave, NGW = F.G * NWAVES;
    const int it_end = (F.G % 8 == 0) ? IT_EARLY : IT_TOTAL;
    for (int it0 = gw; it0 < it_end; it0 += NGW) conv_item(a, it0, scr, lane);
    for (int r = gw; r < 2 * (INP - INC); r += NGW) { const int l = r / (INP - INC), rr = INC + r % (INP - INC);
        GAS v4u* p = (GAS v4u*)((bf16*)(ws + WS_WIN) + ((size_t)l * INP + rr) * DM) + lane;
#pragma unroll
        for (int j = 0; j < 4; ++j) p[64 * j] = (v4u){0u, 0u, 0u, 0u}; }
    { const float* x = (const float*)a->in[0]; bf16* H = (bf16*)(ws + WS_H); float* ssq0 = (float*)(ws + WS_SSQ0);
      for (int m = gw; m < S_; m += NGW) { const GAS f32x4* xr = (const GAS f32x4*)(x + (size_t)m * DM) + lane; GAS v2u* o8 = (GAS v2u*)(H + (size_t)m * DM) + lane; float ss = 0.f;
          f32x4 v[8];
#pragma unroll
          for (int j = 0; j < 8; ++j) v[j] = __builtin_nontemporal_load(xr + 64 * j);
#pragma unroll
          for (int j = 0; j < 8; ++j) { ss += (v[j].x * v[j].x + v[j].y * v[j].y) + (v[j].z * v[j].z + v[j].w * v[j].w); o8[64 * j] = (v2u){pk2(v[j].x, v[j].y), pk2(v[j].z, v[j].w)}; }
          ss = wave_sum(ss, lane); if (lane == 0) ssq0[m] = ss; } }
    { const float* rb = (const float*)a->in[2]; float* tbl = (float*)(ws + WS_TBL);
      for (int i = gw * 64 + lane; i < 2 * NH * att::TBL_N; i += NGW * 64) {
          const int pass = i / (NH * att::TBL_N), ii = i % (NH * att::TBL_N), h = ii / att::TBL_N, u = ii % att::TBL_N, st = att::TBL_U0 - u; float v = -__builtin_inff();
          int dl = -1, mu = 0;
          if (pass == 0) { if (st >= 0 && st <= 512) { dl = st; mu = (dl <= 128 ? 1 : 0) + (((dl & 3) == 0) ? 1 : 0) + (((dl & 15) == 0) ? 1 : 0); } }
          else { if (st >= 33 && st <= 128) { dl = 16 * st; mu = 1; } }
          if (mu > 0) { int bk; if (dl < 16) bk = dl; else { bk = 16 + (int)(logf((float)dl * 0.0625f) / 4.852030263919617f * 16.0f); if (bk > 31) bk = 31; }
              v = (rb[bk * NH + h] + logf((float)mu)) * 11.313708498984761f; }
          tbl[i] = v; } }
}

template <bool ROUTE, bool XB = false>
__device__ __forceinline__ void norm_rows(Frame& F, const float* x, const float* g, bf16* H, KArgs a, bool dry = false) {
    PH_IDX();
    const int gw = F.vcu * NWAVES + wave, NGW = F.G * NWAVES;
    LAS float* wr_l = (LAS float*)(F.lds + RING_OFF);
    if constexpr (ROUTE) {
        const float* wrt = (const float*)a->in[18];
        for (int i0 = tid; i0 < DM * NEXP; i0 += 8 * NWAVES * 64) { float t[8];
#pragma unroll
            for (int q = 0; q < 8; ++q) t[q] = wrt[i0 + q * NWAVES * 64];
#pragma unroll
            for (int q = 0; q < 8; ++q) { const int i = i0 + q * NWAVES * 64, k = i >> 3, e = i & 7; wr_l[e * DM + k] = t[q]; } }
        LDS_WAIT(); __syncthreads();
    }
    f32x4 gv[8];
#pragma unroll
    for (int j = 0; j < 8; ++j) gv[j] = ((const GAS f32x4*)g)[lane + 64 * j];
    LAS unsigned* lcnt = (LAS unsigned*)(F.lds + RING_OFF + 65536); LAS unsigned* lbase = lcnt + 8; LAS int* rec = (LAS int*)(F.lds + RING_OFF + 65536 + 256);
    const int NIT = (S_ + NGW - 1) / NGW;
    for (int c0 = 0; c0 < NIT; c0 += 8) {
        const int c1 = c0 + 8 < NIT ? c0 + 8 : NIT;
        if constexpr (ROUTE) { if (tid < 8) lcnt[tid] = 0u; LDS_WAIT(); __syncthreads(); }
        v2u raw[8];
        for (int ci = c0; ci < c1; ++ci) {
            const int m = gw + ci * NGW;
            if (m >= S_) { if constexpr (ROUTE) { if (lane == 0) rec[(wave * 8 + (ci - c0)) * 8] = -1; } continue; }
            f32x4 v[8]; float ss = 0.f;
            if constexpr (XB) {
                if (ci == c0) { const GAS v2u* xr = (const GAS v2u*)((const bf16*)x + (size_t)m * DM) + lane;
#pragma unroll
                    for (int j = 0; j < 8; ++j) raw[j] = xr[64 * j]; }
#pragma unroll
                for (int j = 0; j < 8; ++j) { const v2u w = raw[j]; v[j] = (f32x4){bflo(w.x), bfhi(w.x), bflo(w.y), bfhi(w.y)}; }
            } else { const GAS f32x4* xr = (const GAS f32x4*)(x + (size_t)m * DM) + lane;
#pragma unroll
                for (int j = 0; j < 8; ++j) v[j] = xr[64 * j]; }
#pragma unroll
            for (int j = 0; j < 8; ++j) ss += (v[j].x * v[j].x + v[j].y * v[j].y) + (v[j].z * v[j].z + v[j].w * v[j].w);
            const float rstd = 1.0f / sqrtf(wave_sum(ss, lane) * (1.0f / DM) + EPS);
#pragma unroll
            for (int j = 0; j < 8; ++j) v[j] = v[j] * rstd * gv[j];
            GAS v2u* o8 = (GAS v2u*)(H + (size_t)m * DM) + lane;
#pragma unroll
            for (int j = 0; j < 8; ++j) o8[64 * j] = (v2u){pk2(v[j].x, v[j].y), pk2(v[j].z, v[j].w)};
            if constexpr (XB) { const int mn = m + NGW; if (ci + 1 < c1 && mn < S_) { const GAS v2u* xn = (const GAS v2u*)((const bf16*)x + (size_t)mn * DM) + lane;
#pragma unroll
                for (int j = 0; j < 8; ++j) raw[j] = xn[64 * j]; } }
            if constexpr (ROUTE) {
                float sd[8];
#pragma unroll
                for (int e = 0; e < 8; ++e) { float t = 0.f;
#pragma unroll
                    for (int j = 0; j < 8; ++j) { const f32x4 w = *(const LAS f32x4*)(wr_l + e * DM + 4 * (lane + 64 * j)); t += (v[j].x * w.x + v[j].y * w.y) + (v[j].z * w.z + v[j].w * w.w); }
                    sd[e] = t; }
                float ra[4], rb[2], rc;
#pragma unroll
                for (int i = 0; i < 4; ++i) { const bool up = (lane & 1) != 0; ra[i] = (up ? sd[4 + i] : sd[i]) + shx(up ? sd[i] : sd[4 + i], lane, 1); }
#pragma unroll
                for (int i = 0; i < 2; ++i) { const bool up = (lane & 2) != 0; rb[i] = (up ? ra[2 + i] : ra[i]) + shx(up ? ra[i] : ra[2 + i], lane, 2); }
                { const bool up = (lane & 4) != 0; rc = (up ? rb[1] : rb[0]) + shx(up ? rb[0] : rb[1], lane, 4); }
                rc += shx(rc, lane, 8); rc += shx(rc, lane, 16); rc += shx(rc, lane, 32);
                float v0 = -__builtin_inff(), v1 = -__builtin_inff(); int e0 = 0, e1 = 0;
#pragma unroll
                for (int e = 0; e < 8; ++e) { constexpr int BR[8] = {0, 4, 2, 6, 1, 5, 3, 7};
                    const float sv = __builtin_bit_cast(float, __builtin_amdgcn_readlane(__builtin_bit_cast(int, rc), BR[e]));
                    if (sv > v0) { v1 = v0; e1 = e0; v0 = sv; e0 = e; } else if (sv > v1) { v1 = sv; e1 = e; } }
                const float g0 = 1.0f / (1.0f + expf(v1 - v0)), g1 = 1.0f - g0;
                if (lane == 0) {
                    const unsigned o0 = __hip_atomic_fetch_add(lcnt + e0, 1u, __ATOMIC_RELAXED, __HIP_MEMORY_SCOPE_WORKGROUP), o1 = __hip_atomic_fetch_add(lcnt + e1, 1u, __ATOMIC_RELAXED, __HIP_MEMORY_SCOPE_WORKGROUP);
                    LAS int* r = rec + (wave * 8 + (ci - c0)) * 8;
                    r[0] = m; r[1] = e0; r[2] = e1; r[3] = __builtin_bit_cast(int, g0); r[4] = __builtin_bit_cast(int, g1); r[5] = (int)o0; r[6] = (int)o1; }
            }
        }
        if constexpr (ROUTE) {
            LDS_WAIT(); __syncthreads();
            if (tid < 8) { const unsigned c = lcnt[tid]; unsigned b = 0u; if (c && !dry) b = xb_add((gu32*)(a->ws + WS_CTL) + CW_CNT + tid * pg8::CNT_STRIDE, c); lbase[tid] = b; }
            LDS_WAIT(); __syncthreads();
            if (lane < c1 - c0 && !dry) { const LAS int* r = rec + (wave * 8 + lane) * 8; const int m = r[0];
                if (m >= 0) { const int e0 = r[1], e1 = r[2]; const int s0 = (int)lbase[e0] + r[5], s1 = (int)lbase[e1] + r[6];
                    int* ltok = (int*)(a->ws + WS_LTOK); float* lgate = (float*)(a->ws + WS_LGATE);
                    ltok[(size_t)e0 * S_ + s0] = m; lgate[(size_t)e0 * S_ + s0] = __builtin_bit_cast(float, r[3]);
                    ltok[(size_t)e1 * S_ + s1] = m; lgate[(size_t)e1 * S_ + s1] = __builtin_bit_cast(float, r[4]);
                    ((int4*)(a->ws + WS_POS))[m] = make_int4(e0, s0, e1, s1); } }
        }
    }
}

__device__ __forceinline__ void unpack8(const v4u w, float (&f)[8]) { f[0] = bflo(w.x); f[1] = bfhi(w.x); f[2] = bflo(w.y); f[3] = bfhi(w.y); f[4] = bflo(w.z); f[5] = bfhi(w.z); f[6] = bflo(w.w); f[7] = bfhi(w.w); }
__device__ __forceinline__ v4u pack8s(const float (&f)[8], float s, const float (&g)[8]) {
    v4u o; o.x = pk2(f[0] * s * g[0], f[1] * s * g[1]); o.y = pk2(f[2] * s * g[2], f[3] * s * g[3]); o.z = pk2(f[4] * s * g[4], f[5] * s * g[5]); o.w = pk2(f[6] * s * g[6], f[7] * s * g[7]); return o; }
__device__ __forceinline__ float ssq8(const float (&f)[8]) { return ((f[0] * f[0] + f[1] * f[1]) + (f[2] * f[2] + f[3] * f[3])) + ((f[4] * f[4] + f[5] * f[5]) + (f[6] * f[6] + f[7] * f[7])); }
__device__ __forceinline__ void prep2(Frame& F, KArgs a, int l, bool dry = false) {
    PH_IDX();
    const int gw = F.vcu * NWAVES + wave, NGW = F.G * NWAVES, h = lane >> 3, sub = lane & 7;
    bf16* PROJ = (bf16*)(a->ws + WS_PROJ); bf16* QM = (bf16*)(a->ws + WS_QM); bf16* KVM = (bf16*)(a->ws + WS_KVM); bf16* KM = (bf16*)(a->ws + WS_KM);
    const int* pos = (const int*)a->in[1];
    const float* gq = (const float*)a->in[11] + l * QKB; const float* gk = (const float*)a->in[12] + l * QKB;
    float g_q[3][8], g_k[3][8], inv[8];
#pragma unroll
    for (int i = 0; i < 3; ++i)
#pragma unroll
        for (int j = 0; j < 8; ++j) { g_q[i][j] = gq[64 * i + 8 * sub + j]; g_k[i][j] = gk[64 * i + 8 * sub + j]; }
#pragma unroll
    for (int j = 0; j < 8; ++j) inv[j] = powf(10000.0f, -(float)((sub & 3) * 8 + j) * (1.0f / 32.0f));
    for (int m = gw; m < S_; m += NGW) {
        const float p = (float)pos[m];
        float cs[8], sn[8];
#pragma unroll
        for (int j = 0; j < 8; ++j) { const float ang = p * inv[j]; sincosf(ang, &sn[j], &cs[j]); }
        const GAS v4u* qrow = (const GAS v4u*)(QM + (size_t)m * NQB_ + h * QKB);
        const GAS v4u* krow = (const GAS v4u*)(KVM + (size_t)m * NKVB + h * 256);
        const GAS v4u* rrow = (const GAS v4u*)(PROJ + (size_t)m * INP + C_KR);
        float fq[3][8], fk[3][8];
#pragma unroll
        for (int i = 0; i < 3; ++i) unpack8(qrow[sub + 8 * i], fq[i]);
        unpack8(krow[sub], fk[0]); unpack8(krow[8 + sub], fk[1]); unpack8(rrow[sub], fk[2]);
        float sq = ssq8(fq[0]) + ssq8(fq[1]) + ssq8(fq[2]), sk = ssq8(fk[0]) + ssq8(fk[1]) + ssq8(fk[2]);
#pragma unroll
        for (int o = 1; o < 8; o <<= 1) { sq += shx(sq, lane, o); sk += shx(sk, lane, o); }
        const float rq = 1.0f / sqrtf(sq * (1.0f / QKB) + EPS), rk = 1.0f / sqrtf(sk * (1.0f / QKB) + EPS);
        float nq[8], nk[8];
#pragma unroll
        for (int j = 0; j < 8; ++j) { nq[j] = fq[2][j] * rq * g_q[2][j]; nk[j] = fk[2][j] * rk * g_k[2][j]; }
        float oq[8], ok[8];
#pragma unroll
        for (int j = 0; j < 8; ++j) { const float pq = shx(nq[j], lane, 4), pk = shx(nk[j], lane, 4);
            oq[j] = (sub < 4) ? (nq[j] * cs[j] - pq * sn[j]) : (pq * sn[j] + nq[j] * cs[j]);
            ok[j] = (sub < 4) ? (nk[j] * cs[j] - pk * sn[j]) : (pk * sn[j] + nk[j] * cs[j]); }
        const float one[8] = {1.f, 1.f, 1.f, 1.f, 1.f, 1.f, 1.f, 1.f};
        const size_t dofs = dry ? (size_t)(400 * MiB) / 2 : 0; GAS v4u* qo = (GAS v4u*)(QM + dofs + (size_t)m * NQB_ + h * QKB); GAS v4u* ko = (GAS v4u*)(KM + dofs + (size_t)m * NQB_ + h * QKB);
        qo[sub] = pack8s(fq[0], rq, g_q[0]); qo[8 + sub] = pack8s(fq[1], rq, g_q[1]); qo[16 + sub] = pack8s(oq, 1.0f, one);
        ko[sub] = pack8s(fk[0], rk, g_k[0]); ko[8 + sub] = pack8s(fk[1], rk, g_k[1]); ko[16 + sub] = pack8s(ok, 1.0f, one);
    }
}
__device__ __forceinline__ void att_merge(Frame& F, KArgs a) {
    PH_IDX();
    const int gw = F.vcu * NWAVES + wave, NGW = F.G * NWAVES;
    const bf16* OA = (const bf16*)(a->ws + WS_OA); const bf16* OB = (const bf16*)(a->ws + WS_OB); const float* LA = (const float*)(a->ws + WS_LSEA); const float* LB = (const float*)(a->ws + WS_LSEB);
    bf16* ATT = (bf16*)(a->ws + WS_ATT);
    for (int m = gw; m < S_; m += NGW) {
        const GAS v4u* pa = (const GAS v4u*)(OA + (size_t)m * WA) + 2 * lane; const GAS v4u* pb = (const GAS v4u*)(OB + (size_t)m * WA) + 2 * lane;
        const float la = LA[(size_t)m * NH + (lane >> 3)], lb = LB[(size_t)m * NH + (lane >> 3)];
        const v4u qa[2] = {pa[0], pa[1]}, qb[2] = {pb[0], pb[1]};
        const float wb = 1.0f / (1.0f + expf(la - lb)), wa = 1.0f - wb;
        GAS v4u* po = (GAS v4u*)(ATT + (size_t)m * DM) + 2 * lane;
#pragma unroll
        for (int j = 0; j < 2; ++j) { float fa[8], fb[8]; unpack8(qa[j], fa); unpack8(qb[j], fb);
            v4u o; o.x = pk2(wa * fa[0] + wb * fb[0], wa * fa[1] + wb * fb[1]); o.y = pk2(wa * fa[2] + wb * fb[2], wa * fa[3] + wb * fb[3]);
            o.z = pk2(wa * fa[4] + wb * fb[4], wa * fa[5] + wb * fb[5]); o.w = pk2(wa * fa[6] + wb * fb[6], wa * fa[7] + wb * fb[7]); po[j] = o; }
    }
}
__device__ __forceinline__ void moe_tail_reduce(Frame& F, KArgs a, int T, int pm, int pnl) {
    PH_IDX();
    const int bx = (int)blockIdx.x; if (bx >= 4 * T) return;
    const int tu = bx >> 2, q = bx & 3;
    const bf16* P = (const bf16*)(a->ws + WS_PT) + (size_t)tu * 4 * 65536; bf16* Y = (bf16*)(a->ws + WS_Y);
    for (int rr = wave; rr < 64; rr += NWAVES) { const int r = 64 * q + rr;
        float s0 = 0.f, s1 = 0.f, s2 = 0.f, s3 = 0.f;
#pragma unroll
        for (int k = 0; k < 4; ++k) { const v2u w = *((const GAS v2u*)(P + (size_t)k * 65536 + (size_t)r * 256) + lane); s0 += bflo(w.x); s1 += bfhi(w.x); s2 += bflo(w.y); s3 += bfhi(w.y); }
        *((GAS v2u*)(Y + (size_t)(pm * 256 + r) * DM + pnl * 256) + lane) = (v2u){pk2(s0, s1), pk2(s2, s3)}; }
}
__device__ __forceinline__ void moe_tiles(KArgs a, int (&tb)[9]) {
    gu32* cnt = (gu32*)(a->ws + WS_CTL) + CW_CNT; int acc = 0;
    int lane_; asm volatile("v_mbcnt_lo_u32_b32 %0, -1, 0\n\tv_mbcnt_hi_u32_b32 %0, -1, %0" : "=v"(lane_));
    const int cv = (int)__hip_atomic_load(cnt + (lane_ & 7) * pg8::CNT_STRIDE, RLX_AGENT);
#pragma unroll
    for (int e = 0; e < 8; ++e) { tb[e] = acc; acc += (__builtin_amdgcn_readlane(cv, e) + 255) >> 8; }
    tb[8] = acc;
}
__device__ __forceinline__ void moe_combine(Frame& F, KArgs a, bool dry = false) {
    PH_IDX();
    const int gw = F.vcu * NWAVES + wave, NGW = F.G * NWAVES;
    int tb[9]; moe_tiles(a, tb);
    const bf16* Y = (const bf16*)(a->ws + WS_Y); const bf16* X3 = (const bf16*)(a->ws + WS_H); float* out = (float*)a->out; float* outw = dry ? (float*)(a->ws + WS_PROJ) : out;
    typedef int v4i __attribute__((ext_vector_type(4)));
    const GAS v4i* posr = (const GAS v4i*)(a->ws + WS_POS);
    v4i ps = posr[gw < S_ ? gw : 0];
    for (int m = gw; m < S_; m += NGW) {
        int b0 = 0, b1 = 0;
#pragma unroll
        for (int e = 0; e < 8; ++e) { b0 = (ps.x == e) ? tb[e] : b0; b1 = (ps.z == e) ? tb[e] : b1; }
        const GAS v2u* y0 = (const GAS v2u*)(Y + (size_t)(b0 * 256 + ps.y) * DM) + lane; const GAS v2u* y1 = (const GAS v2u*)(Y + (size_t)(b1 * 256 + ps.w) * DM) + lane;
        const GAS v2u* xr = (const GAS v2u*)(X3 + (size_t)m * DM) + lane; GAS f32x4* xw = (GAS f32x4*)(outw + (size_t)m * DM) + lane;
        v2u w0[8], w1[8], wx[8];
#pragma unroll
        for (int j = 0; j < 8; ++j) { w0[j] = y0[64 * j]; w1[j] = y1[64 * j]; wx[j] = xr[64 * j]; }
        { const int mn = m + NGW; ps = posr[mn < S_ ? mn : m]; }
#pragma unroll
        for (int j = 0; j < 8; ++j) { f32x4 v;
            v.x = bflo(wx[j].x) + (bflo(w0[j].x) + bflo(w1[j].x)); v.y = bfhi(wx[j].x) + (bfhi(w0[j].x) + bfhi(w1[j].x)); v.z = bflo(wx[j].y) + (bflo(w0[j].y) + bflo(w1[j].y)); v.w = bfhi(wx[j].y) + (bfhi(w0[j].y) + bfhi(w1[j].y));
            __builtin_nontemporal_store(v, xw + 64 * j); }
    }
}
#ifndef MK_PER_PHASE
#define MK_PER_PHASE 0
#endif
#ifndef DBG_STOP
#define DBG_STOP 23
#endif
#ifndef DUP_MASK
#define DUP_MASK 0u
#endif
constexpr int NPH = 20;
#undef DBG_STOP
#define DBG_STOP NPH

using CfgM = att::Cfg<192, NQB_, NQB_, NKVB, DM, false>;
using CfgA = att::Cfg<128, INP, INP, INP, WA, true, NH, 0>;
using CfgB = att::Cfg<128, 16 * INP, 16 * INP, 16 * INP, 16 * WA, true, 16 * NH, 33>;
constexpr int W_DILA = 513, W_DILB = 129;

__global__ void __launch_bounds__(NWAVES * 64, 2) mega_fwd(Args a_byval) {
    extern __shared__ __attribute__((aligned(16))) unsigned char lds[];
#ifdef PAD_NOPS
    asm volatile(".rept " PAD_NOPS "\n\ts_nop 0\n\t.endr");
#endif
    Frame F;
    F.lds = (LAS unsigned char*)lds;
    F.wave = __builtin_amdgcn_readfirstlane((int)threadIdx.x >> 6); asm volatile("" : "+s"(F.wave));
    F.G = gridDim.x; { const int bx = blockIdx.x; F.vcu = (F.G % 8 == 0) ? (bx % 8) * (F.G / 8) + bx / 8 : bx; }
    const int lo = a_byval.ph_lo, hi = a_byval.ph_hi, use_bar = a_byval.use_bar;
    GAS unsigned char* const ws0 = kargs()->ws;
    volatile LAS unsigned* MISC = (volatile LAS unsigned*)(F.lds + MISC_OFF);
    for (int u = threadIdx.x; u < (LDS_BYTES - LDSCTL_OFF) / 4; u += NWAVES * 64) ((LAS unsigned*)(F.lds + LDSCTL_OFF))[u] = 0u;
    __syncthreads();
    XcdBarrier bar; bar.bar = (gu32*)(ws0 + WS_CTL) + CW_BAR; bar.x = 0; bar.st = nullptr;
    if (use_bar) bar = xcd_barrier_post((gu32*)(ws0 + WS_CTL) + CW_BAR, MISC + 8);
#define IN(k) (lo <= (k) && (k) < hi)
#define REPS(k) (((DUP_MASK >> (k)) & 1u) ? 2 : 1)
#ifndef DUP_BAR
#define DUP_BAR 0
#endif
#define DUP(k) for (int rp_ = 0; rp_ < REPS(k); (DUP_BAR && use_bar && rp_ == 0 && REPS(k) > 1) ? (xcd_barrier(bar), 0) : 0, ++rp_)
#ifndef DOWN_REV
#define DOWN_REV 1
#endif
#ifndef DOWN_WGM
#define DOWN_WGM 4
#endif
#ifndef PROBE_EPI
#define PROBE_EPI 0
#endif
#ifndef SEAM_REPS
#define SEAM_REPS 1
#endif
#define SEAM(k) do { if (use_bar && IN(k) && IN((k) + 1)) { for (int sr_ = 0; sr_ < SEAM_REPS; ++sr_) { XcdBarrier b_ = bar; asm volatile("" : "+s"(b_.bar)); xcd_barrier(b_); } } } while (0)
    LAS unsigned char* const ring = F.lds + RING_OFF;
    LAS float* const xlds = (LAS float*)(F.lds + XLDS_OFF);

    if (IN(0)) { DUP(0) p0_prologue(F, kargs()); SEAM(0); }

    for (int l = 0; l < NLAYER; ++l) {
        const int pb = l ? 9 : 1;
        int bx = (int)blockIdx.x, G_ = F.G; asm volatile("" : "+s"(bx), "+s"(G_));
        const KArgs a = kargs(); GAS unsigned char* ws = a->ws; asm volatile("" : "+s"(ws));
        bf16* const H = (bf16*)(ws + WS_H); bf16* const PROJ = (bf16*)(ws + WS_PROJ); bf16* const QM = (bf16*)(ws + WS_QM); bf16* const KVM = (bf16*)(ws + WS_KVM);
        bf16* const KM = (bf16*)(ws + WS_KM); bf16* const ATT = (bf16*)(ws + WS_ATT);
        bf16* const ACT = (bf16*)(ws + WS_ACT); bf16* const Y = (bf16*)(ws + WS_Y);
        float* const ssq0 = (float*)(ws + WS_SSQ0); float* const ssqx = (float*)(ws + WS_SSQX); float* const ssqc = (float*)(ws + WS_SSQC) + (size_t)l * S_ * 2;
        if (IN(pb + 0)) { DUP(pb + 0) {
            pg8::Gemm g{H, (const bf16*)(ws + WS_WIN) + (size_t)l * INP * DM, DM, DM}; pg8::TileOrder O; O.init(S_ / 256, INP / 256, G_, bx);
            pg8::EpiInProj E{PROJ, INP, l ? ssqx + (size_t)S_ * 8 : ssq0, l ? 8 : 1, (const float*)a->in[9] + l * HD, (const float*)a->in[10] + l * HD, (const float*)a->in[6] + l * KVLORA, ssqc, EPS};
            pg8::gemm_phase<pg8::EpiInProj, pg8::TileOrder, false>(ring, g, O, E, F.wave, xlds); }
            SEAM(pb + 0);
        }
        if (IN(pb + 1)) { DUP(pb + 1) {
            { pg8::Gemm g{PROJ + C_CQ, (const bf16*)(ws + WS_WQB) + (size_t)l * NQB_ * QLORA, QLORA, INP}; pg8::TileOrder O; O.init(S_ / 256, NQB_ / 256, G_, bx);
              pg8::EpiBf16 E{QM, NQB_, ssqc, 2, 1.0f / QLORA, EPS}; pg8::gemm_phase<pg8::EpiBf16, pg8::TileOrder, false>(ring, g, O, E, F.wave, xlds); }
            { pg8::Gemm g{PROJ + C_CKV, (const bf16*)(ws + WS_WKVB) + (size_t)l * NKVB * KVLORA, KVLORA, INP}; pg8::TileOrder O; O.init(S_ / 256, NKVB / 256, G_, bx);
              pg8::EpiBf16 E{KVM, NKVB, nullptr, 0, 0.f, 0.f}; pg8::gemm_phase<pg8::EpiBf16, pg8::TileOrder, false>(ring, g, O, E, F.wave, xlds); } }
            SEAM(pb + 1);
        }
        if (IN(pb + 2)) { if (REPS(pb + 2) > 1) prep2(F, a, l, true); prep2(F, a, l); SEAM(pb + 2); }
        if (IN(pb + 3)) { DUP(pb + 3) {
            att::lptr albs = (att::lptr)ring;
            const bool host = (l == 0) && (G_ % 8 == 0) && rp_ == 0;
            if (host && (bx & 4) == 0) { late_convert(F, a, 0); __syncthreads(); }
            if (F.wave >= 4) __builtin_amdgcn_s_setprio(1);
            {   att::Seam<CfgM> Sm;
                for (int it = bx; it < 256; it += G_) {
                    const int h = it & 7, x = it >> 3;
                    att::BlockRef b0, b1;
                    b0.P0 = (63 - x) * 256; b1.P0 = x * 256;
                    b0.K = b1.K = KM + h * QKB; b0.V = b1.V = KVM + h * 256 + 128;
                    b0.Q = QM + (size_t)b0.P0 * NQB_ + h * QKB; b1.Q = QM + (size_t)b1.P0 * NQB_ + h * QKB;
                    b0.O = ATT + (size_t)b0.P0 * DM + WA + h * HD; b1.O = ATT + (size_t)b1.P0 * DM + WA + h * HD; b0.lse = b1.lse = nullptr;
                    att::prime<CfgM>(b0, W_CAUSAL, albs, Sm, F.wave);
                    for (int pass = 0; pass < 2; ++pass) { const att::BlockRef cur = pass ? b1 : b0; att::block<CfgM>(cur, b1, S_, W_CAUSAL, albs, Sm, F.wave); }
                } }
            {   att::Seam<CfgA> Sa;
                bf16* const OA = (bf16*)(ws + WS_OA); float* const LA = (float*)(ws + WS_LSEA);
                for (int it = bx; it < 256; it += G_) {
                    const int h = it & 7, x = it >> 3;
                    { const float* tg = (const float*)(ws + WS_TBL) + h * att::TBL_N; LAS float* tl = (LAS float*)(ring + CfgA::OFF_TBL);
                      PH_IDX(); static_assert(att::TBL_N % 4 == 0 && att::TBL_N / 4 <= 2 * NWAVES * 64, "table copy"); const int i1 = tid + NWAVES * 64; const bool h1 = i1 < att::TBL_N / 4; const f32x4 t0 = ((const GAS f32x4*)tg)[tid], t1 = ((const GAS f32x4*)tg)[h1 ? i1 : tid]; ((LAS f32x4*)tl)[tid] = t0; if (h1) ((LAS f32x4*)tl)[i1] = t1; }
                    att::BlockRef b0, b1;
                    b0.P0 = x * 256; b1.P0 = (63 - x) * 256;
                    b0.K = b1.K = PROJ + C_KA + h * HD; b0.V = b1.V = PROJ + C_VA + h * HD;
                    b0.Q = PROJ + (size_t)b0.P0 * INP + C_QA + h * HD; b1.Q = PROJ + (size_t)b1.P0 * INP + C_QA + h * HD;
                    b0.O = OA + (size_t)b0.P0 * WA + h * HD; b1.O = OA + (size_t)b1.P0 * WA + h * HD;
                    b0.lse = LA + (size_t)b0.P0 * NH + h; b1.lse = LA + (size_t)b1.P0 * NH + h;
                    att::prime<CfgA>(b0, W_DILA, albs, Sa, F.wave);
                    for (int pass = 0; pass < 2; ++pass) { const att::BlockRef cur = pass ? b1 : b0; att::block<CfgA>(cur, b1, S_, W_DILA, albs, Sa, F.wave); }
                } }
            {   att::Seam<CfgB> Sb;
                bf16* const OB = (bf16*)(ws + WS_OB); float* const LB = (float*)(ws + WS_LSEB);
                for (int it = bx; it < 256; it += G_) {
                    const int h = it & 7, y = it >> 3;
                    { const float* tg = (const float*)(ws + WS_TBL) + (NH + h) * att::TBL_N; LAS float* tl = (LAS float*)(ring + CfgB::OFF_TBL);
                      PH_IDX(); static_assert(att::TBL_N % 4 == 0 && att::TBL_N / 4 <= 2 * NWAVES * 64, "table copy"); const int i1 = tid + NWAVES * 64; const bool h1 = i1 < att::TBL_N / 4; const f32x4 t0 = ((const GAS f32x4*)tg)[tid], t1 = ((const GAS f32x4*)tg)[h1 ? i1 : tid]; ((LAS f32x4*)tl)[tid] = t0; if (h1) ((LAS f32x4*)tl)[i1] = t1; }
                    att::BlockRef b0, b1;
                    const int i0 = 2 * y, i1 = 2 * y + 1, r0 = i0 >> 2, r1 = i1 >> 2;
                    b0.P0 = (i0 & 3) * 256; b1.P0 = (i1 & 3) * 256;
                    b0.K = PROJ + (size_t)r0 * INP + C_KA + h * HD; b1.K = PROJ + (size_t)r1 * INP + C_KA + h * HD;
                    b0.V = PROJ + (size_t)r0 * INP + C_VA + h * HD; b1.V = PROJ + (size_t)r1 * INP + C_VA + h * HD;
                    b0.Q = PROJ + ((size_t)b0.P0 * 16 + r0) * INP + C_QA + h * HD; b1.Q = PROJ + ((size_t)b1.P0 * 16 + r1) * INP + C_QA + h * HD;
                    b0.O = OB + ((size_t)b0.P0 * 16 + r0) * WA + h * HD; b1.O = OB + ((size_t)b1.P0 * 16 + r1) * WA + h * HD;
                    b0.lse = LB + ((size_t)b0.P0 * 16 + r0) * NH + h; b1.lse = LB + ((size_t)b1.P0 * 16 + r1) * NH + h;
                    att::prime<CfgB>(b0, W_DILB, albs, Sb, F.wave);
                    for (int pass = 0; pass < 2; ++pass) { const att::BlockRef cur = pass ? b1 : b0; att::block<CfgB>(cur, b1, S_ / 16, W_DILB, albs, Sb, F.wave); }
                } }
            __builtin_amdgcn_s_setprio(0);
            if (host && (bx & 4) != 0) { __syncthreads(); late_convert(F, a, 1); } }
            SEAM(pb + 3);
        }
        if (IN(pb + 4)) { att_merge(F, a); SEAM(pb + 4); }
        if (IN(pb + 5)) { for (int rp_ = 0; rp_ < (l == 0 ? REPS(6) : 1); ++rp_) {
            pg8::Gemm g{ATT, (const bf16*)(ws + WS_WOUT) + (size_t)l * DM * DM, DM, DM}; pg8::TileOrder O; O.init(S_ / 256, DM / 256, G_, bx);
            pg8::EpiRes E{l == 0 ? (const float*)a->in[0] : nullptr, H, nullptr, H, ssqx, DM};
            pg8::gemm_phase<pg8::EpiRes, pg8::TileOrder, false>(ring, g, O, E, F.wave, xlds); }
            SEAM(pb + 5);
        }
        if (l == 0) {
            if (IN(7)) { DUP(7) {
                pg8::Gemm g{H, (const bf16*)(ws + WS_WGU), DM, DM}; pg8::TileOrder O; O.init(S_ / 256, NT_GU, G_, bx);
                pg8::EpiSwiGLU E{ACT, FF, NT_GU, ssqx, EPS, (REPS(7) > 1 && rp_ == 0) ? PROBE_EPI : 0};
                pg8::gemm_phase<pg8::EpiSwiGLU, pg8::TileOrder, false>(ring, g, O, E, F.wave, xlds); }
                SEAM(7);
            }
            if (IN(8)) { DUP(8) {
                const bool dry = REPS(8) > 1 && rp_ == 0;
                pg8::Gemm g{ACT, (const bf16*)(ws + WS_WD), FF, FF}; pg8::TileOrder O; O.init(S_ / 256, NT_D, G_, bx, DOWN_WGM);
                pg8::EpiRes E{nullptr, H, dry ? (float*)(ws + WS_END) : nullptr, dry ? nullptr : H, ssqx + (size_t)S_ * 8, DM};
                pg8::gemm_phase<pg8::EpiRes, pg8::TileOrder, false>(ring, g, O, E, F.wave, xlds); }
                SEAM(8);
            }
        } else {
            bf16* const HN = (bf16*)(ws + WS_HN);
            if (IN(15)) { if (REPS(15) > 1) norm_rows<true, true>(F, (const float*)H, (const float*)a->in[14] + l * DM, HN, a, true); norm_rows<true, true>(F, (const float*)H, (const float*)a->in[14] + l * DM, HN, a); SEAM(15); }
            if (IN(16)) { DUP(16) {
                int tb[9]; moe_tiles(a, tb);
                pg8::MoeOrder O; O.t.init(tb[8], NT_GU, G_, bx); O.t1 = tb[1]; O.t2 = tb[2]; O.t3 = tb[3]; O.t4 = tb[4]; O.t5 = tb[5]; O.t6 = tb[6]; O.t7 = tb[7];
                O.nNl = NT_GU; O.list = (const int*)(ws + WS_LTOK); O.cnt = (const int*)(ws + WS_CTL) + CW_CNT; O.S_cap = S_; O.R = -1; O.T = 0; O.nkt_full = DM / 64;
                pg8::Gemm g{HN, (const bf16*)(ws + WS_WGUE), DM, DM};
                pg8::EpiSwiGLU E{ACT, FF, NT_GU, nullptr, 0.f, (REPS(16) > 1 && rp_ == 0) ? PROBE_EPI : 0};
                pg8::gemm_phase<pg8::EpiSwiGLU, pg8::MoeOrder, true>(ring, g, O, E, F.wave, xlds); }
                SEAM(16);
            }
            if (IN(17)) { DUP(17) {
                int tb[9]; moe_tiles(a, tb);
                pg8::MoeOrder O; O.t.init(tb[8], NT_D, G_, bx, DOWN_WGM); O.t.rev = DOWN_REV; O.t1 = tb[1]; O.t2 = tb[2]; O.t3 = tb[3]; O.t4 = tb[4]; O.t5 = tb[5]; O.t6 = tb[6]; O.t7 = tb[7];
                O.nNl = NT_D; O.list = (const int*)(ws + WS_LTOK); O.cnt = (const int*)(ws + WS_CTL) + CW_CNT; O.S_cap = S_; O.nkt_full = FF / 64;
                { const int U = tb[8] * NT_D, Rr = U / G_, Tt = U - Rr * G_; const bool split = Tt > 0 && 4 * Tt <= G_; O.R = split ? Rr : -1; O.T = split ? Tt : 0; }
                pg8::Gemm g{ACT, (const bf16*)(ws + WS_WDE), FF, FF};
                pg8::EpiMoeDown E{Y, DM, NT_D, (const float*)(ws + WS_LGATE), (const int*)(ws + WS_CTL) + CW_CNT, S_, (bf16*)(ws + WS_PT)};
                pg8::gemm_phase<pg8::EpiMoeDown, pg8::MoeOrder, false, true>(ring, g, O, E, F.wave, xlds); }
                SEAM(17);
            }
            if (IN(18)) {
                int tb[9]; moe_tiles(a, tb);
                const int U = tb[8] * NT_D, Rr = U / G_, Tt = U - Rr * G_;
                if (Tt > 0 && 4 * Tt <= G_ && bx < 4 * Tt) {
                    pg8::TileOrder O; O.init(tb[8], NT_D, G_, bx, DOWN_WGM); O.rev = DOWN_REV; pg8::Unit u; O.at((long)Rr * G_ + (bx >> 2), u);
                    moe_tail_reduce(F, a, Tt, u.pm, u.pn); }
                SEAM(18);
            }
            if (IN(19)) { if (REPS(19) > 1) moe_combine(F, a, true); moe_combine(F, a); }
        }
    }
#undef IN
#undef SEAM
#undef REPS
#undef DUP
}

extern "C" void kernel_launch(void* const* d_in, const int* in_sizes, int n_in, void* d_out, int out_size, void* d_ws, size_t ws_size, hipStream_t stream) {
    static int grid = 0;
    if (grid == 0) {
        if (n_in != 22 || in_sizes[0] != S_ * DM || out_size != S_ * DM || ws_size < WS_END) { fprintf(stderr, "kernel_launch: shape/workspace mismatch (n_in %d, in0 %d, out %d, ws %zu, need %zu)\n", n_in, n_in > 0 ? in_sizes[0] : -1, out_size, ws_size, (size_t)WS_END); grid = -1; return; }
        int dev = 0, cus = 0, per_cu = 0;
        if (hipGetDevice(&dev) != hipSuccess || hipDeviceGetAttribute(&cus, hipDeviceAttributeMultiprocessorCount, dev) != hipSuccess) { grid = -1; return; }
        if (hipFuncSetAttribute((const void*)mega_fwd, hipFuncAttributeMaxDynamicSharedMemorySize, LDS_BYTES) != hipSuccess) { fprintf(stderr, "kernel_launch: hipFuncSetAttribute failed\n"); grid = -1; return; }
        if (hipOccupancyMaxActiveBlocksPerMultiprocessor(&per_cu, (const void*)mega_fwd, NWAVES * 64, LDS_BYTES) != hipSuccess || per_cu < 1) { fprintf(stderr, "kernel_launch: occupancy query reports %d\n", per_cu); }
        (void)hipGetLastError();
        grid = cus;
    }
    if (grid < 0) return;
    if (hipMemsetAsync((char*)d_ws + WS_CTL, 0, CTL_ZERO_BYTES, stream) != hipSuccess) return;
    Args a{};
    for (int i = 0; i < 22; ++i) a.in[i] = d_in[i];
    a.out = (float*)d_out; a.ws = (unsigned char*)d_ws; a.pad = 0;
#if MK_PER_PHASE
    for (int ph = 0; ph < DBG_STOP; ++ph) { a.ph_lo = ph; a.ph_hi = ph + 1; a.use_bar = 0;
        hipLaunchKernelGGL(mega_fwd, dim3(grid), dim3(NWAVES * 64), LDS_BYTES, stream, a); }
#else
    a.ph_lo = 0; a.ph_hi = DBG_STOP; a.use_bar = 1;
    hipLaunchKernelGGL(mega_fwd, dim3(grid), dim3(NWAVES * 64), LDS_BYTES, stream, a);
#endif
}
```
